# Optimizing an MI355X kernel written in HIP

```python
import math
import jax, jax.numpy as jnp
from jax import lax
import numpy as np

D_MODEL = 1024
BATCH = 16
SEQ = 256
DEPTH = 2
DEC_BATCH = 8
DEC_SEQ = 2048
PAST_LEN = 512

GRID_W = 64
CONV_CH = D_MODEL
CONV_W = 31
CONV_PAD = CONV_W // 2
RET_HEADS = 4
RET_DK = 256
RET_DV = 512
RET_QK_W = RET_HEADS * RET_DK
RET_V_W = RET_HEADS * RET_DV
CHUNK = 128
MLP_W = 4 * D_MODEL
PROJ_W = 2 * CONV_CH + 2 * RET_QK_W + 2 * RET_V_W + 2 * D_MODEL
ROPE_BASE = 10000.0
EPS = 1e-6

kernel_name = "hybrid_conformer_retention_dit_step"


def _rmsnorm(x, g):
    xf = x.astype(jnp.float32)
    y = xf * lax.rsqrt(jnp.mean(xf * xf, axis=-1, keepdims=True) + EPS)
    return (y * g.astype(jnp.float32)).astype(x.dtype)


def _head_norm(y):
    yf = y.astype(jnp.float32)
    mu = jnp.mean(yf, axis=-1, keepdims=True)
    var = jnp.mean(jnp.square(yf - mu), axis=-1, keepdims=True)
    return ((yf - mu) * lax.rsqrt(var + EPS)).astype(y.dtype)


def _rope_2d(x):
    L = x.shape[1]
    t = jnp.arange(L)
    row = (t // GRID_W).astype(jnp.float32)
    col = (t % GRID_W).astype(jnp.float32)
    nf = RET_DK // 4
    inv = ROPE_BASE ** (-jnp.arange(nf, dtype=jnp.float32) / nf)
    ang = jnp.concatenate([row[:, None] * inv, col[:, None] * inv], axis=-1)[None, :, None, :]
    cos = jnp.cos(ang).astype(x.dtype)
    sin = jnp.sin(ang).astype(x.dtype)
    x1, x2 = jnp.split(x, 2, axis=-1)
    return jnp.concatenate([x1 * cos - x2 * sin, x2 * cos + x1 * sin], axis=-1)


def _dwconv(u, w, b):
    out = lax.conv_general_dilated(
        u, w[:, None, :].astype(u.dtype), window_strides=(1,), padding=[(CONV_PAD, CONV_PAD)],
        dimension_numbers=("NWC", "WIO", "NWC"), feature_group_count=u.shape[-1])
    return out + b.astype(u.dtype)


def _retention_scan(q, k, v, log_gamma, s0):
    B, L, H, DK = q.shape
    DV = v.shape[-1]
    n = L // CHUNK
    dt = q.dtype
    lg = log_gamma.astype(jnp.float32)
    idx = jnp.arange(CHUNK, dtype=jnp.float32)
    diff = idx[:, None] - idx[None, :]
    dmat = jnp.where(diff[None] >= 0, jnp.exp(jnp.maximum(diff, 0.0)[None] * lg[:, None, None]), 0.0).astype(dt)
    q_dec = jnp.exp((idx + 1.0)[:, None] * lg[None, :]).astype(dt)
    k_dec = jnp.exp((CHUNK - 1.0 - idx)[:, None] * lg[None, :]).astype(dt)
    s_dec = jnp.exp(CHUNK * lg).astype(dt)

    def chunks(t):
        return jnp.moveaxis(t.reshape(B, n, CHUNK, H, t.shape[-1]), 1, 0)

    def step(s, inp):
        qc, kc, vc = inp
        scores = jnp.einsum("bihd,bjhd->bhij", qc, kc) * dmat
        y = (jnp.einsum("bhij,bjhe->bihe", scores, vc)
             + jnp.einsum("bihd,bhde->bihe", qc, s) * q_dec[None, :, :, None])
        s = s * s_dec[None, :, None, None] + jnp.einsum("bjhd,bjhe->bhde", kc * k_dec[None, :, :, None], vc)
        return s, y

    s_fin, ys = lax.scan(step, s0.astype(dt), (chunks(q), chunks(k), chunks(v)))
    y = jnp.moveaxis(ys, 0, 1).reshape(B, L, H, DV)
    return y, s_fin


def _layer(x, mod, s0, grid, norm1_g, norm2_g, w_in, conv_dw, conv_b, conv_norm_g, w_conv_out,
           decay_logit, w_ret_out, w_out, w_mlp1, w_mlp2):
    B, L, _ = x.shape
    sh1, sc1, g1, sh2, sc2, g2 = jnp.split(mod[:, None, :].astype(x.dtype), 6, axis=-1)
    h = _rmsnorm(x, norm1_g) * (1.0 + sc1) + sh1
    split_idx = [2 * CONV_CH, 2 * CONV_CH + RET_QK_W, 2 * CONV_CH + 2 * RET_QK_W,
                 2 * CONV_CH + 2 * RET_QK_W + RET_V_W, 2 * CONV_CH + 2 * RET_QK_W + 2 * RET_V_W]
    u, q, k, v, rg, bg = jnp.split(h @ w_in, split_idx, axis=-1)

    a = u[..., :CONV_CH] * jax.nn.sigmoid(u[..., CONV_CH:])
    if grid:
        rows = L // GRID_W
        a = _dwconv(a.reshape(B * rows, GRID_W, CONV_CH), conv_dw, conv_b).reshape(B, L, CONV_CH)
    else:
        a = _dwconv(a, conv_dw, conv_b)
    a = jax.nn.silu(_rmsnorm(a, conv_norm_g)) @ w_conv_out

    q = q.reshape(B, L, RET_HEADS, RET_DK)
    k = k.reshape(B, L, RET_HEADS, RET_DK) * (RET_DK ** -0.5)
    v = v.reshape(B, L, RET_HEADS, RET_DV)
    if grid:
        q = _rope_2d(q)
        k = _rope_2d(k)
    log_g = jax.nn.log_sigmoid(decay_logit.astype(jnp.float32))
    y_f, s_f = _retention_scan(q, k, v, log_g[0], s0[:, 0])
    y_b, s_b = _retention_scan(q[:, ::-1], k[:, ::-1], v[:, ::-1], log_g[1], s0[:, 1])
    y = _head_norm(y_f + y_b[:, ::-1]).reshape(B, L, RET_V_W)
    b = (jax.nn.silu(rg) * y) @ w_ret_out

    ga, gb = jnp.split(jax.nn.sigmoid(bg), 2, axis=-1)
    x = x + g1 * ((ga * a + gb * b) @ w_out)

    h2 = _rmsnorm(x, norm2_g) * (1.0 + sc2) + sh2
    x = x + g2 * (jnp.square(jax.nn.relu(h2 @ w_mlp1)) @ w_mlp2)
    return x, jnp.stack([s_f, s_b], axis=1)


def setup_inputs(seed: int = 0) -> dict:
    key = jax.random.key(seed)
    ks = jax.random.split(key, 24)
    f32 = jnp.float32

    def nrm(k, shape, scale):
        return jax.random.normal(k, shape, f32) * scale

    base_logit = jnp.log(2.0 ** (5.0 + jnp.arange(RET_HEADS, dtype=f32)) - 1.0)
    return {
        "x_prompt": nrm(ks[0], (BATCH, SEQ, D_MODEL), 1.0),
        "x_sample": nrm(ks[1], (DEC_BATCH, DEC_SEQ, D_MODEL), 1.0),
        "c": nrm(ks[2], (DEC_BATCH, D_MODEL), 1.0),
        "state_ret": nrm(ks[3], (DEC_BATCH, DEPTH, 2, RET_HEADS, RET_DK, RET_DV), 0.05),
        "c_ctx": nrm(ks[4], (D_MODEL,), 1.0),
        "norm1_g": 1.0 + nrm(ks[5], (DEPTH, D_MODEL), 0.02),
        "norm2_g": 1.0 + nrm(ks[6], (DEPTH, D_MODEL), 0.02),
        "w_mod": nrm(ks[7], (DEPTH, D_MODEL, 6 * D_MODEL), D_MODEL ** -0.5),
        "b_mod": nrm(ks[8], (DEPTH, 6 * D_MODEL), 0.02),
        "w_in": nrm(ks[9], (DEPTH, D_MODEL, PROJ_W), D_MODEL ** -0.5),
        "conv_dw": nrm(ks[10], (DEPTH, CONV_W, CONV_CH), CONV_W ** -0.5),
        "conv_b": nrm(ks[11], (DEPTH, CONV_CH), 0.02),
        "conv_norm_g": 1.0 + nrm(ks[12], (DEPTH, CONV_CH), 0.02),
        "w_conv_out": nrm(ks[13], (DEPTH, CONV_CH, D_MODEL), CONV_CH ** -0.5),
        "ret_decay_logit": base_logit[None, None, :] + nrm(ks[14], (DEPTH, 2, RET_HEADS), 0.1),
        "w_ret_out": nrm(ks[15], (DEPTH, RET_V_W, D_MODEL), RET_V_W ** -0.5),
        "w_out": nrm(ks[16], (DEPTH, D_MODEL, D_MODEL), D_MODEL ** -0.5),
        "w_mlp1": nrm(ks[17], (DEPTH, D_MODEL, MLP_W), D_MODEL ** -0.5),
        "w_mlp2": nrm(ks[18], (DEPTH, MLP_W, D_MODEL), MLP_W ** -0.5),
        "final_norm_g": 1.0 + nrm(ks[19], (D_MODEL,), 0.02),
    }


def reference(x_prompt, x_sample, c, state_ret, c_ctx, norm1_g, norm2_g, w_mod, b_mod, w_in,
              conv_dw, conv_b, conv_norm_g, w_conv_out, ret_decay_logit, w_ret_out, w_out,
              w_mlp1, w_mlp2, final_norm_g):
    xp = x_prompt
    xs = x_sample
    cond_ctx = jax.nn.silu(c_ctx)[None, :]
    cond_lat = jax.nn.silu(c)
    zero_state = jnp.zeros((xp.shape[0], 2, RET_HEADS, RET_DK, RET_DV), xp.dtype)
    new_states = []
    for l in range(DEPTH):
        lw = (norm1_g[l], norm2_g[l], w_in[l], conv_dw[l], conv_b[l], conv_norm_g[l], w_conv_out[l],
              ret_decay_logit[l], w_ret_out[l], w_out[l], w_mlp1[l], w_mlp2[l])
        mod_ctx = cond_ctx @ w_mod[l] + b_mod[l]
        xp, st = _layer(xp, mod_ctx, zero_state, False, *lw)
        new_states.append(st)
        mod_lat = cond_lat @ w_mod[l] + b_mod[l]
        xs, _ = _layer(xs, mod_lat, state_ret[:, l], True, *lw)
    new_state_ret = jnp.stack(new_states, axis=1)
    y_prompt = _rmsnorm(xp, final_norm_g)
    y_sample = _rmsnorm(xs, final_norm_g)
    return (y_prompt, y_sample, new_state_ret)
```

```cpp
#include <hip/hip_runtime.h>
#include <hip/hip_cooperative_groups.h>
namespace cg = cooperative_groups;

#define LAS __attribute__((address_space(3)))
typedef unsigned short bf16_t;
typedef short bf16x8 __attribute__((ext_vector_type(8)));
typedef float f32x4 __attribute__((ext_vector_type(4)));
typedef float f32x2 __attribute__((ext_vector_type(2)));
typedef unsigned u32x2 __attribute__((ext_vector_type(2)));
typedef unsigned u32x4 __attribute__((ext_vector_type(4)));

constexpr int DM = 1024, TC = 4096, TL = 16384, TT = 20480, PW = 10240, MLPW = 4096, VW = 2048;
constexpr int NTHR = 512;
constexpr float EPSV = 1e-6f;
constexpr size_t MiB = (size_t)1 << 20;
constexpr size_t WS_W = 0;
constexpr size_t WL_IN = 0, WL_CONV = 20 * MiB, WL_RET = 22 * MiB, WL_OUT = 26 * MiB, WL_M1 = 28 * MiB, WL_M2 = 36 * MiB, WL_SZ = 44 * MiB;
constexpr size_t WS_MOD = 88 * MiB;
constexpr size_t WS_ROPE = 88 * MiB + 512 * 1024;
constexpr size_t WS_R1 = 90 * MiB;
constexpr size_t WS_R2 = 130 * MiB;
constexpr size_t WS_Q = 170 * MiB;
constexpr size_t WS_K = 210 * MiB;
constexpr size_t WS_KT = 250 * MiB;
constexpr size_t WS_VT = 290 * MiB;
constexpr size_t WS_RG = 370 * MiB;
constexpr size_t WS_GATE = 450 * MiB;
constexpr size_t WS_YF = 530 * MiB;
constexpr size_t WS_YB = 610 * MiB;
constexpr size_t WS_BAR = 88 * MiB + 448 * 1024;
constexpr size_t WS_END = 690 * MiB;

struct Params { const float* in[20]; float* out; unsigned char* ws; };

typedef __bf16 bf16x2_t __attribute__((ext_vector_type(2)));
__device__ __forceinline__ unsigned cvt_pk_bf16(float lo, float hi) { const f32x2 f = {lo, hi}; const bf16x2_t v = __builtin_convertvector(f, bf16x2_t); return __builtin_bit_cast(unsigned, v); }
__device__ __forceinline__ float bf_lo(unsigned u) { return __uint_as_float(u << 16); }
__device__ __forceinline__ float bf_hi(unsigned u) { return __uint_as_float(u & 0xffff0000u); }
__device__ __forceinline__ float sigmoidf_(float x) { return __builtin_amdgcn_rcpf(1.f + __expf(-x)); }
__device__ __forceinline__ float siluf_(float x) { return x * sigmoidf_(x); }
__device__ __forceinline__ float wave_sum(float v) {
#pragma unroll
    for (int o = 32; o > 0; o >>= 1) v += __shfl_xor(v, o, 64);
    return v;
}
__device__ __forceinline__ int tid_opaque() { int t = threadIdx.x; asm volatile("" : "+v"(t)); return t; }
__device__ __forceinline__ int row_group(int row) { return row < TC ? 0 : 1 + ((row - TC) >> 11); }

namespace pg8 {
constexpr int BM = 256, BK = 64, HALF = 128, HTB = HALF * BK * 2, NXCD = 8, WGM = 8;
__device__ __forceinline__ int lds_byte(int r, int c) { const int st = (r >> 4) * 2 + (c >> 5), rr = r & 15, cc = c & 31, ob = rr * 64 + cc * 2; return st * 1024 + (ob ^ (((ob >> 9) & 1) << 5)); }
__device__ __forceinline__ void stage_rc(int b, int& R, int& C) { const int st = b / 1024, sb = b % 1024, swz = sb ^ (((sb >> 9) & 1) << 5); R = (st >> 1) * 16 + swz / 64; C = (st & 1) * 32 + (swz % 64) / 2; }
__device__ __forceinline__ int perm32(int rho) { const int n = rho >> 4, i = rho & 15; return 8 * (i >> 2) + 4 * n + (i & 3); }
struct Unit { int pm, pn; };
struct Gemm { const bf16_t* A; const bf16_t* Bt; int M, N, K; };
struct StaticOrder {
    int nM, nN, nwg, G, c;
    __device__ void init(int M, int N, int G_, int c_) { nM = M / BM; nN = N / BM; nwg = nM * nN; G = G_; c = c_; }
    __device__ bool next(int i, Unit& u) const {
        const long L = (long)i * G + c; if (L >= nwg) return false;
        int wgid = (int)L; { const int q = nwg / NXCD, r = nwg % NXCD, xcd = wgid % NXCD, off = wgid / NXCD; wgid = (xcd < r ? xcd * (q + 1) : r * (q + 1) + (xcd - r) * q) + off; }
        const int nig = WGM * nN, gid = wgid / nig, fm = gid * WGM, gsz = (nM - fm) < WGM ? (nM - fm) : WGM;
        u.pm = fm + ((wgid % nig) % gsz); u.pn = (wgid % nig) / gsz; return true;
    }
};

template <class Epi>
__device__ __forceinline__ void gemm_phase(LAS unsigned char* lds, const Gemm g, const StaticOrder& S, const Epi& E) {
    const int tid = tid_opaque(), wid = __builtin_amdgcn_readfirstlane(tid >> 6), lane = tid & 63, wr = wid >> 2, wc = wid & 3, fr = lane & 15, fq = lane >> 4;
    const int K = g.K, nt = K / BK;
    unsigned voffA[2], voffB[2];
#pragma unroll
    for (int i = 0; i < 2; ++i) { int R, C; stage_rc(tid * 16 + i * 8192, R, C); const int Rb = (R & ~31) + perm32(R & 31); voffA[i] = (unsigned)(R * K + C) * 2u; voffB[i] = (unsigned)(Rb * K + C) * 2u; }
    const size_t kstep = (size_t)(BK * 2);
    const size_t hstep = (size_t)HALF * K * 2;
    const size_t tstep = 2 * hstep;
    const unsigned ldsw = (unsigned)wid * 1024u;
    const int aoff = lds_byte(wr * 64 + fr, fq * 8), boff = lds_byte(wc * 32 + fr, fq * 8);
#define PG8_SA(b, h) (((b) * 2 + (h)) * HTB)
#define PG8_SB(b, h) ((4 + (b) * 2 + (h)) * HTB)
#define PG8_STAGE(bufoff, gbase, voff) do { _Pragma("unroll") for (int _i = 0; _i < 2; ++_i) \
        __builtin_amdgcn_global_load_lds((const unsigned*)((const char*)(gbase) + (voff)[_i]), (LAS unsigned*)(lds + (bufoff) + ldsw + _i * 8192), 16, 0, 0); } while (0)
#define PG8_LDA(dst, b, h) do { _Pragma("unroll") for (int m = 0; m < 4; ++m) _Pragma("unroll") for (int k = 0; k < 2; ++k) dst[m][k] = *(const LAS bf16x8*)(lds + PG8_SA(b, h) + aoff + m * 2048 + k * 1024); } while (0)
#define PG8_LDB(dst, b, h) do { _Pragma("unroll") for (int n = 0; n < 2; ++n) _Pragma("unroll") for (int k = 0; k < 2; ++k) dst[n][k] = *(const LAS bf16x8*)(lds + PG8_SB(b, h) + boff + n * 2048 + k * 1024); } while (0)
#define PG8_MMA(ai, bj, At, Bt) do { __builtin_amdgcn_s_setprio(1); _Pragma("unroll") for (int m = 0; m < 4; ++m) _Pragma("unroll") for (int n = 0; n < 2; ++n) _Pragma("unroll") for (int k = 0; k < 2; ++k) \
        acc[ai][bj][m][n] = __builtin_amdgcn_mfma_f32_16x16x32_bf16(Bt[n][k], At[m][k], acc[ai][bj][m][n], 0, 0, 0); __builtin_amdgcn_s_setprio(0); } while (0)
#define PG8_WAIT_V(n) asm volatile("s_waitcnt vmcnt(" #n ")" ::: "memory")
#define PG8_WAIT_L(n) asm volatile("s_waitcnt lgkmcnt(" #n ")" ::: "memory")
#define PG8_BAR __builtin_amdgcn_s_barrier()
#define PG8_SCHED __builtin_amdgcn_sched_barrier(0)
    Unit cur, nxt; int ui = 0;
    if (!S.next(0, cur)) return;
    f32x4 acc[2][2][4][2];
#pragma unroll
    for (int a = 0; a < 2; ++a)
#pragma unroll
        for (int b = 0; b < 2; ++b)
#pragma unroll
            for (int m = 0; m < 4; ++m)
#pragma unroll
                for (int n = 0; n < 2; ++n) acc[a][b][m][n] = (f32x4){0.f, 0.f, 0.f, 0.f};
    bf16x8 At[4][2], B0[2][2], B1[2][2];
    const char* cA = E.swapped(cur) ? (const char*)g.Bt + (size_t)cur.pn * tstep : (const char*)g.A + (size_t)cur.pm * tstep;
    const char* cB = E.swapped(cur) ? (const char*)g.A + (size_t)cur.pm * tstep : (const char*)g.Bt + (size_t)cur.pn * tstep;
    PG8_STAGE(PG8_SB(0, 0), cB, voffB); PG8_STAGE(PG8_SA(0, 0), cA, voffA); PG8_STAGE(PG8_SB(0, 1), cB + hstep, voffB); PG8_STAGE(PG8_SA(0, 1), cA + hstep, voffA);
    if (wr == 1) PG8_BAR;
    PG8_WAIT_V(4); PG8_BAR;
    PG8_STAGE(PG8_SB(1, 0), cB + kstep, voffB); PG8_STAGE(PG8_SA(1, 0), cA + kstep, voffA); PG8_STAGE(PG8_SB(1, 1), cB + hstep + kstep, voffB);
    PG8_WAIT_V(6); PG8_BAR;
    for (;;) {
        const bool has_next = S.next(ui + 1, nxt);
        const bool nsw = has_next && E.swapped(nxt);
        const char* nA = has_next ? (nsw ? (const char*)g.Bt + (size_t)nxt.pn * tstep : (const char*)g.A + (size_t)nxt.pm * tstep) : cA;
        const char* nB = has_next ? (nsw ? (const char*)g.A + (size_t)nxt.pm * tstep : (const char*)g.Bt + (size_t)nxt.pn * tstep) : cB;
        for (int t = 0; t < nt; t += 2) {
            const bool last = (t == nt - 2);
            const char* a1 = cA + (size_t)(t + 1) * kstep;
            const char* a2 = last ? nA : cA + (size_t)(t + 2) * kstep; const char* b2 = last ? nB : cB + (size_t)(t + 2) * kstep;
            const char* a3 = a2 + kstep; const char* b3 = b2 + kstep;
            PG8_LDB(B0, 0, 0); PG8_SCHED; PG8_LDA(At, 0, 0); PG8_STAGE(PG8_SA(1, 1), a1 + hstep, voffA);
            PG8_WAIT_L(8); PG8_BAR; PG8_WAIT_L(0); PG8_MMA(0, 0, At, B0); PG8_BAR; PG8_SCHED;
            PG8_LDB(B1, 0, 1); PG8_STAGE(PG8_SB(0, 0), b2, voffB);
            PG8_BAR; PG8_WAIT_L(0); PG8_MMA(0, 1, At, B1); PG8_BAR;
            PG8_LDA(At, 0, 1); PG8_STAGE(PG8_SA(0, 0), a2, voffA);
            PG8_BAR; PG8_WAIT_L(0); PG8_MMA(1, 0, At, B0); PG8_BAR; PG8_SCHED;
            PG8_STAGE(PG8_SB(0, 1), b2 + hstep, voffB);
            PG8_WAIT_V(6); PG8_BAR; PG8_MMA(1, 1, At, B1); PG8_BAR;
            PG8_LDB(B0, 1, 0); PG8_SCHED; PG8_LDA(At, 1, 0); PG8_STAGE(PG8_SA(0, 1), a2 + hstep, voffA);
            PG8_WAIT_L(8); PG8_BAR; PG8_WAIT_L(0); PG8_MMA(0, 0, At, B0); PG8_BAR; PG8_SCHED;
            PG8_LDB(B1, 1, 1); PG8_STAGE(PG8_SB(1, 0), b3, voffB);
            PG8_BAR; PG8_WAIT_L(0); PG8_MMA(0, 1, At, B1); PG8_BAR;
            PG8_LDA(At, 1, 1); PG8_STAGE(PG8_SA(1, 0), a3, voffA);
            PG8_BAR; PG8_WAIT_L(0); PG8_MMA(1, 0, At, B0); PG8_BAR; PG8_SCHED;
            PG8_STAGE(PG8_SB(1, 1), b3 + hstep, voffB);
            PG8_WAIT_V(6); PG8_BAR; PG8_MMA(1, 1, At, B1); PG8_BAR;
        }
        E(acc, cur, wr, wc, fr, fq);
        if (!has_next) break;
#pragma unroll
        for (int a = 0; a < 2; ++a)
#pragma unroll
            for (int b = 0; b < 2; ++b)
#pragma unroll
                for (int m = 0; m < 4; ++m)
#pragma unroll
                    for (int n = 0; n < 2; ++n) acc[a][b][m][n] = (f32x4){0.f, 0.f, 0.f, 0.f};
        cur = nxt; cA = nA; cB = nB; ++ui;
    }
    PG8_WAIT_V(0);
    if (wr == 0) PG8_BAR;
    PG8_BAR;
#undef PG8_SA
#undef PG8_SB
#undef PG8_STAGE
#undef PG8_LDA
#undef PG8_LDB
#undef PG8_MMA
#undef PG8_WAIT_V
#undef PG8_WAIT_L
#undef PG8_BAR
#undef PG8_SCHED
}
}
using pg8::Unit;
typedef const f32x4 (&AccRef)[2][2][4][2];

__device__ __forceinline__ void st_bf16x4(bf16_t* p, f32x4 v) { u32x2 w; w.x = cvt_pk_bf16(v[0], v[1]); w.y = cvt_pk_bf16(v[2], v[3]); *(u32x2*)p = w; }
__device__ __forceinline__ void st_bf16x8(bf16_t* p, f32x4 a, f32x4 b) { u32x4 w; w.x = cvt_pk_bf16(a[0], a[1]); w.y = cvt_pk_bf16(a[2], a[3]); w.z = cvt_pk_bf16(b[0], b[1]); w.w = cvt_pk_bf16(b[2], b[3]); *(u32x4*)p = w; }
__device__ __forceinline__ bf16_t bf16_1(float v) { return (bf16_t)(cvt_pk_bf16(v, 0.f) & 0xffffu); }

struct EpiG1 {
    __device__ __forceinline__ bool swapped(const Unit& u) const { return u.pn >= 16 && u.pn < 24; }
    bf16_t *aglu, *q, *k, *kt, *vt, *rg, *gate; const float *rcos, *rsin;
    __device__ __forceinline__ void operator()(AccRef acc, const Unit& u, int wr, int wc, int fr, int fq) const {
        const int pn = u.pn, row0 = u.pm * 256 + wr * 64 + fr, ct = wc * 32 + 8 * fq;
        if (pn < 8) {
#pragma unroll
            for (int ai = 0; ai < 2; ++ai)
#pragma unroll
                for (int m = 0; m < 4; ++m) { const int row = row0 + ai * 128 + m * 16; f32x4 o[2];
#pragma unroll
                    for (int n = 0; n < 2; ++n) { const f32x4 a = acc[ai][0][m][n], b = acc[ai][1][m][n];
#pragma unroll
                        for (int r = 0; r < 4; ++r) o[n][r] = a[r] * sigmoidf_(b[r]); }
                    st_bf16x8(aglu + (size_t)row * DM + pn * 128 + ct, o[0], o[1]); }
        } else if (pn < 16) {
            const bool isK = pn >= 12; const int h = (pn - 8) & 3; const float sc = isK ? 0.0625f : 1.0f; bf16_t* dst = isK ? k : q;
#pragma unroll
            for (int ai = 0; ai < 2; ++ai)
#pragma unroll
                for (int m = 0; m < 4; ++m) { const int row = row0 + ai * 128 + m * 16; const bool lat = row >= TC; const int pos = (row - TC) & 2047, gr = pos >> 6, gc = pos & 63; f32x4 o1[2], o2[2];
#pragma unroll
                    for (int n = 0; n < 2; ++n) { const int d1 = ct + n * 4; const f32x4 x1 = acc[ai][0][m][n] * sc, x2 = acc[ai][1][m][n] * sc; o1[n] = x1; o2[n] = x2;
                        if (lat) { const int ti = (d1 < 64) ? gr * 64 + d1 : gc * 64 + d1 - 64; const f32x4 cs = *(const f32x4*)(rcos + ti), sn = *(const f32x4*)(rsin + ti);
                            o1[n] = x1 * cs - x2 * sn; o2[n] = x2 * cs + x1 * sn; }
                        if (isK) {
#pragma unroll
                            for (int r = 0; r < 4; ++r) { kt[(size_t)(h * 256 + d1 + r) * TT + row] = bf16_1(o1[n][r]); kt[(size_t)(h * 256 + 128 + d1 + r) * TT + row] = bf16_1(o2[n][r]); } } }
                    st_bf16x8(dst + (size_t)row * DM + h * 256 + ct, o1[0], o1[1]); st_bf16x8(dst + (size_t)row * DM + h * 256 + 128 + ct, o2[0], o2[1]); }
        } else if (pn < 24) {
            const int e0 = (pn - 16) * 256 + wr * 64 + fr, t0 = u.pm * 256 + ct;
#pragma unroll
            for (int ai = 0; ai < 2; ++ai)
#pragma unroll
                for (int m = 0; m < 4; ++m) { bf16_t* vr = vt + (size_t)(e0 + ai * 128 + m * 16) * TT + t0;
#pragma unroll
                    for (int bj = 0; bj < 2; ++bj) st_bf16x8(vr + bj * 128, acc[ai][bj][m][0], acc[ai][bj][m][1]); }
        } else {
            const bool isG = pn >= 32; bf16_t* dst = isG ? gate : rg; const int cb = ((pn - 24) & 7) * 256;
#pragma unroll
            for (int ai = 0; ai < 2; ++ai)
#pragma unroll
                for (int m = 0; m < 4; ++m) { const int row = row0 + ai * 128 + m * 16;
#pragma unroll
                    for (int bj = 0; bj < 2; ++bj) { f32x4 o[2];
#pragma unroll
                        for (int n = 0; n < 2; ++n) { const f32x4 v = acc[ai][bj][m][n];
#pragma unroll
                            for (int r = 0; r < 4; ++r) { const float s = sigmoidf_(v[r]); o[n][r] = isG ? s : v[r] * s; } }
                        st_bf16x8(dst + (size_t)row * VW + cb + bj * 128 + ct, o[0], o[1]); } }
        }
    }
};

struct EpiE1 {
    __device__ __forceinline__ bool swapped(const Unit&) const { return false; }
    bf16_t* m1; const bf16_t* gate;
    __device__ __forceinline__ void operator()(AccRef acc, const Unit& u, int wr, int wc, int fr, int fq) const {
        const int row0 = u.pm * 256 + wr * 64 + fr, col0 = u.pn * 256 + wc * 32 + 8 * fq;
#pragma unroll
        for (int ai = 0; ai < 2; ++ai)
#pragma unroll
            for (int m = 0; m < 4; ++m) { const int row = row0 + ai * 128 + m * 16;
#pragma unroll
                for (int bj = 0; bj < 2; ++bj) { const int col = col0 + bj * 128; const u32x4 gv = *(const u32x4*)(gate + (size_t)row * VW + col); const f32x4 v0 = acc[ai][bj][m][0], v1 = acc[ai][bj][m][1];
                    f32x4 o0, o1; o0[0] = v0[0] * bf_lo(gv.x); o0[1] = v0[1] * bf_hi(gv.x); o0[2] = v0[2] * bf_lo(gv.y); o0[3] = v0[3] * bf_hi(gv.y);
                    o1[0] = v1[0] * bf_lo(gv.z); o1[1] = v1[1] * bf_hi(gv.z); o1[2] = v1[2] * bf_lo(gv.w); o1[3] = v1[3] * bf_hi(gv.w);
                    st_bf16x8(m1 + (size_t)row * DM + col, o0, o1); } }
    }
};
struct EpiE2 {
    __device__ __forceinline__ bool swapped(const Unit&) const { return false; }
    const bf16_t* m1; const bf16_t* gate; bf16_t* mm;
    __device__ __forceinline__ void operator()(AccRef acc, const Unit& u, int wr, int wc, int fr, int fq) const {
        const int row0 = u.pm * 256 + wr * 64 + fr, col0 = u.pn * 256 + wc * 32 + 8 * fq;
#pragma unroll
        for (int ai = 0; ai < 2; ++ai)
#pragma unroll
            for (int m = 0; m < 4; ++m) { const int row = row0 + ai * 128 + m * 16;
#pragma unroll
                for (int bj = 0; bj < 2; ++bj) { const int col = col0 + bj * 128; const u32x4 gv = *(const u32x4*)(gate + (size_t)row * VW + DM + col), mv = *(const u32x4*)(m1 + (size_t)row * DM + col); const f32x4 v0 = acc[ai][bj][m][0], v1 = acc[ai][bj][m][1];
                    f32x4 o0, o1; o0[0] = bf_lo(mv.x) + v0[0] * bf_lo(gv.x); o0[1] = bf_hi(mv.x) + v0[1] * bf_hi(gv.x); o0[2] = bf_lo(mv.y) + v0[2] * bf_lo(gv.y); o0[3] = bf_hi(mv.y) + v0[3] * bf_hi(gv.y);
                    o1[0] = bf_lo(mv.z) + v1[0] * bf_lo(gv.z); o1[1] = bf_hi(mv.z) + v1[1] * bf_hi(gv.z); o1[2] = bf_lo(mv.w) + v1[2] * bf_lo(gv.w); o1[3] = bf_hi(mv.w) + v1[3] * bf_hi(gv.w);
                    st_bf16x8(mm + (size_t)row * DM + col, o0, o1); } }
    }
};
struct EpiRes {
    __device__ __forceinline__ bool swapped(const Unit&) const { return false; }
    const float *xa, *xb; float* xout; const float* gvec;
    __device__ __forceinline__ void operator()(AccRef acc, const Unit& u, int wr, int wc, int fr, int fq) const {
        const int row0 = u.pm * 256 + wr * 64 + fr, col0 = u.pn * 256 + wc * 32 + 8 * fq;
#pragma unroll
        for (int ai = 0; ai < 2; ++ai)
#pragma unroll
            for (int m = 0; m < 4; ++m) { const int row = row0 + ai * 128 + m * 16; const float* xr = row < TC ? xa + (size_t)row * DM : xb + (size_t)(row - TC) * DM; const float* gr = gvec + row_group(row) * 6144;
#pragma unroll
                for (int bj = 0; bj < 2; ++bj)
#pragma unroll
                    for (int n = 0; n < 2; ++n) { const int col = col0 + bj * 128 + n * 4; const f32x4 xv = *(const f32x4*)(xr + col), gv = *(const f32x4*)(gr + col);
                        *(f32x4*)(xout + (size_t)row * DM + col) = xv + gv * acc[ai][bj][m][n]; } }
    }
};
struct EpiF1 {
    __device__ __forceinline__ bool swapped(const Unit&) const { return false; }
    bf16_t* uo;
    __device__ __forceinline__ void operator()(AccRef acc, const Unit& u, int wr, int wc, int fr, int fq) const {
        const int row0 = u.pm * 256 + wr * 64 + fr, col0 = u.pn * 256 + wc * 32 + 8 * fq;
#pragma unroll
        for (int ai = 0; ai < 2; ++ai)
#pragma unroll
            for (int m = 0; m < 4; ++m) { const int row = row0 + ai * 128 + m * 16;
#pragma unroll
                for (int bj = 0; bj < 2; ++bj) { f32x4 o[2];
#pragma unroll
                    for (int n = 0; n < 2; ++n) { const f32x4 v = acc[ai][bj][m][n];
#pragma unroll
                        for (int r = 0; r < 4; ++r) { const float t = fmaxf(v[r], 0.f); o[n][r] = t * t; } }
                    st_bf16x8(uo + (size_t)row * MLPW + col0 + bj * 128, o[0], o[1]); } }
    }
};

__device__ __forceinline__ void tconv_item(const float* __restrict__ src, bf16_t* __restrict__ dst, int K, int N, int item, bool permIn, float* tile  ) {
    const int tilesN = N >> 8, kt = item / tilesN, ntile = item - kt * tilesN, k0 = kt * 64, n0 = ntile * 256, tid = tid_opaque();
    { const int r = tid >> 6, c4 = (tid & 63) * 4; f32x4 v[8];
#pragma unroll
      for (int rr = 0; rr < 8; ++rr) v[rr] = __builtin_nontemporal_load((const f32x4*)(src + (size_t)(k0 + r + rr * 8) * N + n0 + c4));
#pragma unroll
      for (int rr = 0; rr < 8; ++rr) { float* t = tile + (r + rr * 8) * 257 + c4; t[0] = v[rr][0]; t[1] = v[rr][1]; t[2] = v[rr][2]; t[3] = v[rr][3]; } }
    __syncthreads();
#pragma unroll
    for (int q = 0; q < 4; ++q) { const int n = q * 64 + (tid >> 3), k8 = (tid & 7) * 8; float v[8];
#pragma unroll
      for (int e = 0; e < 8; ++e) v[e] = tile[(k8 + e) * 257 + n];
      int nn = n0 + n;
      if (permIn && nn < 2048) { const int c = nn & 1023, half = nn >> 10; nn = (c >> 7) * 256 + half * 128 + (c & 127); }
      u32x4 w; w.x = cvt_pk_bf16(v[0], v[1]); w.y = cvt_pk_bf16(v[2], v[3]); w.z = cvt_pk_bf16(v[4], v[5]); w.w = cvt_pk_bf16(v[6], v[7]);
      *(u32x4*)(dst + (size_t)nn * K + k0 + k8) = w; }
    __syncthreads();
}

__device__ void phase0(const Params& p, unsigned char* smem) {
    float* tile = (float*)smem;
    float* scond = (float*)(smem + 66048);
    float* red = (float*)(smem + 66048 + 36864);
    const int tid = tid_opaque();
    constexpr int NT_L = 1408, NT = 2 * NT_L, NMOD = 192;
    for (int it = blockIdx.x; it < NT + NMOD + 1; it += gridDim.x) {
        if (it < NT) {
            const int l = it / NT_L; int j = it - l * NT_L; unsigned char* wb = p.ws + WS_W + (size_t)l * WL_SZ;
            if (j < 640) tconv_item(p.in[9] + (size_t)l * DM * PW, (bf16_t*)(wb + WL_IN), DM, PW, j, true, tile);
            else if ((j -= 640) < 64) tconv_item(p.in[13] + (size_t)l * DM * DM, (bf16_t*)(wb + WL_CONV), DM, DM, j, false, tile);
            else if ((j -= 64) < 128) tconv_item(p.in[15] + (size_t)l * VW * DM, (bf16_t*)(wb + WL_RET), VW, DM, j, false, tile);
            else if ((j -= 128) < 64) tconv_item(p.in[16] + (size_t)l * DM * DM, (bf16_t*)(wb + WL_OUT), DM, DM, j, false, tile);
            else if ((j -= 64) < 256) tconv_item(p.in[17] + (size_t)l * DM * MLPW, (bf16_t*)(wb + WL_M1), DM, MLPW, j, false, tile);
            else { j -= 256; tconv_item(p.in[18] + (size_t)l * MLPW * DM, (bf16_t*)(wb + WL_M2), MLPW, DM, j, false, tile); }
        } else if (it < NT + NMOD) {
            const int j = it - NT, l = j / 96, c0 = (j % 96) * 64;
            for (int idx = tid; idx < 9 * 1024; idx += NTHR) { const int g = idx >> 10, k = idx & 1023; const float v = g == 0 ? p.in[4][k] : p.in[2][(g - 1) * 1024 + k]; scond[idx] = siluf_(v); }
            __syncthreads();
            const int col = tid & 63, kg = tid >> 6; float a[9];
#pragma unroll
            for (int g = 0; g < 9; ++g) a[g] = 0.f;
            const float* wm = p.in[7] + (size_t)l * DM * 6144 + c0 + col;
#pragma unroll 16
            for (int k = kg * 128; k < kg * 128 + 128; ++k) { const float w = __builtin_nontemporal_load(wm + (size_t)k * 6144);
#pragma unroll
                for (int g = 0; g < 9; ++g) a[g] += scond[g * 1024 + k] * w; }
#pragma unroll
            for (int g = 0; g < 9; ++g) red[(kg * 9 + g) * 64 + col] = a[g];
            __syncthreads();
            for (int o = tid; o < 9 * 64; o += NTHR) { const int g = o >> 6, cc = o & 63; float s = 0.f;
#pragma unroll
                for (int q = 0; q < 8; ++q) s += red[(q * 9 + g) * 64 + cc];
                ((float*)(p.ws + WS_MOD))[(size_t)(l * 9 + g) * 6144 + c0 + cc] = s + p.in[8][l * 6144 + c0 + cc]; }
            __syncthreads();
        } else {
            float* rc = (float*)(p.ws + WS_ROPE); float* rs = rc + 4096;
            for (int idx = tid; idx < 4096; idx += NTHR) { const int pos = idx >> 6, i = idx & 63; const float inv = exp2f(-(float)i * (13.287712379549449f / 64.f)); const float ang = (float)pos * inv;
                rc[idx] = __cosf(ang); rs[idx] = __sinf(ang); }
        }
    }
}

__device__ void norm_mod_phase(const float* xa, const float* xb, bf16_t* dst, const float* ng, const float* modl, int sh_chunk) {
    const int tid = tid_opaque(), lane = tid & 63, gw = blockIdx.x * 8 + (tid >> 6), nw = gridDim.x * 8;
    for (int row0 = gw; row0 < TT; row0 += 2 * nw) {
        f32x4 v[2][4]; float ss[2];
#pragma unroll
        for (int q = 0; q < 2; ++q) { const int row = min(row0 + q * nw, TT - 1); const float* xr = row < TC ? xa + (size_t)row * DM : xb + (size_t)(row - TC) * DM;
#pragma unroll
            for (int i = 0; i < 4; ++i) v[q][i] = __builtin_nontemporal_load((const f32x4*)(xr + i * 256 + lane * 4)); }
#pragma unroll
        for (int q = 0; q < 2; ++q) { float s = 0.f;
#pragma unroll
            for (int i = 0; i < 4; ++i) s += v[q][i][0] * v[q][i][0] + v[q][i][1] * v[q][i][1] + v[q][i][2] * v[q][i][2] + v[q][i][3] * v[q][i][3];
            ss[q] = s; }
#pragma unroll
        for (int q = 0; q < 2; ++q) { const int row = row0 + q * nw; if (row >= TT) break;
            const float rstd = rsqrtf(wave_sum(ss[q]) * (1.f / DM) + EPSV); const float* md = modl + row_group(row) * 6144;
#pragma unroll
            for (int i = 0; i < 4; ++i) { const int c = i * 256 + lane * 4; const f32x4 g = *(const f32x4*)(ng + c), sh = *(const f32x4*)(md + sh_chunk * 1024 + c), sc = *(const f32x4*)(md + (sh_chunk + 1) * 1024 + c);
                const f32x4 o = v[q][i] * rstd * g * (sc + 1.f) + sh; st_bf16x4(dst + (size_t)row * DM + c, o); } }
    }
}
__device__ void final_norm_phase(float* x, const float* ng) {
    const int tid = tid_opaque(), lane = tid & 63, gw = blockIdx.x * 8 + (tid >> 6), nw = gridDim.x * 8;
    for (int row = gw; row < TT; row += nw) {
        float* xr = x + (size_t)row * DM; f32x4 v[4]; float ss = 0.f;
#pragma unroll
        for (int i = 0; i < 4; ++i) { v[i] = __builtin_nontemporal_load((const f32x4*)(xr + i * 256 + lane * 4)); ss += v[i][0] * v[i][0] + v[i][1] * v[i][1] + v[i][2] * v[i][2] + v[i][3] * v[i][3]; }
        ss = wave_sum(ss); const float rstd = rsqrtf(ss * (1.f / DM) + EPSV);
#pragma unroll
        for (int i = 0; i < 4; ++i) { const int c = i * 256 + lane * 4; const f32x4 g = *(const f32x4*)(ng + c); __builtin_nontemporal_store(v[i] * rstd * g, (f32x4*)(xr + c)); }
    }
}

__device__ void conv_phase(const Params& p, int l, unsigned char* smem) {
    const int tid = tid_opaque(), lane = tid & 63, wv = tid >> 6;
    const bf16_t* aglu = (const bf16_t*)(p.ws + WS_R2); bf16_t* aconv = (bf16_t*)(p.ws + WS_R1);
    float* red = (float*)(smem + 46 * 2048);
    float* rst = red + 128;
    const int c0 = 2 * tid;
    float w0[31], w1[31];
#pragma unroll
    for (int j = 0; j < 31; ++j) { const f32x2 wv2 = *(const f32x2*)(p.in[10] + (size_t)(l * 31 + j) * DM + c0); w0[j] = wv2.x; w1[j] = wv2.y; }
    const f32x2 bias = *(const f32x2*)(p.in[11] + l * DM + c0), gn = *(const f32x2*)(p.in[12] + l * DM + c0);
    for (int it = blockIdx.x; it < TT / 16; it += gridDim.x) {
        const int t0 = it * 16, segl = t0 < TC ? 256 : 64, ss = t0 & ~(segl - 1), se = ss + segl;
        for (int idx = tid; idx < 46 * 128; idx += NTHR) { const int rr = idx >> 7, ch = idx & 127, tt = t0 - 15 + rr; u32x4 v = (u32x4){0u, 0u, 0u, 0u};
            if (tt >= ss && tt < se) v = *(const u32x4*)(aglu + (size_t)tt * DM + ch * 8);
            *(u32x4*)(smem + rr * 2048 + ch * 16) = v; }
        __syncthreads();
        float a0[16], a1[16];
#pragma unroll
        for (int t = 0; t < 16; ++t) { a0[t] = bias.x; a1[t] = bias.y; }
#pragma unroll
        for (int rr = 0; rr < 46; ++rr) { const unsigned uv = *(const unsigned*)(smem + rr * 2048 + c0 * 2); const float lo = bf_lo(uv), hi = bf_hi(uv);
#pragma unroll
            for (int t = 0; t < 16; ++t) { const int j = rr - t; if (j >= 0 && j < 31) { a0[t] += w0[j] * lo; a1[t] += w1[j] * hi; } } }
#pragma unroll
        for (int t = 0; t < 16; ++t) { const float s = wave_sum(a0[t] * a0[t] + a1[t] * a1[t]); if (lane == 0) red[wv * 16 + t] = s; }
        __syncthreads();
        if (tid < 16) { float s = 0.f;
#pragma unroll
            for (int q = 0; q < 8; ++q) s += red[q * 16 + tid];
            rst[tid] = rsqrtf(s * (1.f / DM) + EPSV); }
        __syncthreads();
#pragma unroll
        for (int t = 0; t < 16; ++t) { const float r = rst[t]; *(unsigned*)(aconv + (size_t)(t0 + t) * DM + c0) = cvt_pk_bf16(siluf_(a0[t] * r * gn.x), siluf_(a1[t] * r * gn.y)); }
        __syncthreads();
    }
}

__device__ void ret_phase(const Params& p, int l, unsigned char* smem) {
    LAS unsigned char* lds = (LAS unsigned char*)smem;
    const int tid = tid_opaque(), lane = tid & 63, w = __builtin_amdgcn_readfirstlane(tid >> 6), fr = lane & 15, fq = lane >> 4;
    const bf16_t* Qg = (const bf16_t*)(p.ws + WS_Q); const bf16_t* Kg = (const bf16_t*)(p.ws + WS_K); const bf16_t* KTg = (const bf16_t*)(p.ws + WS_KT); const bf16_t* VTg = (const bf16_t*)(p.ws + WS_VT);
    constexpr int QOFF = 0, KTOFF = 65536;
    const unsigned voffQ = (unsigned)(((2 * w + (lane >> 5)) * DM + (((lane & 31) ^ ((2 * w + (lane >> 5)) & 15))) * 8) * 2);
    const unsigned voffKT = (unsigned)(((4 * w + (lane >> 4)) * TT + (((lane & 15) ^ ((((2 * w + (lane >> 5)) & 12)) | ((lane >> 4) & 3)))) * 8) * 2);
    const unsigned voffK = (unsigned)(((16 * w + fr) * DM + fq * 8) * 2);
    const unsigned voffV = (unsigned)(((16 * w + fr) * TT + fq * 8) * 2);
    const unsigned voffY = (unsigned)(((4 * fq) * VW + 16 * w + fr) * 2);
    int xb[4];
#pragma unroll
    for (int k4 = 0; k4 < 4; ++k4) xb[k4] = ((k4 * 4 + fq) ^ fr) * 16;
    for (int it = blockIdx.x; it < 768; it += gridDim.x) {
        int es, dir, h, bb, tok0, nch; const bool lat = it < 256;
        { const int j = lat ? it : it - 256, x = j & 7, y = j >> 3; es = y & 3; const int cmb = (y >> 2) * 8 + x; dir = cmb & 1; h = (cmb >> 1) & 3; bb = cmb >> 3;
          tok0 = lat ? TC + bb * 2048 : bb * 256; nch = lat ? 16 : 2; }
        const float dl = p.in[14][l * 8 + dir * 4 + h]; const float lg2 = -log1pf(expf(-dl)) * 1.4426950408889634f;
        const float sdec = exp2f(128.f * lg2);
        const float zl = dir ? -lg2 : lg2, zb2 = (float)(dir ? 128 - 4 * fq : 4 * fq + 1) * lg2, kb2 = (float)(dir ? 8 * fq : 127 - 8 * fq) * lg2;
        const int pbase = dir ? (16 * w + 4 * fq - fr) : (fr - 16 * w - 4 * fq);
        f32x4 S[16];
        const unsigned voffS = (unsigned)((8 * fq * 512 + 16 * w + fr) * 4);
        if (lat) { const float* sp = p.in[3] + ((((size_t)bb * 2 + l) * 2 + dir) * 4 + h) * 256 * 512 + es * 128;
#pragma unroll
            for (int D = 0; D < 16; ++D)
#pragma unroll
                for (int r = 0; r < 4; ++r) S[D][r] = __builtin_nontemporal_load((const float*)((const char*)(sp + ((D >> 1) * 32 + 4 * (D & 1) + r) * 512) + voffS));
        } else {
#pragma unroll
            for (int D = 0; D < 16; ++D) S[D] = (f32x4){0.f, 0.f, 0.f, 0.f};
        }
        bf16_t* Yg = (bf16_t*)(p.ws + (dir ? WS_YB : WS_YF));
        for (int s = 0; s < nch; ++s) {
            const int c = dir ? nch - 1 - s : s, r0 = tok0 + c * 128;
            { const bf16_t* qu = Qg + (size_t)r0 * DM + h * 256; const bf16_t* ku = KTg + (size_t)(h * 256) * TT + r0;
#pragma unroll
              for (int n = 0; n < 8; ++n) {
                  if (n < 4 || s == 0)
                      __builtin_amdgcn_global_load_lds((const unsigned*)((const char*)(qu + (size_t)(n * 16) * DM) + voffQ), (LAS unsigned*)(lds + QOFF + (n * 8 + w) * 1024), 16, 0, 0);
                  __builtin_amdgcn_global_load_lds((const unsigned*)((const char*)(ku + (size_t)(n * 32) * TT) + voffKT), (LAS unsigned*)(lds + KTOFF + (n * 8 + w) * 1024), 16, 0, 0); } }
            bf16x8 Kf[8], Vf[4];
            { const char* kb = (const char*)(Kg + (size_t)r0 * DM + h * 256) + voffK;
#pragma unroll
              for (int ks = 0; ks < 4; ++ks) Kf[ks] = *(const bf16x8*)(kb + ks * 64); }
            asm volatile("s_waitcnt vmcnt(0)" ::: "memory");
            __syncthreads();
            { const char* kb = (const char*)(Kg + (size_t)r0 * DM + h * 256) + voffK;
#pragma unroll
              for (int ks = 4; ks < 8; ++ks) Kf[ks] = *(const bf16x8*)(kb + ks * 64); }
            f32x4 Z[8], PT[8];
#pragma unroll
            for (int i8 = 0; i8 < 8; ++i8) { Z[i8] = (f32x4){0.f, 0.f, 0.f, 0.f}; PT[i8] = (f32x4){0.f, 0.f, 0.f, 0.f}; }
#define QFRAG(ks, i8) (*(const LAS bf16x8*)(lds + QOFF + xb[(ks) & 3] + fr * 512 + (i8) * 8192 + ((ks) >> 2) * 256))
            { bf16x8 qa[4], qb[4];
#pragma unroll
              for (int j = 0; j < 4; ++j) qa[j] = QFRAG(0, j);
#pragma unroll
              for (int ks = 0; ks < 8; ++ks) { u32x4 t; t.x = cvt_pk_bf16(S[2 * ks][0], S[2 * ks][1]); t.y = cvt_pk_bf16(S[2 * ks][2], S[2 * ks][3]); t.z = cvt_pk_bf16(S[2 * ks + 1][0], S[2 * ks + 1][1]); t.w = cvt_pk_bf16(S[2 * ks + 1][2], S[2 * ks + 1][3]);
                  const bf16x8 Sb = __builtin_bit_cast(bf16x8, t);
#pragma unroll
                  for (int j = 0; j < 4; ++j) qb[j] = QFRAG(ks, 4 + j);
                  __builtin_amdgcn_sched_barrier(0);
#pragma unroll
                  for (int j = 0; j < 4; ++j) { Z[j] = __builtin_amdgcn_mfma_f32_16x16x32_bf16(qa[j], Sb, Z[j], 0, 0, 0); PT[j] = __builtin_amdgcn_mfma_f32_16x16x32_bf16(Kf[ks], qa[j], PT[j], 0, 0, 0); }
                  __builtin_amdgcn_sched_barrier(0);
                  if (ks < 7) {
#pragma unroll
                      for (int j = 0; j < 4; ++j) qa[j] = QFRAG(ks + 1, j); }
                  __builtin_amdgcn_sched_barrier(0);
#pragma unroll
                  for (int j = 0; j < 4; ++j) { Z[4 + j] = __builtin_amdgcn_mfma_f32_16x16x32_bf16(qb[j], Sb, Z[4 + j], 0, 0, 0); PT[4 + j] = __builtin_amdgcn_mfma_f32_16x16x32_bf16(Kf[ks], qb[j], PT[4 + j], 0, 0, 0); }
                  __builtin_amdgcn_sched_barrier(0); } }
#undef QFRAG
            { const char* vb = (const char*)(VTg + (size_t)(h * 512 + es * 128) * TT + r0) + voffV;
#pragma unroll
              for (int ks = 0; ks < 4; ++ks) Vf[ks] = *(const bf16x8*)(vb + ks * 64); }
            float zb2_ = zb2, zl_ = zl, kb2_ = kb2; int pbase_ = pbase;
            asm volatile("" : "+v"(zb2_), "+v"(zl_), "+v"(kb2_), "+v"(pbase_));
            { f32x4 zf, pf; const float z16 = __builtin_amdgcn_exp2f(16.f * zl_);
#pragma unroll
              for (int r = 0; r < 4; ++r) { zf[r] = __builtin_amdgcn_exp2f(zb2_ + (float)r * zl_); pf[r] = __builtin_amdgcn_exp2f((float)(pbase_ + (dir ? r : -r)) * lg2); }
#pragma unroll
              for (int i8 = 0; i8 < 8; ++i8) {
#pragma unroll
                  for (int r = 0; r < 4; ++r) { Z[i8][r] *= zf[r];
                      const int df = pbase_ + (dir ? -(i8 * 16 - r) : (i8 * 16 - r)); PT[i8][r] = df >= 0 ? PT[i8][r] * pf[r] : 0.f; }
                  zf *= z16; pf *= z16; } }
            __syncthreads();
#pragma unroll
            for (int i8 = 0; i8 < 8; ++i8) { const int i = i8 * 16 + fr; u32x2 t; t.x = cvt_pk_bf16(PT[i8][0], PT[i8][1]); t.y = cvt_pk_bf16(PT[i8][2], PT[i8][3]);
                *(LAS u32x2*)(lds + QOFF + i * 256 + (((2 * w + (fq >> 1)) ^ fr)) * 16 + (fq & 1) * 8) = t; }
            __syncthreads();
#define PFRAG(i8, ks) (*(const LAS bf16x8*)(lds + QOFF + xb[ks] + fr * 256 + (i8) * 4096))
            { bf16x8 pa[4], pb[4];
#pragma unroll
              for (int ks = 0; ks < 4; ++ks) pa[ks] = PFRAG(0, ks);
#pragma unroll
              for (int i8 = 0; i8 < 8; i8 += 2) {
#pragma unroll
                  for (int ks = 0; ks < 4; ++ks) pb[ks] = PFRAG(i8 + 1, ks);
                  __builtin_amdgcn_sched_barrier(0);
#pragma unroll
                  for (int ks = 0; ks < 4; ++ks) Z[i8] = __builtin_amdgcn_mfma_f32_16x16x32_bf16(pa[ks], Vf[ks], Z[i8], 0, 0, 0);
                  __builtin_amdgcn_sched_barrier(0);
                  if (i8 < 6) {
#pragma unroll
                      for (int ks = 0; ks < 4; ++ks) pa[ks] = PFRAG(i8 + 2, ks); }
                  __builtin_amdgcn_sched_barrier(0);
#pragma unroll
                  for (int ks = 0; ks < 4; ++ks) Z[i8 + 1] = __builtin_amdgcn_mfma_f32_16x16x32_bf16(pb[ks], Vf[ks], Z[i8 + 1], 0, 0, 0);
                  __builtin_amdgcn_sched_barrier(0); } }
#undef PFRAG
            if (s + 1 < nch) {
                const bf16_t* qn = Qg + (size_t)(tok0 + (dir ? c - 1 : c + 1) * 128) * DM + h * 256;
#pragma unroll
                for (int n = 4; n < 8; ++n) __builtin_amdgcn_global_load_lds((const unsigned*)((const char*)(qn + (size_t)(n * 16) * DM) + voffQ), (LAS unsigned*)(lds + QOFF + (n * 8 + w) * 1024), 16, 0, 0); }
            { char* yb = (char*)(Yg + (size_t)r0 * VW + h * 512 + es * 128);
              unsigned vy = voffY; asm volatile("" : "+v"(vy));
#pragma unroll
              for (int i8 = 0; i8 < 8; ++i8)
#pragma unroll
                  for (int r = 0; r < 4; ++r) *(bf16_t*)(yb + (vy + (unsigned)((i8 * 16 + r) * VW * 2))) = bf16_1(Z[i8][r]); }
            bf16x8 Vs[4];
            float kf8[8], kstep[4];
#pragma unroll
            for (int e = 0; e < 8; ++e) kf8[e] = __builtin_amdgcn_exp2f(kb2_ - (float)e * zl_);
            { const float k32 = __builtin_amdgcn_exp2f(-32.f * zl_); kstep[0] = 1.f; kstep[1] = k32; kstep[2] = k32 * k32; kstep[3] = kstep[2] * k32; }
#pragma unroll
            for (int ks = 0; ks < 4; ++ks) { const u32x4 t = __builtin_bit_cast(u32x4, Vf[ks]); float f[8]; f[0] = bf_lo(t.x); f[1] = bf_hi(t.x); f[2] = bf_lo(t.y); f[3] = bf_hi(t.y); f[4] = bf_lo(t.z); f[5] = bf_hi(t.z); f[6] = bf_lo(t.w); f[7] = bf_hi(t.w);
#pragma unroll
                for (int e = 0; e < 8; ++e) f[e] *= kf8[e] * kstep[ks];
                u32x4 o; o.x = cvt_pk_bf16(f[0], f[1]); o.y = cvt_pk_bf16(f[2], f[3]); o.z = cvt_pk_bf16(f[4], f[5]); o.w = cvt_pk_bf16(f[6], f[7]); Vs[ks] = __builtin_bit_cast(bf16x8, o); }
#define TFRAG(D, ks) (*(const LAS bf16x8*)(lds + KTOFF + xb[ks] + (8 * (fr >> 2) + (fr & 3)) * 256 + ((D) >> 1) * 8192 + ((D) & 1) * 1024))
            { bf16x8 ta[4], tb[4];
#pragma unroll
              for (int ks = 0; ks < 4; ++ks) ta[ks] = TFRAG(0, ks);
#pragma unroll
              for (int D = 0; D < 16; D += 2) { S[D] *= sdec; S[D + 1] *= sdec;
#pragma unroll
                  for (int ks = 0; ks < 4; ++ks) tb[ks] = TFRAG(D + 1, ks);
                  __builtin_amdgcn_sched_barrier(0);
#pragma unroll
                  for (int ks = 0; ks < 4; ++ks) S[D] = __builtin_amdgcn_mfma_f32_16x16x32_bf16(ta[ks], Vs[ks], S[D], 0, 0, 0);
                  __builtin_amdgcn_sched_barrier(0);
                  if (D < 14) {
#pragma unroll
                      for (int ks = 0; ks < 4; ++ks) ta[ks] = TFRAG(D + 2, ks); }
                  __builtin_amdgcn_sched_barrier(0);
#pragma unroll
                  for (int ks = 0; ks < 4; ++ks) S[D + 1] = __builtin_amdgcn_mfma_f32_16x16x32_bf16(tb[ks], Vs[ks], S[D + 1], 0, 0, 0);
                  __builtin_amdgcn_sched_barrier(0); } }
#undef TFRAG
            __syncthreads();
        }
        if (!lat) { float* so = p.out + (size_t)TT * DM + ((((size_t)bb * 2 + l) * 2 + dir) * 4 + h) * 256 * 512 + es * 128;
#pragma unroll
            for (int D = 0; D < 16; ++D)
#pragma unroll
                for (int r = 0; r < 4; ++r) __builtin_nontemporal_store(S[D][r], (float*)((char*)(so + ((D >> 1) * 32 + 4 * (D & 1) + r) * 512) + voffS)); }
    }
}

__device__ void comb_phase(const Params& p) {
    const int tid = tid_opaque(), lane = tid & 63, gw = blockIdx.x * 8 + (tid >> 6), nw = gridDim.x * 8;
    const bf16_t* yf = (const bf16_t*)(p.ws + WS_YF); const bf16_t* yb = (const bf16_t*)(p.ws + WS_YB); const bf16_t* rg = (const bf16_t*)(p.ws + WS_RG); bf16_t* ar = (bf16_t*)(p.ws + WS_Q);
    for (int tok = gw; tok < TT; tok += nw) {
        u32x4 a[4], b[4], g[4];
#pragma unroll
        for (int h = 0; h < 4; ++h) { const size_t off = (size_t)tok * VW + h * 512 + lane * 8; a[h] = __builtin_nontemporal_load((const u32x4*)(yf + off)); b[h] = __builtin_nontemporal_load((const u32x4*)(yb + off)); g[h] = __builtin_nontemporal_load((const u32x4*)(rg + off)); }
#pragma unroll
        for (int h = 0; h < 4; ++h) {
            float y[8];
#pragma unroll
            for (int e = 0; e < 4; ++e) { y[2 * e] = bf_lo(a[h][e]) + bf_lo(b[h][e]); y[2 * e + 1] = bf_hi(a[h][e]) + bf_hi(b[h][e]); }
            float s = 0.f;
#pragma unroll
            for (int e = 0; e < 8; ++e) s += y[e];
            const float mu = wave_sum(s) * (1.f / 512.f); float v = 0.f;
#pragma unroll
            for (int e = 0; e < 8; ++e) { y[e] -= mu; v += y[e] * y[e]; }
            const float rstd = rsqrtf(wave_sum(v) * (1.f / 512.f) + EPSV);
            u32x4 o;
#pragma unroll
            for (int e = 0; e < 4; ++e) o[e] = cvt_pk_bf16(y[2 * e] * rstd * bf_lo(g[h][e]), y[2 * e + 1] * rstd * bf_hi(g[h][e]));
            *(u32x4*)(ar + (size_t)tok * VW + h * 512 + lane * 8) = o;
        }
    }
}


#define XB_TMO      128
#define XB_XCNT(j)  (256  + 64 * (j))
#define XB_XSUB(j)  (1280 + 64 * (j))
#define XB_XGEN(j)  (2304 + 64 * (j))
#define XB_TOP      3328
#define XB_TOPGEN   3392
#define XCD_BAR_WORDS 3456
#define XB_SPIN_CAP (1u << 18)
__device__ __forceinline__ unsigned xb_ld(unsigned* p)              { return __hip_atomic_load(p, __ATOMIC_RELAXED, __HIP_MEMORY_SCOPE_AGENT); }
__device__ __forceinline__ unsigned xb_add(unsigned* p, unsigned v) { return __hip_atomic_fetch_add(p, v, __ATOMIC_RELAXED, __HIP_MEMORY_SCOPE_AGENT); }
__device__ __forceinline__ unsigned xb_xcc_id() { return (unsigned)__builtin_amdgcn_s_getreg((3 << 11) | 20) & 0xFu; }
#define XB_SPIN(cond, bar) do { unsigned _sp = 0; while (cond) { __builtin_amdgcn_s_sleep(1); \
    if ((++_sp & 255u) == 0u) { if (xb_ld(&(bar)[XB_TMO])) break; if (_sp > XB_SPIN_CAP) { atomicAdd(&(bar)[XB_TMO], 1u); break; } } } } while (0)
struct XcdBarrier { unsigned* bar; unsigned x; volatile LAS unsigned* st; };
__device__ __forceinline__ XcdBarrier xcd_barrier_post(unsigned* bar, volatile LAS unsigned* st) {
    XcdBarrier b; b.bar = bar; b.x = xb_xcc_id(); b.st = st;
    if (threadIdx.x == 0) (void)xb_add(&bar[XB_XCNT(b.x)], 1u);
    return b;
}
__device__ __forceinline__ void xcd_barrier_complete(unsigned* bar, unsigned x, unsigned& nloc, unsigned& nx) {
    const unsigned G = gridDim.x * gridDim.y * gridDim.z;
    unsigned sum, cnt, mine, sp = 0u;
    for (;;) {
        sum = 0u; cnt = 0u; mine = 0u;
#pragma unroll
        for (unsigned j = 0; j < 16; ++j) { const unsigned c = xb_ld(&bar[XB_XCNT(j)]); sum += c; cnt += (c > 0u) ? 1u : 0u; mine = (j == x) ? c : mine; }
        if (sum == G) break;
        __builtin_amdgcn_s_sleep(1);
        if ((++sp & 255u) == 0u) { if (xb_ld(&bar[XB_TMO])) break; if (sp > XB_SPIN_CAP) { atomicAdd(&bar[XB_TMO], 1u); break; } }
    }
    nloc = mine > 0u ? mine : 1u; nx = cnt > 0u ? cnt : 1u;
}
__device__ __forceinline__ void xcd_barrier(const XcdBarrier& b) {
    asm volatile("s_waitcnt vmcnt(0)" ::: "memory");
    __syncthreads();
    if (threadIdx.x == 0) {
        unsigned* bar = b.bar;
        __builtin_amdgcn_s_waitcnt(0);
        unsigned nloc = b.st[0], nx = b.st[1];
        if (nloc == 0u) { xcd_barrier_complete(bar, b.x, nloc, nx); b.st[0] = nloc; b.st[1] = nx; }
        const unsigned old = xb_add(&bar[XB_XSUB(b.x)], 1u);
        const unsigned gen = old / nloc;
        if (old + 1u == (gen + 1u) * nloc) {
            __builtin_amdgcn_fence(__ATOMIC_RELEASE, "agent");
            asm volatile("s_waitcnt vmcnt(0)" ::: "memory");
            const unsigned og = xb_add(&bar[XB_TOP], 1u);
            const unsigned tg = og / nx;
            if (og + 1u == (tg + 1u) * nx) xb_add(&bar[XB_TOPGEN], 1u);
            else XB_SPIN(xb_ld(&bar[XB_TOPGEN]) == tg, bar);
            __builtin_amdgcn_fence(__ATOMIC_ACQUIRE, "agent");
            xb_add(&bar[XB_XGEN(b.x)], 1u);
            asm volatile("s_waitcnt vmcnt(0)" ::: "memory");
        } else {
            XB_SPIN(xb_ld(&bar[XB_XGEN(b.x)]) == gen, bar);
            __builtin_amdgcn_fence(__ATOMIC_ACQUIRE, "agent");
            asm volatile("s_waitcnt vmcnt(0)" ::: "memory");
        }
    }
    __syncthreads();
}

__global__ void __launch_bounds__(NTHR) mega(Params p) {
    __shared__ __attribute__((aligned(16))) unsigned char smem[131072];
    cg::grid_group grid = cg::this_grid();
    LAS unsigned char* lds = (LAS unsigned char*)smem;
    unsigned char* ws = p.ws;
    float* xbuf = p.out;
    const float* modb = (const float*)(ws + WS_MOD);
    pg8::StaticOrder so;
    __shared__ __attribute__((aligned(16))) unsigned xb_st[4];
    if (threadIdx.x < 4) xb_st[threadIdx.x] = 0u;
    __syncthreads();
    if (blockIdx.x == 1) { const int t = tid_opaque(); for (int i = t; i < XCD_BAR_WORDS; i += NTHR) ((unsigned*)(ws + WS_BAR))[i] = 0u; }
    phase0(p, smem);
    grid.sync();
    const XcdBarrier xbar = xcd_barrier_post((unsigned*)(ws + WS_BAR), (volatile LAS unsigned*)xb_st);
    for (int l = 0; l < 2; ++l) {
        const unsigned char* wl = ws + WS_W + (size_t)l * WL_SZ;
        const float* modl = modb + (size_t)l * 9 * 6144;
        const float* xa = l == 0 ? p.in[0] : xbuf; const float* xb = l == 0 ? p.in[1] : xbuf + (size_t)TC * DM;
        norm_mod_phase(xa, xb, (bf16_t*)(ws + WS_R1), p.in[5] + l * DM, modl, 0);
        xcd_barrier(xbar);
        { pg8::Gemm g{(const bf16_t*)(ws + WS_R1), (const bf16_t*)(wl + WL_IN), TT, PW, DM}; so.init(TT, PW, gridDim.x, blockIdx.x);
          EpiG1 e{(bf16_t*)(ws + WS_R2), (bf16_t*)(ws + WS_Q), (bf16_t*)(ws + WS_K), (bf16_t*)(ws + WS_KT), (bf16_t*)(ws + WS_VT), (bf16_t*)(ws + WS_RG), (bf16_t*)(ws + WS_GATE), (const float*)(ws + WS_ROPE), (const float*)(ws + WS_ROPE) + 4096};
          pg8::gemm_phase(lds, g, so, e); }
        xcd_barrier(xbar);
        ret_phase(p, l, smem);
        conv_phase(p, l, smem);
        xcd_barrier(xbar);
        { pg8::Gemm g{(const bf16_t*)(ws + WS_R1), (const bf16_t*)(wl + WL_CONV), TT, DM, DM}; so.init(TT, DM, gridDim.x, blockIdx.x);
          EpiE1 e{(bf16_t*)(ws + WS_KT), (const bf16_t*)(ws + WS_GATE)};
          comb_phase(p);
          __syncthreads();
          pg8::gemm_phase(lds, g, so, e); }
        xcd_barrier(xbar);
        { pg8::Gemm g{(const bf16_t*)(ws + WS_Q), (const bf16_t*)(wl + WL_RET), TT, DM, VW}; so.init(TT, DM, gridDim.x, blockIdx.x);
          EpiE2 e{(const bf16_t*)(ws + WS_KT), (const bf16_t*)(ws + WS_GATE), (bf16_t*)(ws + WS_R2)};
          pg8::gemm_phase(lds, g, so, e); }
        xcd_barrier(xbar);
        { pg8::Gemm g{(const bf16_t*)(ws + WS_R2), (const bf16_t*)(wl + WL_OUT), TT, DM, DM}; so.init(TT, DM, gridDim.x, blockIdx.x);
          EpiRes e{xa, xb, xbuf, modl + 2 * 1024};
          pg8::gemm_phase(lds, g, so, e); }
        xcd_barrier(xbar);
        norm_mod_phase(xbuf, xbuf + (size_t)TC * DM, (bf16_t*)(ws + WS_R1), p.in[6] + l * DM, modl, 3);
        xcd_barrier(xbar);
        { pg8::Gemm g{(const bf16_t*)(ws + WS_R1), (const bf16_t*)(wl + WL_M1), TT, MLPW, DM}; so.init(TT, MLPW, gridDim.x, blockIdx.x);
          EpiF1 e{(bf16_t*)(ws + WS_RG)};
          pg8::gemm_phase(lds, g, so, e); }
        xcd_barrier(xbar);
        { pg8::Gemm g{(const bf16_t*)(ws + WS_RG), (const bf16_t*)(wl + WL_M2), TT, DM, MLPW}; so.init(TT, DM, gridDim.x, blockIdx.x);
          EpiRes e{xbuf, xbuf + (size_t)TC * DM, xbuf, modl + 5 * 1024};
          pg8::gemm_phase(lds, g, so, e); }
        xcd_barrier(xbar);
    }
    final_norm_phase(xbuf, p.in[19]);
}

extern "C" void kernel_launch(void* const* d_in, const int* in_sizes, int n_in, void* d_out, int out_size, void* d_ws, size_t ws_size, hipStream_t stream) {
    static int grid_blocks = 0;
    if (!grid_blocks) {
        int dev = 0, cus = 0, per_cu = 0;
        (void)hipGetDevice(&dev);
        (void)hipDeviceGetAttribute(&cus, hipDeviceAttributeMultiprocessorCount, dev);
        (void)hipOccupancyMaxActiveBlocksPerMultiprocessor(&per_cu, mega, NTHR, 0);
        if (per_cu < 1) per_cu = 1;
        grid_blocks = cus;
    }
    if (n_in != 20 || ws_size < WS_END) return;
    Params p{};
    for (int i = 0; i < 20; ++i) p.in[i] = (const float*)d_in[i];
    p.out = (float*)d_out; p.ws = (unsigned char*)d_ws;
    void* args[] = {&p};
    (void)hipLaunchCooperativeKernel((void*)mega, dim3(grid_blocks), dim3(NTHR), args, 0, stream);
}
```

```cpp
#include <hip/hip_runtime.h>
#include <hip/hip_cooperative_groups.h>
namespace cg = cooperative_groups;

#define LAS __attribute__((address_space(3)))
typedef unsigned short bf16_t;
typedef short bf16x8 __attribute__((ext_vector_type(8)));
typedef float f32x4 __attribute__((ext_vector_type(4)));
typedef float f32x2 __attribute__((ext_vector_type(2)));
typedef unsigned u32x2 __attribute__((ext_vector_type(2)));
typedef unsigned u32x4 __attribute__((ext_vector_type(4)));

constexpr int DM = 1024, TC = 4096, TL = 16384, TT = 20480, PW = 10240, MLPW = 4096, VW = 2048;
constexpr int NTHR = 512;
constexpr float EPSV = 1e-6f;
constexpr size_t MiB = (size_t)1 << 20;
constexpr size_t WS_W = 0;
constexpr size_t WL_IN = 0, WL_CONV = 20 * MiB, WL_RET = 22 * MiB, WL_OUT = 26 * MiB, WL_M1 = 28 * MiB, WL_M2 = 36 * MiB, WL_SZ = 44 * MiB;
constexpr size_t WS_MOD = 88 * MiB;
constexpr size_t WS_ROPE = 88 * MiB + 512 * 1024;
constexpr size_t WS_R1 = 90 * MiB;
constexpr size_t WS_R2 = 130 * MiB;
constexpr size_t WS_Q = 170 * MiB;
constexpr size_t WS_K = 210 * MiB;
constexpr size_t WS_KT = 250 * MiB;
constexpr size_t WS_VT = 290 * MiB;
constexpr size_t WS_RG = 370 * MiB;
constexpr size_t WS_GATE = 450 * MiB;
constexpr size_t WS_YF = 530 * MiB;
constexpr size_t WS_YB = 610 * MiB;
constexpr size_t WS_BAR = 88 * MiB + 448 * 1024;
constexpr size_t WS_DUMP = 690 * MiB;
constexpr size_t WS_CNT = 88 * MiB + 480 * 1024;
constexpr size_t WS_END = 754 * MiB;

struct Params { const float* in[20]; float* out; unsigned char* ws; };

typedef __bf16 bf16x2_t __attribute__((ext_vector_type(2)));
__device__ __forceinline__ unsigned cvt_pk_bf16(float lo, float hi) { const f32x2 f = {lo, hi}; const bf16x2_t v = __builtin_convertvector(f, bf16x2_t); return __builtin_bit_cast(unsigned, v); }
__device__ __forceinline__ float bf_lo(unsigned u) { return __uint_as_float(u << 16); }
__device__ __forceinline__ float bf_hi(unsigned u) { return __uint_as_float(u & 0xffff0000u); }
__device__ __forceinline__ float sigmoidf_(float x) { return __builtin_amdgcn_rcpf(1.f + __expf(-x)); }
__device__ __forceinline__ float siluf_(float x) { return x * sigmoidf_(x); }
__device__ __forceinline__ float wave_sum(float v) {
#pragma unroll
    for (int o = 32; o > 0; o >>= 1) v += __shfl_xor(v, o, 64);
    return v;
}
__device__ __forceinline__ int tid_opaque() { int t = threadIdx.x; asm volatile("" : "+v"(t)); return t; }
__device__ __forceinline__ int row_group(int row) { return row < TC ? 0 : 1 + ((row - TC) >> 11); }

namespace pg8 {
constexpr int BM = 256, BK = 64, HALF = 128, HTB = HALF * BK * 2, NXCD = 8, WGM = 8;
__device__ __forceinline__ int lds_byte(int r, int c) { const int st = (r >> 4) * 2 + (c >> 5), rr = r & 15, cc = c & 31, ob = rr * 64 + cc * 2; return st * 1024 + (ob ^ (((ob >> 9) & 1) << 5)); }
__device__ __forceinline__ void stage_rc(int b, int& R, int& C) { const int st = b / 1024, sb = b % 1024, swz = sb ^ (((sb >> 9) & 1) << 5); R = (st >> 1) * 16 + swz / 64; C = (st & 1) * 32 + (swz % 64) / 2; }
__device__ __forceinline__ int perm32(int rho) { const int n = rho >> 4, i = rho & 15; return 8 * (i >> 2) + 4 * n + (i & 3); }
struct Unit { int pm, pn, kq, ti; };
struct Gemm { const bf16_t* A; const bf16_t* Bt; int M, N, K; unsigned long long* dump; unsigned* cnt; };
struct StaticOrder {
    int nM, nN, nwg, G, c; bool split;
    __device__ void init(int M, int N, int G_, int c_, bool allow_split = false) { nM = M / BM; nN = N / BM; nwg = nM * nN; G = G_; c = c_; split = allow_split && nwg == 320 && G == 256; }
    __device__ bool next(int i, Unit& u) const {
        long L; int kq = -1, ti = 0;
        if (split) { if (i == 0) L = c; else if (i == 1) { ti = c >> 2; kq = c & 3; L = G + ti; } else return false; }
        else L = (long)i * G + c;
        if (L >= nwg) return false;
        int wgid = (int)L; { const int q = nwg / NXCD, r = nwg % NXCD, xcd = wgid % NXCD, off = wgid / NXCD; wgid = (xcd < r ? xcd * (q + 1) : r * (q + 1) + (xcd - r) * q) + off; }
        const int nig = WGM * nN, gid = wgid / nig, fm = gid * WGM, gsz = (nM - fm) < WGM ? (nM - fm) : WGM;
        u.pm = fm + ((wgid % nig) % gsz); u.pn = (wgid % nig) / gsz; u.kq = kq; u.ti = ti; return true;
    }
};

template <class Epi>
__device__ __forceinline__ void gemm_phase(LAS unsigned char* lds, const Gemm g, const StaticOrder& S, const Epi& E) {
    const int tid = tid_opaque(), wid = __builtin_amdgcn_readfirstlane(tid >> 6), lane = tid & 63, wr = wid >> 2, wc = wid & 3, fr = lane & 15, fq = lane >> 4;
    const int K = g.K;
    unsigned voffA[2], voffB[2];
#pragma unroll
    for (int i = 0; i < 2; ++i) { int R, C; stage_rc(tid * 16 + i * 8192, R, C); const int Rb = (R & ~31) + perm32(R & 31); voffA[i] = (unsigned)(R * K + C) * 2u; voffB[i] = (unsigned)(Rb * K + C) * 2u; }
    const size_t kstep = (size_t)(BK * 2);
    const size_t hstep = (size_t)HALF * K * 2;
    const size_t tstep = 2 * hstep;
    const unsigned ldsw = (unsigned)wid * 1024u;
    const int aoff = lds_byte(wr * 64 + fr, fq * 8), boff = lds_byte(wc * 32 + fr, fq * 8);
#define PG8_SA(b, h) (((b) * 2 + (h)) * HTB)
#define PG8_SB(b, h) ((4 + (b) * 2 + (h)) * HTB)
#define PG8_STAGE(bufoff, gbase, voff) do { _Pragma("unroll") for (int _i = 0; _i < 2; ++_i) \
        __builtin_amdgcn_global_load_lds((const unsigned*)((const char*)(gbase) + (voff)[_i]), (LAS unsigned*)(lds + (bufoff) + ldsw + _i * 8192), 16, 0, 0); } while (0)
#define PG8_LDA(dst, b, h) do { _Pragma("unroll") for (int m = 0; m < 4; ++m) _Pragma("unroll") for (int k = 0; k < 2; ++k) dst[m][k] = *(const LAS bf16x8*)(lds + PG8_SA(b, h) + aoff + m * 2048 + k * 1024); } while (0)
#define PG8_LDB(dst, b, h) do { _Pragma("unroll") for (int n = 0; n < 2; ++n) _Pragma("unroll") for (int k = 0; k < 2; ++k) dst[n][k] = *(const LAS bf16x8*)(lds + PG8_SB(b, h) + boff + n * 2048 + k * 1024); } while (0)
#define PG8_MMA(ai, bj, At, Bt) do { __builtin_amdgcn_s_setprio(1); _Pragma("unroll") for (int m = 0; m < 4; ++m) _Pragma("unroll") for (int n = 0; n < 2; ++n) _Pragma("unroll") for (int k = 0; k < 2; ++k) \
        acc[ai][bj][m][n] = __builtin_amdgcn_mfma_f32_16x16x32_bf16(Bt[n][k], At[m][k], acc[ai][bj][m][n], 0, 0, 0); __builtin_amdgcn_s_setprio(0); } while (0)
#define PG8_WAIT_V(n) asm volatile("s_waitcnt vmcnt(" #n ")" ::: "memory")
#define PG8_WAIT_L(n) asm volatile("s_waitcnt lgkmcnt(" #n ")" ::: "memory")
#define PG8_BAR __builtin_amdgcn_s_barrier()
#define PG8_SCHED __builtin_amdgcn_sched_barrier(0)
    Unit cur, nxt; int ui = 0;
    if (!S.next(0, cur)) return;
    f32x4 acc[2][2][4][2];
#pragma unroll
    for (int a = 0; a < 2; ++a)
#pragma unroll
        for (int b = 0; b < 2; ++b)
#pragma unroll
            for (int m = 0; m < 4; ++m)
#pragma unroll
                for (int n = 0; n < 2; ++n) acc[a][b][m][n] = (f32x4){0.f, 0.f, 0.f, 0.f};
    bf16x8 At[4][2], B0[2][2], B1[2][2];
    const char* cA = E.swapped(cur) ? (const char*)g.Bt + (size_t)cur.pn * tstep : (const char*)g.A + (size_t)cur.pm * tstep;
    const char* cB = E.swapped(cur) ? (const char*)g.A + (size_t)cur.pm * tstep : (const char*)g.Bt + (size_t)cur.pn * tstep;
    const size_t qstep = (size_t)(K >> 2) * 2;
    if (cur.kq >= 0) { cA += cur.kq * qstep; cB += cur.kq * qstep; }
    PG8_STAGE(PG8_SB(0, 0), cB, voffB); PG8_STAGE(PG8_SA(0, 0), cA, voffA); PG8_STAGE(PG8_SB(0, 1), cB + hstep, voffB); PG8_STAGE(PG8_SA(0, 1), cA + hstep, voffA);
    if (wr == 1) PG8_BAR;
    PG8_WAIT_V(4); PG8_BAR;
    PG8_STAGE(PG8_SB(1, 0), cB + kstep, voffB); PG8_STAGE(PG8_SA(1, 0), cA + kstep, voffA); PG8_STAGE(PG8_SB(1, 1), cB + hstep + kstep, voffB);
    PG8_WAIT_V(6); PG8_BAR;
    for (;;) {
        const bool has_next = S.next(ui + 1, nxt);
        const bool nsw = has_next && E.swapped(nxt);
        const char* nA = has_next ? (nsw ? (const char*)g.Bt + (size_t)nxt.pn * tstep : (const char*)g.A + (size_t)nxt.pm * tstep) : cA;
        const char* nB = has_next ? (nsw ? (const char*)g.A + (size_t)nxt.pm * tstep : (const char*)g.Bt + (size_t)nxt.pn * tstep) : cB;
        if (has_next && nxt.kq >= 0) { nA += nxt.kq * qstep; nB += nxt.kq * qstep; }
        const int nt = (cur.kq >= 0 ? (K >> 2) : K) / BK;
        for (int t = 0; t < nt; t += 2) {
            const bool last = (t == nt - 2);
            const char* a1 = cA + (size_t)(t + 1) * kstep;
            const char* a2 = last ? nA : cA + (size_t)(t + 2) * kstep; const char* b2 = last ? nB : cB + (size_t)(t + 2) * kstep;
            const char* a3 = a2 + kstep; const char* b3 = b2 + kstep;
            PG8_LDB(B0, 0, 0); PG8_SCHED; PG8_LDA(At, 0, 0); PG8_STAGE(PG8_SA(1, 1), a1 + hstep, voffA);
            PG8_WAIT_L(8); PG8_BAR; PG8_WAIT_L(0); PG8_MMA(0, 0, At, B0); PG8_BAR; PG8_SCHED;
            PG8_LDB(B1, 0, 1); PG8_STAGE(PG8_SB(0, 0), b2, voffB);
            PG8_BAR; PG8_WAIT_L(0); PG8_MMA(0, 1, At, B1); PG8_BAR;
            PG8_LDA(At, 0, 1); PG8_STAGE(PG8_SA(0, 0), a2, voffA);
            PG8_BAR; PG8_WAIT_L(0); PG8_MMA(1, 0, At, B0); PG8_BAR; PG8_SCHED;
            PG8_STAGE(PG8_SB(0, 1), b2 + hstep, voffB);
            PG8_WAIT_V(6); PG8_BAR; PG8_MMA(1, 1, At, B1); PG8_BAR;
            PG8_LDB(B0, 1, 0); PG8_SCHED; PG8_LDA(At, 1, 0); PG8_STAGE(PG8_SA(0, 1), a2 + hstep, voffA);
            PG8_WAIT_L(8); PG8_BAR; PG8_WAIT_L(0); PG8_MMA(0, 0, At, B0); PG8_BAR; PG8_SCHED;
            PG8_LDB(B1, 1, 1); PG8_STAGE(PG8_SB(1, 0), b3, voffB);
            PG8_BAR; PG8_WAIT_L(0); PG8_MMA(0, 1, At, B1); PG8_BAR;
            PG8_LDA(At, 1, 1); PG8_STAGE(PG8_SA(1, 0), a3, voffA);
            PG8_BAR; PG8_WAIT_L(0); PG8_MMA(1, 0, At, B0); PG8_BAR; PG8_SCHED;
            PG8_STAGE(PG8_SB(1, 1), b3 + hstep, voffB);
            PG8_WAIT_V(6); PG8_BAR; PG8_MMA(1, 1, At, B1); PG8_BAR;
        }
        if (cur.kq < 0) E(acc, cur, wr, wc, fr, fq);
        if (!has_next) break;
#pragma unroll
        for (int a = 0; a < 2; ++a)
#pragma unroll
            for (int b = 0; b < 2; ++b)
#pragma unroll
                for (int m = 0; m < 4; ++m)
#pragma unroll
                    for (int n = 0; n < 2; ++n) acc[a][b][m][n] = (f32x4){0.f, 0.f, 0.f, 0.f};
        cur = nxt; cA = nA; cB = nB; ++ui;
    }
    PG8_WAIT_V(0);
    if (wr == 0) PG8_BAR;
    PG8_BAR;
    if constexpr (Epi::SPLIT) {
    if (cur.kq >= 0) {
        typedef unsigned long long u64;
        u64* db = g.dump + (size_t)cur.ti * 4 * (64 * 512);
        int lt = tid;
        { u64* d = db + (size_t)cur.kq * (64 * 512);
#pragma unroll
          for (int a = 0; a < 2; ++a)
#pragma unroll
              for (int b = 0; b < 2; ++b)
#pragma unroll
                  for (int m = 0; m < 4; ++m)
#pragma unroll
                      for (int n = 0; n < 2; ++n)
#pragma unroll
                          for (int h = 0; h < 2; ++h) { asm volatile("" : "+v"(lt)); const f32x4 v = acc[a][b][m][n];
                              const u64 w = (u64)__float_as_uint(v[2 * h]) | ((u64)__float_as_uint(v[2 * h + 1]) << 32);
                              __hip_atomic_store(d + ((((a * 2 + b) * 4 + m) * 2 + n) * 2 + h) * 512 + lt, w, __ATOMIC_RELAXED, __HIP_MEMORY_SCOPE_AGENT); } }
        asm volatile("s_waitcnt vmcnt(0)" ::: "memory");
        __syncthreads();
        if (tid == 0) { const unsigned old = __hip_atomic_fetch_add(g.cnt + cur.ti, 1u, __ATOMIC_RELAXED, __HIP_MEMORY_SCOPE_AGENT); *(LAS unsigned*)lds = old;
            if (old == 3u) __hip_atomic_store(g.cnt + cur.ti, 0u, __ATOMIC_RELAXED, __HIP_MEMORY_SCOPE_AGENT); }
        __syncthreads();
        const unsigned arrived = __builtin_amdgcn_readfirstlane(*(LAS unsigned*)lds);
        if (arrived == 3u) {
#pragma unroll
            for (int a = 0; a < 2; ++a)
#pragma unroll
                for (int m = 0; m < 4; ++m) { f32x4 v[2][2];
#pragma unroll
                    for (int b = 0; b < 2; ++b)
#pragma unroll
                        for (int n = 0; n < 2; ++n)
#pragma unroll
                            for (int h = 0; h < 2; ++h) { asm volatile("" : "+v"(lt)); const u64* d = db + ((((a * 2 + b) * 4 + m) * 2 + n) * 2 + h) * 512 + lt;
                                const u64 p0 = __hip_atomic_load(d, __ATOMIC_RELAXED, __HIP_MEMORY_SCOPE_AGENT), p1 = __hip_atomic_load(d + 64 * 512, __ATOMIC_RELAXED, __HIP_MEMORY_SCOPE_AGENT),
                                          p2 = __hip_atomic_load(d + 2 * 64 * 512, __ATOMIC_RELAXED, __HIP_MEMORY_SCOPE_AGENT), p3 = __hip_atomic_load(d + 3 * 64 * 512, __ATOMIC_RELAXED, __HIP_MEMORY_SCOPE_AGENT);
                                v[b][n][2 * h] = (__uint_as_float((unsigned)p0) + __uint_as_float((unsigned)p1)) + (__uint_as_float((unsigned)p2) + __uint_as_float((unsigned)p3));
                                v[b][n][2 * h + 1] = (__uint_as_float((unsigned)(p0 >> 32)) + __uint_as_float((unsigned)(p1 >> 32))) + (__uint_as_float((unsigned)(p2 >> 32)) + __uint_as_float((unsigned)(p3 >> 32))); }
                    E.rg(a, m, v, cur, wr, wc, fr, fq); if (m & 1) asm volatile("" ::: "memory"); }
        }
        __syncthreads();
    }
    }
#undef PG8_SA
#undef PG8_SB
#undef PG8_STAGE
#undef PG8_LDA
#undef PG8_LDB
#undef PG8_MMA
#undef PG8_WAIT_V
#undef PG8_WAIT_L
#undef PG8_BAR
#undef PG8_SCHED
}
}
using pg8::Unit;
typedef const f32x4 (&AccRef)[2][2][4][2];

__device__ __forceinline__ void st_bf16x4(bf16_t* p, f32x4 v) { u32x2 w; w.x = cvt_pk_bf16(v[0], v[1]); w.y = cvt_pk_bf16(v[2], v[3]); *(u32x2*)p = w; }
__device__ __forceinline__ void st_bf16x8(bf16_t* p, f32x4 a, f32x4 b) { u32x4 w; w.x = cvt_pk_bf16(a[0], a[1]); w.y = cvt_pk_bf16(a[2], a[3]); w.z = cvt_pk_bf16(b[0], b[1]); w.w = cvt_pk_bf16(b[2], b[3]); *(u32x4*)p = w; }
__device__ __forceinline__ bf16_t bf16_1(float v) { return (bf16_t)(cvt_pk_bf16(v, 0.f) & 0xffffu); }

struct EpiG1 {
    static constexpr bool SPLIT = false;
    __device__ __forceinline__ bool swapped(const Unit& u) const { return u.pn >= 16 && u.pn < 24; }
    bf16_t *aglu, *q, *k, *kt, *vt, *rg, *gate; const float *rcos, *rsin;
    __device__ __forceinline__ void operator()(AccRef acc, const Unit& u, int wr, int wc, int fr, int fq) const {
        const int pn = u.pn, row0 = u.pm * 256 + wr * 64 + fr, ct = wc * 32 + 8 * fq;
        if (pn < 8) {
#pragma unroll
            for (int ai = 0; ai < 2; ++ai)
#pragma unroll
                for (int m = 0; m < 4; ++m) { const int row = row0 + ai * 128 + m * 16; f32x4 o[2];
#pragma unroll
                    for (int n = 0; n < 2; ++n) { const f32x4 a = acc[ai][0][m][n], b = acc[ai][1][m][n];
#pragma unroll
                        for (int r = 0; r < 4; ++r) o[n][r] = a[r] * sigmoidf_(b[r]); }
                    st_bf16x8(aglu + (size_t)row * DM + pn * 128 + ct, o[0], o[1]); }
        } else if (pn < 16) {
            const bool isK = pn >= 12; const int h = (pn - 8) & 3; const float sc = isK ? 0.0625f : 1.0f; bf16_t* dst = isK ? k : q;
#pragma unroll
            for (int ai = 0; ai < 2; ++ai)
#pragma unroll
                for (int m = 0; m < 4; ++m) { const int row = row0 + ai * 128 + m * 16; const bool lat = row >= TC; const int pos = (row - TC) & 2047, gr = pos >> 6, gc = pos & 63; f32x4 o1[2], o2[2];
#pragma unroll
                    for (int n = 0; n < 2; ++n) { const int d1 = ct + n * 4; const f32x4 x1 = acc[ai][0][m][n] * sc, x2 = acc[ai][1][m][n] * sc; o1[n] = x1; o2[n] = x2;
                        if (lat) { const int ti = (d1 < 64) ? gr * 64 + d1 : gc * 64 + d1 - 64; const f32x4 cs = *(const f32x4*)(rcos + ti), sn = *(const f32x4*)(rsin + ti);
                            o1[n] = x1 * cs - x2 * sn; o2[n] = x2 * cs + x1 * sn; }
                        if (isK) {
#pragma unroll
                            for (int r = 0; r < 4; ++r) { kt[(size_t)(h * 256 + d1 + r) * TT + row] = bf16_1(o1[n][r]); kt[(size_t)(h * 256 + 128 + d1 + r) * TT + row] = bf16_1(o2[n][r]); } } }
                    st_bf16x8(dst + (size_t)row * DM + h * 256 + ct, o1[0], o1[1]); st_bf16x8(dst + (size_t)row * DM + h * 256 + 128 + ct, o2[0], o2[1]); }
        } else if (pn < 24) {
            const int e0 = (pn - 16) * 256 + wr * 64 + fr, t0 = u.pm * 256 + ct;
#pragma unroll
            for (int ai = 0; ai < 2; ++ai)
#pragma unroll
                for (int m = 0; m < 4; ++m) { bf16_t* vr = vt + (size_t)(e0 + ai * 128 + m * 16) * TT + t0;
#pragma unroll
                    for (int bj = 0; bj < 2; ++bj) st_bf16x8(vr + bj * 128, acc[ai][bj][m][0], acc[ai][bj][m][1]); }
        } else {
            const bool isG = pn >= 32; bf16_t* dst = isG ? gate : rg; const int cb = ((pn - 24) & 7) * 256;
#pragma unroll
            for (int ai = 0; ai < 2; ++ai)
#pragma unroll
                for (int m = 0; m < 4; ++m) { const int row = row0 + ai * 128 + m * 16;
#pragma unroll
                    for (int bj = 0; bj < 2; ++bj) { f32x4 o[2];
#pragma unroll
                        for (int n = 0; n < 2; ++n) { const f32x4 v = acc[ai][bj][m][n];
#pragma unroll
                            for (int r = 0; r < 4; ++r) { const float s = sigmoidf_(v[r]); o[n][r] = isG ? s : v[r] * s; } }
                        st_bf16x8(dst + (size_t)row * VW + cb + bj * 128 + ct, o[0], o[1]); } }
        }
    }
};

struct EpiE1 {
    static constexpr bool SPLIT = false;
    __device__ __forceinline__ bool swapped(const Unit&) const { return false; }
    bf16_t* m1; const bf16_t* gate;
    __device__ __forceinline__ void operator()(AccRef acc, const Unit& u, int wr, int wc, int fr, int fq) const {
        const int row0 = u.pm * 256 + wr * 64 + fr, col0 = u.pn * 256 + wc * 32 + 8 * fq;
#pragma unroll
        for (int ai = 0; ai < 2; ++ai)
#pragma unroll
            for (int m = 0; m < 4; ++m) { const int row = row0 + ai * 128 + m * 16;
#pragma unroll
                for (int bj = 0; bj < 2; ++bj) { const int col = col0 + bj * 128; const u32x4 gv = *(const u32x4*)(gate + (size_t)row * VW + col); const f32x4 v0 = acc[ai][bj][m][0], v1 = acc[ai][bj][m][1];
                    f32x4 o0, o1; o0[0] = v0[0] * bf_lo(gv.x); o0[1] = v0[1] * bf_hi(gv.x); o0[2] = v0[2] * bf_lo(gv.y); o0[3] = v0[3] * bf_hi(gv.y);
                    o1[0] = v1[0] * bf_lo(gv.z); o1[1] = v1[1] * bf_hi(gv.z); o1[2] = v1[2] * bf_lo(gv.w); o1[3] = v1[3] * bf_hi(gv.w);
                    st_bf16x8(m1 + (size_t)row * DM + col, o0, o1); } }
    }
};
struct EpiE2 {
    static constexpr bool SPLIT = false;
    __device__ __forceinline__ bool swapped(const Unit&) const { return false; }
    const bf16_t* m1; const bf16_t* gate; bf16_t* mm;
    __device__ __forceinline__ void operator()(AccRef acc, const Unit& u, int wr, int wc, int fr, int fq) const {
        const int row0 = u.pm * 256 + wr * 64 + fr, col0 = u.pn * 256 + wc * 32 + 8 * fq;
#pragma unroll
        for (int ai = 0; ai < 2; ++ai)
#pragma unroll
            for (int m = 0; m < 4; ++m) { const int row = row0 + ai * 128 + m * 16;
#pragma unroll
                for (int bj = 0; bj < 2; ++bj) { const int col = col0 + bj * 128; const u32x4 gv = *(const u32x4*)(gate + (size_t)row * VW + DM + col), mv = *(const u32x4*)(m1 + (size_t)row * DM + col); const f32x4 v0 = acc[ai][bj][m][0], v1 = acc[ai][bj][m][1];
                    f32x4 o0, o1; o0[0] = bf_lo(mv.x) + v0[0] * bf_lo(gv.x); o0[1] = bf_hi(mv.x) + v0[1] * bf_hi(gv.x); o0[2] = bf_lo(mv.y) + v0[2] * bf_lo(gv.y); o0[3] = bf_hi(mv.y) + v0[3] * bf_hi(gv.y);
                    o1[0] = bf_lo(mv.z) + v1[0] * bf_lo(gv.z); o1[1] = bf_hi(mv.z) + v1[1] * bf_hi(gv.z); o1[2] = bf_lo(mv.w) + v1[2] * bf_lo(gv.w); o1[3] = bf_hi(mv.w) + v1[3] * bf_hi(gv.w);
                    st_bf16x8(mm + (size_t)row * DM + col, o0, o1); } }
    }
};
template <bool SPLIT_> struct EpiResT {
    static constexpr bool SPLIT = SPLIT_;
    __device__ __forceinline__ bool swapped(const Unit&) const { return false; }
    const float *xa, *xb; float* xout; const float* gvec;
    __device__ __forceinline__ void rg(int ai, int m, const f32x4 (&v)[2][2], const Unit& u, int wr, int wc, int fr, int fq) const {
        const int row = u.pm * 256 + wr * 64 + fr + ai * 128 + m * 16, col0 = u.pn * 256 + wc * 32 + 8 * fq;
        const float* xr = row < TC ? xa + (size_t)row * DM : xb + (size_t)(row - TC) * DM; const float* gr = gvec + row_group(row) * 6144;
#pragma unroll
        for (int bj = 0; bj < 2; ++bj)
#pragma unroll
            for (int n = 0; n < 2; ++n) { const int col = col0 + bj * 128 + n * 4; const f32x4 xv = *(const f32x4*)(xr + col), gv = *(const f32x4*)(gr + col);
                *(f32x4*)(xout + (size_t)row * DM + col) = xv + gv * v[bj][n]; }
    }
    __device__ __forceinline__ void operator()(AccRef acc, const Unit& u, int wr, int wc, int fr, int fq) const {
#pragma unroll
        for (int a = 0; a < 2; ++a)
#pragma unroll
            for (int m = 0; m < 4; ++m) { const f32x4 v[2][2] = {{acc[a][0][m][0], acc[a][0][m][1]}, {acc[a][1][m][0], acc[a][1][m][1]}}; rg(a, m, v, u, wr, wc, fr, fq); }
    }
};
struct EpiF1 {
    static constexpr bool SPLIT = false;
    __device__ __forceinline__ bool swapped(const Unit&) const { return false; }
    bf16_t* uo;
    __device__ __forceinline__ void operator()(AccRef acc, const Unit& u, int wr, int wc, int fr, int fq) const {
        const int row0 = u.pm * 256 + wr * 64 + fr, col0 = u.pn * 256 + wc * 32 + 8 * fq;
#pragma unroll
        for (int ai = 0; ai < 2; ++ai)
#pragma unroll
            for (int m = 0; m < 4; ++m) { const int row = row0 + ai * 128 + m * 16;
#pragma unroll
                for (int bj = 0; bj < 2; ++bj) { f32x4 o[2];
#pragma unroll
                    for (int n = 0; n < 2; ++n) { const f32x4 v = acc[ai][bj][m][n];
#pragma unroll
                        for (int r = 0; r < 4; ++r) { const float t = fmaxf(v[r], 0.f); o[n][r] = t * t; } }
                    st_bf16x8(uo + (size_t)row * MLPW + col0 + bj * 128, o[0], o[1]); } }
    }
};

__device__ __forceinline__ void tconv_item(const float* __restrict__ src, bf16_t* __restrict__ dst, int K, int N, int item, bool permIn, float* tile  ) {
    const int tilesN = N >> 8, kt = item / tilesN, ntile = item - kt * tilesN, k0 = kt * 64, n0 = ntile * 256, tid = tid_opaque();
    { const int r = tid >> 6, c4 = (tid & 63) * 4; f32x4 v[8];
#pragma unroll
      for (int rr = 0; rr < 8; ++rr) v[rr] = __builtin_nontemporal_load((const f32x4*)(src + (size_t)(k0 + r + rr * 8) * N + n0 + c4));
#pragma unroll
      for (int rr = 0; rr < 8; ++rr) { float* t = tile + (r + rr * 8) * 257 + c4; t[0] = v[rr][0]; t[1] = v[rr][1]; t[2] = v[rr][2]; t[3] = v[rr][3]; } }
    __syncthreads();
#pragma unroll
    for (int q = 0; q < 4; ++q) { const int n = q * 64 + (tid >> 3), k8 = (tid & 7) * 8; float v[8];
#pragma unroll
      for (int e = 0; e < 8; ++e) v[e] = tile[(k8 + e) * 257 + n];
      int nn = n0 + n;
      if (permIn && nn < 2048) { const int c = nn & 1023, half = nn >> 10; nn = (c >> 7) * 256 + half * 128 + (c & 127); }
      u32x4 w; w.x = cvt_pk_bf16(v[0], v[1]); w.y = cvt_pk_bf16(v[2], v[3]); w.z = cvt_pk_bf16(v[4], v[5]); w.w = cvt_pk_bf16(v[6], v[7]);
      *(u32x4*)(dst + (size_t)nn * K + k0 + k8) = w; }
    __syncthreads();
}

__device__ void phase0(const Params& p, unsigned char* smem) {
    float* tile = (float*)smem;
    float* scond = (float*)(smem + 66048);
    float* red = (float*)(smem + 66048 + 36864);
    const int tid = tid_opaque();
    constexpr int NT_L = 1408, NT = 2 * NT_L, NMOD = 192;
    for (int it = blockIdx.x; it < NT + NMOD + 1; it += gridDim.x) {
        if (it < NT) {
            const int l = it / NT_L; int j = it - l * NT_L; unsigned char* wb = p.ws + WS_W + (size_t)l * WL_SZ;
            if (j < 640) tconv_item(p.in[9] + (size_t)l * DM * PW, (bf16_t*)(wb + WL_IN), DM, PW, j, true, tile);
            else if ((j -= 640) < 64) tconv_item(p.in[13] + (size_t)l * DM * DM, (bf16_t*)(wb + WL_CONV), DM, DM, j, false, tile);
            else if ((j -= 64) < 128) tconv_item(p.in[15] + (size_t)l * VW * DM, (bf16_t*)(wb + WL_RET), VW, DM, j, false, tile);
            else if ((j -= 128) < 64) tconv_item(p.in[16] + (size_t)l * DM * DM, (bf16_t*)(wb + WL_OUT), DM, DM, j, false, tile);
            else if ((j -= 64) < 256) tconv_item(p.in[17] + (size_t)l * DM * MLPW, (bf16_t*)(wb + WL_M1), DM, MLPW, j, false, tile);
            else { j -= 256; tconv_item(p.in[18] + (size_t)l * MLPW * DM, (bf16_t*)(wb + WL_M2), MLPW, DM, j, false, tile); }
        } else if (it < NT + NMOD) {
            const int j = it - NT, l = j / 96, c0 = (j % 96) * 64;
            for (int idx = tid; idx < 9 * 1024; idx += NTHR) { const int g = idx >> 10, k = idx & 1023; const float v = g == 0 ? p.in[4][k] : p.in[2][(g - 1) * 1024 + k]; scond[idx] = siluf_(v); }
            __syncthreads();
            const int col = tid & 63, kg = tid >> 6; float a[9];
#pragma unroll
            for (int g = 0; g < 9; ++g) a[g] = 0.f;
            const float* wm = p.in[7] + (size_t)l * DM * 6144 + c0 + col;
#pragma unroll 16
            for (int k = kg * 128; k < kg * 128 + 128; ++k) { const float w = __builtin_nontemporal_load(wm + (size_t)k * 6144);
#pragma unroll
                for (int g = 0; g < 9; ++g) a[g] += scond[g * 1024 + k] * w; }
#pragma unroll
            for (int g = 0; g < 9; ++g) red[(kg * 9 + g) * 64 + col] = a[g];
            __syncthreads();
            for (int o = tid; o < 9 * 64; o += NTHR) { const int g = o >> 6, cc = o & 63; float s = 0.f;
#pragma unroll
                for (int q = 0; q < 8; ++q) s += red[(q * 9 + g) * 64 + cc];
                ((float*)(p.ws + WS_MOD))[(size_t)(l * 9 + g) * 6144 + c0 + cc] = s + p.in[8][l * 6144 + c0 + cc]; }
            __syncthreads();
        } else {
            float* rc = (float*)(p.ws + WS_ROPE); float* rs = rc + 4096;
            if (tid < 64) ((unsigned*)(p.ws + WS_CNT))[tid] = 0u;
            for (int idx = tid; idx < 4096; idx += NTHR) { const int pos = idx >> 6, i = idx & 63; const float inv = exp2f(-(float)i * (13.287712379549449f / 64.f)); const float ang = (float)pos * inv;
                rc[idx] = __cosf(ang); rs[idx] = __sinf(ang); }
        }
    }
}

__device__ void norm_mod_phase(const float* xa, const float* xb, bf16_t* dst, const float* ng, const float* modl, int sh_chunk) {
    const int tid = tid_opaque(), lane = tid & 63, gw = blockIdx.x * 8 + (tid >> 6), nw = gridDim.x * 8;
    for (int row0 = gw; row0 < TT; row0 += 2 * nw) {
        f32x4 v[2][4]; float ss[2];
#pragma unroll
        for (int q = 0; q < 2; ++q) { const int row = min(row0 + q * nw, TT - 1); const float* xr = row < TC ? xa + (size_t)row * DM : xb + (size_t)(row - TC) * DM;
#pragma unroll
            for (int i = 0; i < 4; ++i) v[q][i] = __builtin_nontemporal_load((const f32x4*)(xr + i * 256 + lane * 4)); }
#pragma unroll
        for (int q = 0; q < 2; ++q) { float s = 0.f;
#pragma unroll
            for (int i = 0; i < 4; ++i) s += v[q][i][0] * v[q][i][0] + v[q][i][1] * v[q][i][1] + v[q][i][2] * v[q][i][2] + v[q][i][3] * v[q][i][3];
            ss[q] = s; }
#pragma unroll
        for (int q = 0; q < 2; ++q) { const int row = row0 + q * nw; if (row >= TT) break;
            const float rstd = rsqrtf(wave_sum(ss[q]) * (1.f / DM) + EPSV); const float* md = modl + row_group(row) * 6144;
#pragma unroll
            for (int i = 0; i < 4; ++i) { const int c = i * 256 + lane * 4; const f32x4 g = *(const f32x4*)(ng + c), sh = *(const f32x4*)(md + sh_chunk * 1024 + c), sc = *(const f32x4*)(md + (sh_chunk + 1) * 1024 + c);
                const f32x4 o = v[q][i] * rstd * g * (sc + 1.f) + sh; st_bf16x4(dst + (size_t)row * DM + c, o); } }
    }
}
__device__ void final_norm_phase(float* x, const float* ng) {
    const int tid = tid_opaque(), lane = tid & 63, gw = blockIdx.x * 8 + (tid >> 6), nw = gridDim.x * 8;
    for (int row = gw; row < TT; row += nw) {
        float* xr = x + (size_t)row * DM; f32x4 v[4]; float ss = 0.f;
#pragma unroll
        for (int i = 0; i < 4; ++i) { v[i] = __builtin_nontemporal_load((const f32x4*)(xr + i * 256 + lane * 4)); ss += v[i][0] * v[i][0] + v[i][1] * v[i][1] + v[i][2] * v[i][2] + v[i][3] * v[i][3]; }
        ss = wave_sum(ss); const float rstd = rsqrtf(ss * (1.f / DM) + EPSV);
#pragma unroll
        for (int i = 0; i < 4; ++i) { const int c = i * 256 + lane * 4; const f32x4 g = *(const f32x4*)(ng + c); __builtin_nontemporal_store(v[i] * rstd * g, (f32x4*)(xr + c)); }
    }
}

__device__ void conv_phase(const Params& p, int l, unsigned char* smem) {
    const int tid = tid_opaque(), lane = tid & 63, wv = tid >> 6;
    const bf16_t* aglu = (const bf16_t*)(p.ws + WS_R2); bf16_t* aconv = (bf16_t*)(p.ws + WS_R1);
    float* red = (float*)(smem + 46 * 2048);
    float* rst = red + 128;
    const int c0 = 2 * tid;
    float w0[31], w1[31];
#pragma unroll
    for (int j = 0; j < 31; ++j) { const f32x2 wv2 = *(const f32x2*)(p.in[10] + (size_t)(l * 31 + j) * DM + c0); w0[j] = wv2.x; w1[j] = wv2.y; }
    const f32x2 bias = *(const f32x2*)(p.in[11] + l * DM + c0), gn = *(const f32x2*)(p.in[12] + l * DM + c0);
    for (int it = blockIdx.x; it < TT / 16; it += gridDim.x) {
        const int t0 = it * 16, segl = t0 < TC ? 256 : 64, ss = t0 & ~(segl - 1), se = ss + segl;
        for (int idx = tid; idx < 46 * 128; idx += NTHR) { const int rr = idx >> 7, ch = idx & 127, tt = t0 - 15 + rr; u32x4 v = (u32x4){0u, 0u, 0u, 0u};
            if (tt >= ss && tt < se) v = *(const u32x4*)(aglu + (size_t)tt * DM + ch * 8);
            *(u32x4*)(smem + rr * 2048 + ch * 16) = v; }
        __syncthreads();
        float a0[16], a1[16];
#pragma unroll
        for (int t = 0; t < 16; ++t) { a0[t] = bias.x; a1[t] = bias.y; }
#pragma unroll
        for (int rr = 0; rr < 46; ++rr) { const unsigned uv = *(const unsigned*)(smem + rr * 2048 + c0 * 2); const float lo = bf_lo(uv), hi = bf_hi(uv);
#pragma unroll
            for (int t = 0; t < 16; ++t) { const int j = rr - t; if (j >= 0 && j < 31) { a0[t] += w0[j] * lo; a1[t] += w1[j] * hi; } } }
#pragma unroll
        for (int t = 0; t < 16; ++t) { const float s = wave_sum(a0[t] * a0[t] + a1[t] * a1[t]); if (lane == 0) red[wv * 16 + t] = s; }
        __syncthreads();
        if (tid < 16) { float s = 0.f;
#pragma unroll
            for (int q = 0; q < 8; ++q) s += red[q * 16 + tid];
            rst[tid] = rsqrtf(s * (1.f / DM) + EPSV); }
        __syncthreads();
#pragma unroll
        for (int t = 0; t < 16; ++t) { const float r = rst[t]; *(unsigned*)(aconv + (size_t)(t0 + t) * DM + c0) = cvt_pk_bf16(siluf_(a0[t] * r * gn.x), siluf_(a1[t] * r * gn.y)); }
        __syncthreads();
    }
}

__device__ void ret_phase(const Params& p, int l, unsigned char* smem) {
    LAS unsigned char* lds = (LAS unsigned char*)smem;
    const int tid = tid_opaque(), lane = tid & 63, w = __builtin_amdgcn_readfirstlane(tid >> 6), fr = lane & 15, fq = lane >> 4;
    const bf16_t* Qg = (const bf16_t*)(p.ws + WS_Q); const bf16_t* Kg = (const bf16_t*)(p.ws + WS_K); const bf16_t* KTg = (const bf16_t*)(p.ws + WS_KT); const bf16_t* VTg = (const bf16_t*)(p.ws + WS_VT);
    constexpr int QOFF = 0, KTOFF = 65536;
    const unsigned voffQ = (unsigned)(((2 * w + (lane >> 5)) * DM + (((lane & 31) ^ ((2 * w + (lane >> 5)) & 15))) * 8) * 2);
    const unsigned voffKT = (unsigned)(((4 * w + (lane >> 4)) * TT + (((lane & 15) ^ ((((2 * w + (lane >> 5)) & 12)) | ((lane >> 4) & 3)))) * 8) * 2);
    const unsigned voffK = (unsigned)(((16 * w + fr) * DM + fq * 8) * 2);
    const unsigned voffV = (unsigned)(((16 * w + fr) * TT + fq * 8) * 2);
    const unsigned voffY = (unsigned)(((4 * fq) * VW + 16 * w + fr) * 2);
    int xb[4];
#pragma unroll
    for (int k4 = 0; k4 < 4; ++k4) xb[k4] = ((k4 * 4 + fq) ^ fr) * 16;
    for (int it = blockIdx.x; it < 768; it += gridDim.x) {
        int es, dir, h, bb, tok0, nch; const bool lat = it < 256;
        { const int j = lat ? it : it - 256, x = j & 7, y = j >> 3; es = y & 3; const int cmb = (y >> 2) * 8 + x; dir = cmb & 1; h = (cmb >> 1) & 3; bb = cmb >> 3;
          tok0 = lat ? TC + bb * 2048 : bb * 256; nch = lat ? 16 : 2; }
        const float dl = p.in[14][l * 8 + dir * 4 + h]; const float lg2 = -log1pf(expf(-dl)) * 1.4426950408889634f;
        const float sdec = exp2f(128.f * lg2);
        const float zl = dir ? -lg2 : lg2, zb2 = (float)(dir ? 128 - 4 * fq : 4 * fq + 1) * lg2, kb2 = (float)(dir ? 8 * fq : 127 - 8 * fq) * lg2;
        const int pbase = dir ? (16 * w + 4 * fq - fr) : (fr - 16 * w - 4 * fq);
        f32x4 S[16];
        const unsigned voffS = (unsigned)((8 * fq * 512 + 16 * w + fr) * 4);
        if (lat) { const float* sp = p.in[3] + ((((size_t)bb * 2 + l) * 2 + dir) * 4 + h) * 256 * 512 + es * 128;
#pragma unroll
            for (int D = 0; D < 16; ++D)
#pragma unroll
                for (int r = 0; r < 4; ++r) S[D][r] = __builtin_nontemporal_load((const float*)((const char*)(sp + ((D >> 1) * 32 + 4 * (D & 1) + r) * 512) + voffS));
        } else {
#pragma unroll
            for (int D = 0; D < 16; ++D) S[D] = (f32x4){0.f, 0.f, 0.f, 0.f};
        }
        bf16_t* Yg = (bf16_t*)(p.ws + (dir ? WS_YB : WS_YF));
        for (int s = 0; s < nch; ++s) {
            const int c = dir ? nch - 1 - s : s, r0 = tok0 + c * 128;
            { const bf16_t* qu = Qg + (size_t)r0 * DM + h * 256; const bf16_t* ku = KTg + (size_t)(h * 256) * TT + r0;
#pragma unroll
              for (int n = 0; n < 8; ++n) {
                  __builtin_amdgcn_global_load_lds((const unsigned*)((const char*)(qu + (size_t)(n * 16) * DM) + voffQ), (LAS unsigned*)(lds + QOFF + (n * 8 + w) * 1024), 16, 0, 0);
                  __builtin_amdgcn_global_load_lds((const unsigned*)((const char*)(ku + (size_t)(n * 32) * TT) + voffKT), (LAS unsigned*)(lds + KTOFF + (n * 8 + w) * 1024), 16, 0, 0); } }
            bf16x8 Kf[8], Vf[4];
            { const char* kb = (const char*)(Kg + (size_t)r0 * DM + h * 256) + voffK;
#pragma unroll
              for (int ks = 0; ks < 4; ++ks) Kf[ks] = *(const bf16x8*)(kb + ks * 64); }
            asm volatile("s_waitcnt vmcnt(0)" ::: "memory");
            __syncthreads();
            { const char* kb = (const char*)(Kg + (size_t)r0 * DM + h * 256) + voffK;
#pragma unroll
              for (int ks = 4; ks < 8; ++ks) Kf[ks] = *(const bf16x8*)(kb + ks * 64); }
            f32x4 Z[8], PT[8];
#pragma unroll
            for (int i8 = 0; i8 < 8; ++i8) { Z[i8] = (f32x4){0.f, 0.f, 0.f, 0.f}; PT[i8] = (f32x4){0.f, 0.f, 0.f, 0.f}; }
#define QFRAG(ks, i8) (*(const LAS bf16x8*)(lds + QOFF + xb[(ks) & 3] + fr * 512 + (i8) * 8192 + ((ks) >> 2) * 256))
            { bf16x8 qa[4], qb[4];
#pragma unroll
              for (int j = 0; j < 4; ++j) qa[j] = QFRAG(0, j);
#pragma unroll
              for (int ks = 0; ks < 8; ++ks) { u32x4 t; t.x = cvt_pk_bf16(S[2 * ks][0], S[2 * ks][1]); t.y = cvt_pk_bf16(S[2 * ks][2], S[2 * ks][3]); t.z = cvt_pk_bf16(S[2 * ks + 1][0], S[2 * ks + 1][1]); t.w = cvt_pk_bf16(S[2 * ks + 1][2], S[2 * ks + 1][3]);
                  const bf16x8 Sb = __builtin_bit_cast(bf16x8, t);
#pragma unroll
                  for (int j = 0; j < 4; ++j) qb[j] = QFRAG(ks, 4 + j);
                  __builtin_amdgcn_sched_barrier(0);
#pragma unroll
                  for (int j = 0; j < 4; ++j) { Z[j] = __builtin_amdgcn_mfma_f32_16x16x32_bf16(qa[j], Sb, Z[j], 0, 0, 0); PT[j] = __builtin_amdgcn_mfma_f32_16x16x32_bf16(Kf[ks], qa[j], PT[j], 0, 0, 0); }
                  __builtin_amdgcn_sched_barrier(0);
                  if (ks < 7) {
#pragma unroll
                      for (int j = 0; j < 4; ++j) qa[j] = QFRAG(ks + 1, j); }
                  __builtin_amdgcn_sched_barrier(0);
#pragma unroll
                  for (int j = 0; j < 4; ++j) { Z[4 + j] = __builtin_amdgcn_mfma_f32_16x16x32_bf16(qb[j], Sb, Z[4 + j], 0, 0, 0); PT[4 + j] = __builtin_amdgcn_mfma_f32_16x16x32_bf16(Kf[ks], qb[j], PT[4 + j], 0, 0, 0); }
                  __builtin_amdgcn_sched_barrier(0); } }
#undef QFRAG
            { const char* vb = (const char*)(VTg + (size_t)(h * 512 + es * 128) * TT + r0) + voffV;
#pragma unroll
              for (int ks = 0; ks < 4; ++ks) Vf[ks] = *(const bf16x8*)(vb + ks * 64); }
            float zb2_ = zb2, zl_ = zl, kb2_ = kb2; int pbase_ = pbase;
            asm volatile("" : "+v"(zb2_), "+v"(zl_), "+v"(kb2_), "+v"(pbase_));
            { f32x4 zf, pf; const float z16 = __builtin_amdgcn_exp2f(16.f * zl_);
#pragma unroll
              for (int r = 0; r < 4; ++r) { zf[r] = __builtin_amdgcn_exp2f(zb2_ + (float)r * zl_); pf[r] = __builtin_amdgcn_exp2f((float)(pbase_ + (dir ? r : -r)) * lg2); }
#pragma unroll
              for (int i8 = 0; i8 < 8; ++i8) {
#pragma unroll
                  for (int r = 0; r < 4; ++r) { Z[i8][r] *= zf[r];
                      const int df = pbase_ + (dir ? -(i8 * 16 - r) : (i8 * 16 - r)); PT[i8][r] = df >= 0 ? PT[i8][r] * pf[r] : 0.f; }
                  zf *= z16; pf *= z16; } }
            __syncthreads();
#pragma unroll
            for (int i8 = 0; i8 < 8; ++i8) { const int i = i8 * 16 + fr; u32x2 t; t.x = cvt_pk_bf16(PT[i8][0], PT[i8][1]); t.y = cvt_pk_bf16(PT[i8][2], PT[i8][3]);
                *(LAS u32x2*)(lds + QOFF + i * 256 + (((2 * w + (fq >> 1)) ^ fr)) * 16 + (fq & 1) * 8) = t; }
            __syncthreads();
#define PFRAG(i8, ks) (*(const LAS bf16x8*)(lds + QOFF + xb[ks] + fr * 256 + (i8) * 4096))
            { bf16x8 pa[4], pb[4];
#pragma unroll
              for (int ks = 0; ks < 4; ++ks) pa[ks] = PFRAG(0, ks);
#pragma unroll
              for (int i8 = 0; i8 < 8; i8 += 2) {
#pragma unroll
                  for (int ks = 0; ks < 4; ++ks) pb[ks] = PFRAG(i8 + 1, ks);
                  __builtin_amdgcn_sched_barrier(0);
#pragma unroll
                  for (int ks = 0; ks < 4; ++ks) Z[i8] = __builtin_amdgcn_mfma_f32_16x16x32_bf16(pa[ks], Vf[ks], Z[i8], 0, 0, 0);
                  __builtin_amdgcn_sched_barrier(0);
                  if (i8 < 6) {
#pragma unroll
                      for (int ks = 0; ks < 4; ++ks) pa[ks] = PFRAG(i8 + 2, ks); }
                  __builtin_amdgcn_sched_barrier(0);
#pragma unroll
                  for (int ks = 0; ks < 4; ++ks) Z[i8 + 1] = __builtin_amdgcn_mfma_f32_16x16x32_bf16(pb[ks], Vf[ks], Z[i8 + 1], 0, 0, 0);
                  __builtin_amdgcn_sched_barrier(0); } }
#undef PFRAG
#pragma unroll
            for (int i8 = 0; i8 < 8; ++i8)
#pragma unroll
                for (int r = 0; r < 4; ++r) *(bf16_t*)((char*)(Yg + (size_t)(r0 + i8 * 16 + r) * VW + h * 512 + es * 128) + voffY) = bf16_1(Z[i8][r]);
            bf16x8 Vs[4];
            float kf8[8], kstep[4];
#pragma unroll
            for (int e = 0; e < 8; ++e) kf8[e] = __builtin_amdgcn_exp2f(kb2_ - (float)e * zl_);
            { const float k32 = __builtin_amdgcn_exp2f(-32.f * zl_); kstep[0] = 1.f; kstep[1] = k32; kstep[2] = k32 * k32; kstep[3] = kstep[2] * k32; }
#pragma unroll
            for (int ks = 0; ks < 4; ++ks) { const u32x4 t = __builtin_bit_cast(u32x4, Vf[ks]); float f[8]; f[0] = bf_lo(t.x); f[1] = bf_hi(t.x); f[2] = bf_lo(t.y); f[3] = bf_hi(t.y); f[4] = bf_lo(t.z); f[5] = bf_hi(t.z); f[6] = bf_lo(t.w); f[7] = bf_hi(t.w);
#pragma unroll
                for (int e = 0; e < 8; ++e) f[e] *= kf8[e] * kstep[ks];
                u32x4 o; o.x = cvt_pk_bf16(f[0], f[1]); o.y = cvt_pk_bf16(f[2], f[3]); o.z = cvt_pk_bf16(f[4], f[5]); o.w = cvt_pk_bf16(f[6], f[7]); Vs[ks] = __builtin_bit_cast(bf16x8, o); }
#define TFRAG(D, ks) (*(const LAS bf16x8*)(lds + KTOFF + xb[ks] + (8 * (fr >> 2) + (fr & 3)) * 256 + ((D) >> 1) * 8192 + ((D) & 1) * 1024))
            { bf16x8 ta[4], tb[4];
#pragma unroll
              for (int ks = 0; ks < 4; ++ks) ta[ks] = TFRAG(0, ks);
#pragma unroll
              for (int D = 0; D < 16; D += 2) { S[D] *= sdec; S[D + 1] *= sdec;
#pragma unroll
                  for (int ks = 0; ks < 4; ++ks) tb[ks] = TFRAG(D + 1, ks);
                  __builtin_amdgcn_sched_barrier(0);
#pragma unroll
                  for (int ks = 0; ks < 4; ++ks) S[D] = __builtin_amdgcn_mfma_f32_16x16x32_bf16(ta[ks], Vs[ks], S[D], 0, 0, 0);
                  __builtin_amdgcn_sched_barrier(0);
                  if (D < 14) {
#pragma unroll
                      for (int ks = 0; ks < 4; ++ks) ta[ks] = TFRAG(D + 2, ks); }
                  __builtin_amdgcn_sched_barrier(0);
#pragma unroll
                  for (int ks = 0; ks < 4; ++ks) S[D + 1] = __builtin_amdgcn_mfma_f32_16x16x32_bf16(tb[ks], Vs[ks], S[D + 1], 0, 0, 0);
                  __builtin_amdgcn_sched_barrier(0); } }
#undef TFRAG
            __syncthreads();
        }
        if (!lat) { float* so = p.out + (size_t)TT * DM + ((((size_t)bb * 2 + l) * 2 + dir) * 4 + h) * 256 * 512 + es * 128;
#pragma unroll
            for (int D = 0; D < 16; ++D)
#pragma unroll
                for (int r = 0; r < 4; ++r) __builtin_nontemporal_store(S[D][r], (float*)((char*)(so + ((D >> 1) * 32 + 4 * (D & 1) + r) * 512) + voffS)); }
    }
}

__device__ void comb_phase(const Params& p) {
    const int tid = tid_opaque(), lane = tid & 63, gw = blockIdx.x * 8 + (tid >> 6), nw = gridDim.x * 8;
    const bf16_t* yf = (const bf16_t*)(p.ws + WS_YF); const bf16_t* yb = (const bf16_t*)(p.ws + WS_YB); const bf16_t* rg = (const bf16_t*)(p.ws + WS_RG); bf16_t* ar = (bf16_t*)(p.ws + WS_Q);
    for (int tok = gw; tok < TT; tok += nw) {
        u32x4 a[4], b[4], g[4];
#pragma unroll
        for (int h = 0; h < 4; ++h) { const size_t off = (size_t)tok * VW + h * 512 + lane * 8; a[h] = __builtin_nontemporal_load((const u32x4*)(yf + off)); b[h] = __builtin_nontemporal_load((const u32x4*)(yb + off)); g[h] = __builtin_nontemporal_load((const u32x4*)(rg + off)); }
#pragma unroll
        for (int h = 0; h < 4; ++h) {
            float y[8];
#pragma unroll
            for (int e = 0; e < 4; ++e) { y[2 * e] = bf_lo(a[h][e]) + bf_lo(b[h][e]); y[2 * e + 1] = bf_hi(a[h][e]) + bf_hi(b[h][e]); }
            float s = 0.f;
#pragma unroll
            for (int e = 0; e < 8; ++e) s += y[e];
            const float mu = wave_sum(s) * (1.f / 512.f); float v = 0.f;
#pragma unroll
            for (int e = 0; e < 8; ++e) { y[e] -= mu; v += y[e] * y[e]; }
            const float rstd = rsqrtf(wave_sum(v) * (1.f / 512.f) + EPSV);
            u32x4 o;
#pragma unroll
            for (int e = 0; e < 4; ++e) o[e] = cvt_pk_bf16(y[2 * e] * rstd * bf_lo(g[h][e]), y[2 * e + 1] * rstd * bf_hi(g[h][e]));
            *(u32x4*)(ar + (size_t)tok * VW + h * 512 + lane * 8) = o;
        }
    }
}


#define XB_TMO      128
#define XB_XCNT(j)  (256  + 64 * (j))
#define XB_XSUB(j)  (1280 + 64 * (j))
#define XB_XGEN(j)  (2304 + 64 * (j))
#define XB_TOP      3328
#define XB_TOPGEN   3392
#define XCD_BAR_WORDS 3456
#define XB_SPIN_CAP (1u << 18)
__device__ __forceinline__ unsigned xb_ld(unsigned* p)              { return __hip_atomic_load(p, __ATOMIC_RELAXED, __HIP_MEMORY_SCOPE_AGENT); }
__device__ __forceinline__ unsigned xb_add(unsigned* p, unsigned v) { return __hip_atomic_fetch_add(p, v, __ATOMIC_RELAXED, __HIP_MEMORY_SCOPE_AGENT); }
__device__ __forceinline__ unsigned xb_xcc_id() { return (unsigned)__builtin_amdgcn_s_getreg((3 << 11) | 20) & 0xFu; }
#define XB_SPIN(cond, bar) do { unsigned _sp = 0; while (cond) { __builtin_amdgcn_s_sleep(1); \
    if ((++_sp & 255u) == 0u) { if (xb_ld(&(bar)[XB_TMO])) break; if (_sp > XB_SPIN_CAP) { atomicAdd(&(bar)[XB_TMO], 1u); break; } } } } while (0)
struct XcdBarrier { unsigned* bar; unsigned x; volatile LAS unsigned* st; };
__device__ __forceinline__ XcdBarrier xcd_barrier_post(unsigned* bar, volatile LAS unsigned* st) {
    XcdBarrier b; b.bar = bar; b.x = xb_xcc_id(); b.st = st;
    if (threadIdx.x == 0) (void)xb_add(&bar[XB_XCNT(b.x)], 1u);
    return b;
}
__device__ __forceinline__ void xcd_barrier_complete(unsigned* bar, unsigned x, unsigned& nloc, unsigned& nx) {
    const unsigned G = gridDim.x * gridDim.y * gridDim.z;
    unsigned sum, cnt, mine, sp = 0u;
    for (;;) {
        sum = 0u; cnt = 0u; mine = 0u;
#pragma unroll
        for (unsigned j = 0; j < 16; ++j) { const unsigned c = xb_ld(&bar[XB_XCNT(j)]); sum += c; cnt += (c > 0u) ? 1u : 0u; mine = (j == x) ? c : mine; }
        if (sum == G) break;
        __builtin_amdgcn_s_sleep(1);
        if ((++sp & 255u) == 0u) { if (xb_ld(&bar[XB_TMO])) break; if (sp > XB_SPIN_CAP) { atomicAdd(&bar[XB_TMO], 1u); break; } }
    }
    nloc = mine > 0u ? mine : 1u; nx = cnt > 0u ? cnt : 1u;
}
__device__ __forceinline__ void xcd_barrier(const XcdBarrier& b) {
    asm volatile("s_waitcnt vmcnt(0)" ::: "memory");
    __syncthreads();
    if (threadIdx.x == 0) {
        unsigned* bar = b.bar;
        __builtin_amdgcn_s_waitcnt(0);
        unsigned nloc = b.st[0], nx = b.st[1];
        if (nloc == 0u) { xcd_barrier_complete(bar, b.x, nloc, nx); b.st[0] = nloc; b.st[1] = nx; }
        const unsigned old = xb_add(&bar[XB_XSUB(b.x)], 1u);
        const unsigned gen = old / nloc;
        if (old + 1u == (gen + 1u) * nloc) {
            __builtin_amdgcn_fence(__ATOMIC_RELEASE, "agent");
            asm volatile("s_waitcnt vmcnt(0)" ::: "memory");
            const unsigned og = xb_add(&bar[XB_TOP], 1u);
            const unsigned tg = og / nx;
            if (og + 1u == (tg + 1u) * nx) xb_add(&bar[XB_TOPGEN], 1u);
            else XB_SPIN(xb_ld(&bar[XB_TOPGEN]) == tg, bar);
            __builtin_amdgcn_fence(__ATOMIC_ACQUIRE, "agent");
            xb_add(&bar[XB_XGEN(b.x)], 1u);
            asm volatile("s_waitcnt vmcnt(0)" ::: "memory");
        } else {
            XB_SPIN(xb_ld(&bar[XB_XGEN(b.x)]) == gen, bar);
            __builtin_amdgcn_fence(__ATOMIC_ACQUIRE, "agent");
            asm volatile("s_waitcnt vmcnt(0)" ::: "memory");
        }
    }
    __syncthreads();
}

__global__ void __launch_bounds__(NTHR) mega(Params p) {
    __shared__ __attribute__((aligned(16))) unsigned char smem[131072];
    cg::grid_group grid = cg::this_grid();
    LAS unsigned char* lds = (LAS unsigned char*)smem;
    unsigned char* ws = p.ws;
    float* xbuf = p.out;
    const float* modb = (const float*)(ws + WS_MOD);
    pg8::StaticOrder so;
    __shared__ __attribute__((aligned(16))) unsigned xb_st[4];
    if (threadIdx.x < 4) xb_st[threadIdx.x] = 0u;
    __syncthreads();
    if (blockIdx.x == 1) { const int t = tid_opaque(); for (int i = t; i < XCD_BAR_WORDS; i += NTHR) ((unsigned*)(ws + WS_BAR))[i] = 0u; }
    phase0(p, smem);
    grid.sync();
    const XcdBarrier xbar = xcd_barrier_post((unsigned*)(ws + WS_BAR), (volatile LAS unsigned*)xb_st);
    for (int l = 0; l < 2; ++l) {
        const unsigned char* wl = ws + WS_W + (size_t)l * WL_SZ;
        const float* modl = modb + (size_t)l * 9 * 6144;
        const float* xa = l == 0 ? p.in[0] : xbuf; const float* xb = l == 0 ? p.in[1] : xbuf + (size_t)TC * DM;
        norm_mod_phase(xa, xb, (bf16_t*)(ws + WS_R1), p.in[5] + l * DM, modl, 0);
        xcd_barrier(xbar);
        { pg8::Gemm g{(const bf16_t*)(ws + WS_R1), (const bf16_t*)(wl + WL_IN), TT, PW, DM, nullptr, nullptr}; so.init(TT, PW, gridDim.x, blockIdx.x);
          EpiG1 e{(bf16_t*)(ws + WS_R2), (bf16_t*)(ws + WS_Q), (bf16_t*)(ws + WS_K), (bf16_t*)(ws + WS_KT), (bf16_t*)(ws + WS_VT), (bf16_t*)(ws + WS_RG), (bf16_t*)(ws + WS_GATE), (const float*)(ws + WS_ROPE), (const float*)(ws + WS_ROPE) + 4096};
          pg8::gemm_phase(lds, g, so, e); }
        xcd_barrier(xbar);
        ret_phase(p, l, smem);
        conv_phase(p, l, smem);
        xcd_barrier(xbar);
        { pg8::Gemm g{(const bf16_t*)(ws + WS_R1), (const bf16_t*)(wl + WL_CONV), TT, DM, DM, nullptr, nullptr}; so.init(TT, DM, gridDim.x, blockIdx.x);
          EpiE1 e{(bf16_t*)(ws + WS_KT), (const bf16_t*)(ws + WS_GATE)};
          comb_phase(p);
          __syncthreads();
          pg8::gemm_phase(lds, g, so, e); }
        xcd_barrier(xbar);
        { pg8::Gemm g{(const bf16_t*)(ws + WS_Q), (const bf16_t*)(wl + WL_RET), TT, DM, VW, nullptr, nullptr}; so.init(TT, DM, gridDim.x, blockIdx.x);
          EpiE2 e{(const bf16_t*)(ws + WS_KT), (const bf16_t*)(ws + WS_GATE), (bf16_t*)(ws + WS_R2)};
          pg8::gemm_phase(lds, g, so, e); }
        xcd_barrier(xbar);
        { pg8::Gemm g{(const bf16_t*)(ws + WS_R2), (const bf16_t*)(wl + WL_OUT), TT, DM, DM, nullptr, nullptr}; so.init(TT, DM, gridDim.x, blockIdx.x);
          EpiResT<false> e{xa, xb, xbuf, modl + 2 * 1024};
          pg8::gemm_phase(lds, g, so, e); }
        xcd_barrier(xbar);
        norm_mod_phase(xbuf, xbuf + (size_t)TC * DM, (bf16_t*)(ws + WS_R1), p.in[6] + l * DM, modl, 3);
        xcd_barrier(xbar);
        { pg8::Gemm g{(const bf16_t*)(ws + WS_R1), (const bf16_t*)(wl + WL_M1), TT, MLPW, DM, nullptr, nullptr}; so.init(TT, MLPW, gridDim.x, blockIdx.x);
          EpiF1 e{(bf16_t*)(ws + WS_RG)};
          pg8::gemm_phase(lds, g, so, e); }
        xcd_barrier(xbar);
        { pg8::Gemm g{(const bf16_t*)(ws + WS_RG), (const bf16_t*)(wl + WL_M2), TT, DM, MLPW, (unsigned long long*)(ws + WS_DUMP), (unsigned*)(ws + WS_CNT)}; so.init(TT, DM, gridDim.x, blockIdx.x, true);
          EpiResT<true> e{xbuf, xbuf + (size_t)TC * DM, xbuf, modl + 5 * 1024};
          pg8::gemm_phase(lds, g, so, e); }
        xcd_barrier(xbar);
    }
    final_norm_phase(xbuf, p.in[19]);
}

extern "C" void kernel_launch(void* const* d_in, const int* in_sizes, int n_in, void* d_out, int out_size, void* d_ws, size_t ws_size, hipStream_t stream) {
    static int grid_blocks = 0;
    if (!grid_blocks) {
        int dev = 0, cus = 0, per_cu = 0;
        (void)hipGetDevice(&dev);
        (void)hipDeviceGetAttribute(&cus, hipDeviceAttributeMultiprocessorCount, dev);
        (void)hipOccupancyMaxActiveBlocksPerMultiprocessor(&per_cu, mega, NTHR, 0);
        if (per_cu < 1) per_cu = 1;
        grid_blocks = cus;
    }
    if (n_in != 20 || ws_size < WS_END) return;
    Params p{};
    for (int i = 0; i < 20; ++i) p.in[i] = (const float*)d_in[i];
    p.out = (float*)d_out; p.ws = (unsigned char*)d_ws;
    void* args[] = {&p};
    (void)hipLaunchCooperativeKernel((void*)mega, dim3(grid_blocks), dim3(NTHR), args, 0, stream);
}
```

```cpp
#include <hip/hip_runtime.h>
#include <hip/hip_cooperative_groups.h>
namespace cg = cooperative_groups;

#define LAS __attribute__((address_space(3)))
typedef unsigned short bf16_t;
typedef short bf16x8 __attribute__((ext_vector_type(8)));
typedef float f32x4 __attribute__((ext_vector_type(4)));
typedef float f32x2 __attribute__((ext_vector_type(2)));
typedef unsigned u32x2 __attribute__((ext_vector_type(2)));
typedef unsigned u32x4 __attribute__((ext_vector_type(4)));

constexpr int DM = 1024, TC = 4096, TL = 16384, TT = 20480, PW = 10240, MLPW = 4096, VW = 2048;
constexpr int NTHR = 512;
constexpr float EPSV = 1e-6f;
constexpr size_t MiB = (size_t)1 << 20;
constexpr size_t WS_W = 0;
constexpr size_t WL_IN = 0, WL_CONV = 20 * MiB, WL_RET = 22 * MiB, WL_OUT = 26 * MiB, WL_M1 = 28 * MiB, WL_M2 = 36 * MiB, WL_SZ = 44 * MiB;
constexpr size_t WS_MOD = 88 * MiB;
constexpr size_t WS_ROPE = 88 * MiB + 512 * 1024;
constexpr size_t WS_R1 = 90 * MiB;
constexpr size_t WS_R2 = 130 * MiB;
constexpr size_t WS_Q = 170 * MiB;
constexpr size_t WS_K = 210 * MiB;
constexpr size_t WS_KT = 250 * MiB;
constexpr size_t WS_VT = 290 * MiB;
constexpr size_t WS_RG = 370 * MiB;
constexpr size_t WS_GATE = 450 * MiB;
constexpr size_t WS_YF = 530 * MiB;
constexpr size_t WS_YB = 610 * MiB;
constexpr size_t WS_BAR = 88 * MiB + 448 * 1024;
constexpr size_t WS_DUMP = 690 * MiB;
constexpr size_t WS_CNT = 88 * MiB + 480 * 1024;
constexpr size_t WS_END = 754 * MiB;

struct Params { const float* in[20]; float* out; unsigned char* ws; };

typedef __bf16 bf16x2_t __attribute__((ext_vector_type(2)));
__device__ __forceinline__ unsigned cvt_pk_bf16(float lo, float hi) { const f32x2 f = {lo, hi}; const bf16x2_t v = __builtin_convertvector(f, bf16x2_t); return __builtin_bit_cast(unsigned, v); }
__device__ __forceinline__ float bf_lo(unsigned u) { return __uint_as_float(u << 16); }
__device__ __forceinline__ float bf_hi(unsigned u) { return __uint_as_float(u & 0xffff0000u); }
__device__ __forceinline__ float sigmoidf_(float x) { return __builtin_amdgcn_rcpf(1.f + __expf(-x)); }
__device__ __forceinline__ float siluf_(float x) { return x * sigmoidf_(x); }
__device__ __forceinline__ float wave_sum(float v) {
#pragma unroll
    for (int o = 32; o > 0; o >>= 1) v += __shfl_xor(v, o, 64);
    return v;
}
__device__ __forceinline__ int tid_opaque() { int t = threadIdx.x; asm volatile("" : "+v"(t)); return t; }
__device__ __forceinline__ int row_group(int row) { return row < TC ? 0 : 1 + ((row - TC) >> 11); }

namespace pg8 {
constexpr int BM = 256, BK = 64, HALF = 128, HTB = HALF * BK * 2, NXCD = 8, WGM = 8;
__device__ __forceinline__ int lds_byte(int r, int c) { const int st = (r >> 4) * 2 + (c >> 5), rr = r & 15, cc = c & 31, ob = rr * 64 + cc * 2; return st * 1024 + (ob ^ (((ob >> 9) & 1) << 5)); }
__device__ __forceinline__ void stage_rc(int b, int& R, int& C) { const int st = b / 1024, sb = b % 1024, swz = sb ^ (((sb >> 9) & 1) << 5); R = (st >> 1) * 16 + swz / 64; C = (st & 1) * 32 + (swz % 64) / 2; }
__device__ __forceinline__ int perm32(int rho) { const int n = rho >> 4, i = rho & 15; return 8 * (i >> 2) + 4 * n + (i & 3); }
struct Unit { int pm, pn, kq, ti; };
struct Gemm { const bf16_t* A; const bf16_t* Bt; int M, N, K; unsigned long long* dump; unsigned* cnt; };
struct StaticOrder {
    int nM, nN, nwg, G, c; bool split;
    __device__ void init(int M, int N, int G_, int c_, bool allow_split = false) { nM = M / BM; nN = N / BM; nwg = nM * nN; G = G_; c = c_; split = allow_split && nwg == 320 && G == 256; }
    __device__ bool next(int i, Unit& u) const {
        long L; int kq = -1, ti = 0;
        if (split) { if (i == 0) L = c; else if (i == 1) { ti = c >> 2; kq = c & 3; L = G + ti; } else return false; }
        else L = (long)i * G + c;
        if (L >= nwg) return false;
        int wgid = (int)L; { const int q = nwg / NXCD, r = nwg % NXCD, xcd = wgid % NXCD, off = wgid / NXCD; wgid = (xcd < r ? xcd * (q + 1) : r * (q + 1) + (xcd - r) * q) + off; }
        const int nig = WGM * nN, gid = wgid / nig, fm = gid * WGM, gsz = (nM - fm) < WGM ? (nM - fm) : WGM;
        u.pm = fm + ((wgid % nig) % gsz); u.pn = (wgid % nig) / gsz; u.kq = kq; u.ti = ti; return true;
    }
};

template <class Epi>
__device__ __forceinline__ void gemm_phase(LAS unsigned char* lds, const Gemm g, const StaticOrder& S, const Epi& E) {
    const int tid = tid_opaque(), wid = __builtin_amdgcn_readfirstlane(tid >> 6), lane = tid & 63, wr = wid >> 2, wc = wid & 3, fr = lane & 15, fq = lane >> 4;
    const int K = g.K;
    unsigned voffA[2], voffB[2];
#pragma unroll
    for (int i = 0; i < 2; ++i) { int R, C; stage_rc(tid * 16 + i * 8192, R, C); const int Rb = (R & ~31) + perm32(R & 31); voffA[i] = (unsigned)(R * K + C) * 2u; voffB[i] = (unsigned)(Rb * K + C) * 2u; }
    const size_t kstep = (size_t)(BK * 2);
    const size_t hstep = (size_t)HALF * K * 2;
    const size_t tstep = 2 * hstep;
    const unsigned ldsw = (unsigned)wid * 1024u;
    const int aoff = lds_byte(wr * 64 + fr, fq * 8), boff = lds_byte(wc * 32 + fr, fq * 8);
#define PG8_SA(b, h) (((b) * 2 + (h)) * HTB)
#define PG8_SB(b, h) ((4 + (b) * 2 + (h)) * HTB)
#define PG8_STAGE(bufoff, gbase, voff) do { _Pragma("unroll") for (int _i = 0; _i < 2; ++_i) \
        __builtin_amdgcn_global_load_lds((const unsigned*)((const char*)(gbase) + (voff)[_i]), (LAS unsigned*)(lds + (bufoff) + ldsw + _i * 8192), 16, 0, 0); } while (0)
#define PG8_LDA(dst, b, h) do { _Pragma("unroll") for (int m = 0; m < 4; ++m) _Pragma("unroll") for (int k = 0; k < 2; ++k) dst[m][k] = *(const LAS bf16x8*)(lds + PG8_SA(b, h) + aoff + m * 2048 + k * 1024); } while (0)
#define PG8_LDB(dst, b, h) do { _Pragma("unroll") for (int n = 0; n < 2; ++n) _Pragma("unroll") for (int k = 0; k < 2; ++k) dst[n][k] = *(const LAS bf16x8*)(lds + PG8_SB(b, h) + boff + n * 2048 + k * 1024); } while (0)
#define PG8_MMA(ai, bj, At, Bt) do { __builtin_amdgcn_s_setprio(1); _Pragma("unroll") for (int m = 0; m < 4; ++m) _Pragma("unroll") for (int n = 0; n < 2; ++n) _Pragma("unroll") for (int k = 0; k < 2; ++k) \
        acc[ai][bj][m][n] = __builtin_amdgcn_mfma_f32_16x16x32_bf16(Bt[n][k], At[m][k], acc[ai][bj][m][n], 0, 0, 0); __builtin_amdgcn_s_setprio(0); } while (0)
#define PG8_WAIT_V(n) asm volatile("s_waitcnt vmcnt(" #n ")" ::: "memory")
#define PG8_WAIT_L(n) asm volatile("s_waitcnt lgkmcnt(" #n ")" ::: "memory")
#define PG8_BAR __builtin_amdgcn_s_barrier()
#define PG8_SCHED __builtin_amdgcn_sched_barrier(0)
    Unit cur, nxt; int ui = 0;
    if (!S.next(0, cur)) return;
    f32x4 acc[2][2][4][2];
#pragma unroll
    for (int a = 0; a < 2; ++a)
#pragma unroll
        for (int b = 0; b < 2; ++b)
#pragma unroll
            for (int m = 0; m < 4; ++m)
#pragma unroll
                for (int n = 0; n < 2; ++n) acc[a][b][m][n] = (f32x4){0.f, 0.f, 0.f, 0.f};
    bf16x8 At[4][2], B0[2][2], B1[2][2];
    const char* cA = E.swapped(cur) ? (const char*)g.Bt + (size_t)cur.pn * tstep : (const char*)g.A + (size_t)cur.pm * tstep;
    const char* cB = E.swapped(cur) ? (const char*)g.A + (size_t)cur.pm * tstep : (const char*)g.Bt + (size_t)cur.pn * tstep;
    const size_t qstep = (size_t)(K >> 2) * 2;
    if (cur.kq >= 0) { cA += cur.kq * qstep; cB += cur.kq * qstep; }
    PG8_STAGE(PG8_SB(0, 0), cB, voffB); PG8_STAGE(PG8_SA(0, 0), cA, voffA); PG8_STAGE(PG8_SB(0, 1), cB + hstep, voffB); PG8_STAGE(PG8_SA(0, 1), cA + hstep, voffA);
    if (wr == 1) PG8_BAR;
    PG8_WAIT_V(4); PG8_BAR;
    PG8_STAGE(PG8_SB(1, 0), cB + kstep, voffB); PG8_STAGE(PG8_SA(1, 0), cA + kstep, voffA); PG8_STAGE(PG8_SB(1, 1), cB + hstep + kstep, voffB);
    PG8_WAIT_V(6); PG8_BAR;
    for (;;) {
        const bool has_next = S.next(ui + 1, nxt);
        const bool nsw = has_next && E.swapped(nxt);
        const char* nA = has_next ? (nsw ? (const char*)g.Bt + (size_t)nxt.pn * tstep : (const char*)g.A + (size_t)nxt.pm * tstep) : cA;
        const char* nB = has_next ? (nsw ? (const char*)g.A + (size_t)nxt.pm * tstep : (const char*)g.Bt + (size_t)nxt.pn * tstep) : cB;
        if (has_next && nxt.kq >= 0) { nA += nxt.kq * qstep; nB += nxt.kq * qstep; }
        const int nt = (cur.kq >= 0 ? (K >> 2) : K) / BK;
        for (int t = 0; t < nt; t += 2) {
            const bool last = (t == nt - 2);
            const char* a1 = cA + (size_t)(t + 1) * kstep;
            const char* a2 = last ? nA : cA + (size_t)(t + 2) * kstep; const char* b2 = last ? nB : cB + (size_t)(t + 2) * kstep;
            const char* a3 = a2 + kstep; const char* b3 = b2 + kstep;
            PG8_LDB(B0, 0, 0); PG8_SCHED; PG8_LDA(At, 0, 0); PG8_STAGE(PG8_SA(1, 1), a1 + hstep, voffA);
            PG8_WAIT_L(8); PG8_BAR; PG8_WAIT_L(0); PG8_MMA(0, 0, At, B0); PG8_BAR; PG8_SCHED;
            PG8_LDB(B1, 0, 1); PG8_STAGE(PG8_SB(0, 0), b2, voffB);
            PG8_BAR; PG8_WAIT_L(0); PG8_MMA(0, 1, At, B1); PG8_BAR;
            PG8_LDA(At, 0, 1); PG8_STAGE(PG8_SA(0, 0), a2, voffA);
            PG8_BAR; PG8_WAIT_L(0); PG8_MMA(1, 0, At, B0); PG8_BAR; PG8_SCHED;
            PG8_STAGE(PG8_SB(0, 1), b2 + hstep, voffB);
            PG8_WAIT_V(6); PG8_BAR; PG8_MMA(1, 1, At, B1); PG8_BAR;
            PG8_LDB(B0, 1, 0); PG8_SCHED; PG8_LDA(At, 1, 0); PG8_STAGE(PG8_SA(0, 1), a2 + hstep, voffA);
            PG8_WAIT_L(8); PG8_BAR; PG8_WAIT_L(0); PG8_MMA(0, 0, At, B0); PG8_BAR; PG8_SCHED;
            PG8_LDB(B1, 1, 1); PG8_STAGE(PG8_SB(1, 0), b3, voffB);
            PG8_BAR; PG8_WAIT_L(0); PG8_MMA(0, 1, At, B1); PG8_BAR;
            PG8_LDA(At, 1, 1); PG8_STAGE(PG8_SA(1, 0), a3, voffA);
            PG8_BAR; PG8_WAIT_L(0); PG8_MMA(1, 0, At, B0); PG8_BAR; PG8_SCHED;
            PG8_STAGE(PG8_SB(1, 1), b3 + hstep, voffB);
            PG8_WAIT_V(6); PG8_BAR; PG8_MMA(1, 1, At, B1); PG8_BAR;
        }
        if (cur.kq < 0) E(acc, cur, wr, wc, fr, fq);
        if (!has_next) break;
#pragma unroll
        for (int a = 0; a < 2; ++a)
#pragma unroll
            for (int b = 0; b < 2; ++b)
#pragma unroll
                for (int m = 0; m < 4; ++m)
#pragma unroll
                    for (int n = 0; n < 2; ++n) acc[a][b][m][n] = (f32x4){0.f, 0.f, 0.f, 0.f};
        cur = nxt; cA = nA; cB = nB; ++ui;
    }
    PG8_WAIT_V(0);
    if (wr == 0) PG8_BAR;
    PG8_BAR;
    if constexpr (Epi::SPLIT) {
    if (cur.kq >= 0) {
        const __amdgpu_buffer_rsrc_t drs = __builtin_amdgcn_make_buffer_rsrc((void*)(g.dump + (size_t)cur.ti * 4 * (64 * 512)), 0, 4 * 64 * 512 * 8, 0x00020000);
        unsigned lo = (unsigned)tid * 16u;
        { const unsigned qo = (unsigned)cur.kq * (64 * 512 * 8);
#pragma unroll
          for (int a = 0; a < 2; ++a)
#pragma unroll
              for (int b = 0; b < 2; ++b)
#pragma unroll
                  for (int m = 0; m < 4; ++m)
#pragma unroll
                      for (int n = 0; n < 2; ++n) { asm volatile("" : "+v"(lo));
                          __builtin_amdgcn_raw_buffer_store_b128(__builtin_bit_cast(u32x4, acc[a][b][m][n]), drs, qo + (unsigned)((((a * 2 + b) * 4 + m) * 2 + n) * (512 * 16)) + lo, 0,   16); } }
        asm volatile("s_waitcnt vmcnt(0)" ::: "memory");
        __syncthreads();
        if (tid == 0) { const unsigned old = __hip_atomic_fetch_add(g.cnt + cur.ti, 1u, __ATOMIC_RELAXED, __HIP_MEMORY_SCOPE_AGENT); *(LAS unsigned*)lds = old;
            if (old == 3u) __hip_atomic_store(g.cnt + cur.ti, 0u, __ATOMIC_RELAXED, __HIP_MEMORY_SCOPE_AGENT); }
        __syncthreads();
        const unsigned arrived = __builtin_amdgcn_readfirstlane(*(LAS unsigned*)lds);
        if (arrived == 3u) {
#pragma unroll
            for (int a = 0; a < 2; ++a)
#pragma unroll
                for (int m = 0; m < 4; ++m) { f32x4 v[2][2];
#pragma unroll
                    for (int b = 0; b < 2; ++b)
#pragma unroll
                        for (int n = 0; n < 2; ++n) { asm volatile("" : "+v"(lo)); const unsigned o = (unsigned)((((a * 2 + b) * 4 + m) * 2 + n) * (512 * 16)) + lo;
                            const f32x4 p0 = __builtin_bit_cast(f32x4, __builtin_amdgcn_raw_buffer_load_b128(drs, o, 0, 16)), p1 = __builtin_bit_cast(f32x4, __builtin_amdgcn_raw_buffer_load_b128(drs, o + 64 * 512 * 8, 0, 16)),
                                        p2 = __builtin_bit_cast(f32x4, __builtin_amdgcn_raw_buffer_load_b128(drs, o + 2 * 64 * 512 * 8, 0, 16)), p3 = __builtin_bit_cast(f32x4, __builtin_amdgcn_raw_buffer_load_b128(drs, o + 3 * 64 * 512 * 8, 0, 16));
                            v[b][n] = (p0 + p1) + (p2 + p3); }
                    E.rg(a, m, v, cur, wr, wc, fr, fq); if (m & 1) asm volatile("" ::: "memory"); }
        }
        __syncthreads();
    }
    }
#undef PG8_SA
#undef PG8_SB
#undef PG8_STAGE
#undef PG8_LDA
#undef PG8_LDB
#undef PG8_MMA
#undef PG8_WAIT_V
#undef PG8_WAIT_L
#undef PG8_BAR
#undef PG8_SCHED
}
}
using pg8::Unit;
typedef const f32x4 (&AccRef)[2][2][4][2];

__device__ __forceinline__ void st_bf16x4(bf16_t* p, f32x4 v) { u32x2 w; w.x = cvt_pk_bf16(v[0], v[1]); w.y = cvt_pk_bf16(v[2], v[3]); *(u32x2*)p = w; }
__device__ __forceinline__ void st_bf16x8(bf16_t* p, f32x4 a, f32x4 b) { u32x4 w; w.x = cvt_pk_bf16(a[0], a[1]); w.y = cvt_pk_bf16(a[2], a[3]); w.z = cvt_pk_bf16(b[0], b[1]); w.w = cvt_pk_bf16(b[2], b[3]); *(u32x4*)p = w; }
__device__ __forceinline__ bf16_t bf16_1(float v) { return (bf16_t)(cvt_pk_bf16(v, 0.f) & 0xffffu); }

struct EpiG1 {
    static constexpr bool SPLIT = false;
    __device__ __forceinline__ bool swapped(const Unit& u) const { return u.pn >= 16 && u.pn < 24; }
    bf16_t *aglu, *q, *k, *kt, *vt, *rg, *gate; const float *rcos, *rsin;
    __device__ __forceinline__ void operator()(AccRef acc, const Unit& u, int wr, int wc, int fr, int fq) const {
        const int pn = u.pn, row0 = u.pm * 256 + wr * 64 + fr, ct = wc * 32 + 8 * fq;
        if (pn < 8) {
#pragma unroll
            for (int ai = 0; ai < 2; ++ai)
#pragma unroll
                for (int m = 0; m < 4; ++m) { const int row = row0 + ai * 128 + m * 16; f32x4 o[2];
#pragma unroll
                    for (int n = 0; n < 2; ++n) { const f32x4 a = acc[ai][0][m][n], b = acc[ai][1][m][n];
#pragma unroll
                        for (int r = 0; r < 4; ++r) o[n][r] = a[r] * sigmoidf_(b[r]); }
                    st_bf16x8(aglu + (size_t)row * DM + pn * 128 + ct, o[0], o[1]); }
        } else if (pn < 16) {
            const bool isK = pn >= 12; const int h = (pn - 8) & 3; const float sc = isK ? 0.0625f : 1.0f; bf16_t* dst = isK ? k : q;
#pragma unroll
            for (int ai = 0; ai < 2; ++ai)
#pragma unroll
                for (int m = 0; m < 4; ++m) { const int row = row0 + ai * 128 + m * 16; const bool lat = row >= TC; const int pos = (row - TC) & 2047, gr = pos >> 6, gc = pos & 63; f32x4 o1[2], o2[2];
#pragma unroll
                    for (int n = 0; n < 2; ++n) { const int d1 = ct + n * 4; const f32x4 x1 = acc[ai][0][m][n] * sc, x2 = acc[ai][1][m][n] * sc; o1[n] = x1; o2[n] = x2;
                        if (lat) { const int ti = (d1 < 64) ? gr * 64 + d1 : gc * 64 + d1 - 64; const f32x4 cs = *(const f32x4*)(rcos + ti), sn = *(const f32x4*)(rsin + ti);
                            o1[n] = x1 * cs - x2 * sn; o2[n] = x2 * cs + x1 * sn; }
                        if (isK) {
#pragma unroll
                            for (int r = 0; r < 4; ++r) { kt[(size_t)(h * 256 + d1 + r) * TT + row] = bf16_1(o1[n][r]); kt[(size_t)(h * 256 + 128 + d1 + r) * TT + row] = bf16_1(o2[n][r]); } } }
                    st_bf16x8(dst + (size_t)row * DM + h * 256 + ct, o1[0], o1[1]); st_bf16x8(dst + (size_t)row * DM + h * 256 + 128 + ct, o2[0], o2[1]); }
        } else if (pn < 24) {
            const int e0 = (pn - 16) * 256 + wr * 64 + fr, t0 = u.pm * 256 + ct;
#pragma unroll
            for (int ai = 0; ai < 2; ++ai)
#pragma unroll
                for (int m = 0; m < 4; ++m) { bf16_t* vr = vt + (size_t)(e0 + ai * 128 + m * 16) * TT + t0;
#pragma unroll
                    for (int bj = 0; bj < 2; ++bj) st_bf16x8(vr + bj * 128, acc[ai][bj][m][0], acc[ai][bj][m][1]); }
        } else {
            const bool isG = pn >= 32; bf16_t* dst = isG ? gate : rg; const int cb = ((pn - 24) & 7) * 256;
#pragma unroll
            for (int ai = 0; ai < 2; ++ai)
#pragma unroll
                for (int m = 0; m < 4; ++m) { const int row = row0 + ai * 128 + m * 16;
#pragma unroll
                    for (int bj = 0; bj < 2; ++bj) { f32x4 o[2];
#pragma unroll
                        for (int n = 0; n < 2; ++n) { const f32x4 v = acc[ai][bj][m][n];
#pragma unroll
                            for (int r = 0; r < 4; ++r) { const float s = sigmoidf_(v[r]); o[n][r] = isG ? s : v[r] * s; } }
                        st_bf16x8(dst + (size_t)row * VW + cb + bj * 128 + ct, o[0], o[1]); } }
        }
    }
};

struct EpiE1 {
    static constexpr bool SPLIT = false;
    __device__ __forceinline__ bool swapped(const Unit&) const { return false; }
    bf16_t* m1; const bf16_t* gate;
    __device__ __forceinline__ void operator()(AccRef acc, const Unit& u, int wr, int wc, int fr, int fq) const {
        const int row0 = u.pm * 256 + wr * 64 + fr, col0 = u.pn * 256 + wc * 32 + 8 * fq;
#pragma unroll
        for (int ai = 0; ai < 2; ++ai)
#pragma unroll
            for (int m = 0; m < 4; ++m) { const int row = row0 + ai * 128 + m * 16;
#pragma unroll
                for (int bj = 0; bj < 2; ++bj) { const int col = col0 + bj * 128; const u32x4 gv = *(const u32x4*)(gate + (size_t)row * VW + col); const f32x4 v0 = acc[ai][bj][m][0], v1 = acc[ai][bj][m][1];
                    f32x4 o0, o1; o0[0] = v0[0] * bf_lo(gv.x); o0[1] = v0[1] * bf_hi(gv.x); o0[2] = v0[2] * bf_lo(gv.y); o0[3] = v0[3] * bf_hi(gv.y);
                    o1[0] = v1[0] * bf_lo(gv.z); o1[1] = v1[1] * bf_hi(gv.z); o1[2] = v1[2] * bf_lo(gv.w); o1[3] = v1[3] * bf_hi(gv.w);
                    st_bf16x8(m1 + (size_t)row * DM + col, o0, o1); } }
    }
};
struct EpiE2 {
    static constexpr bool SPLIT = false;
    __device__ __forceinline__ bool swapped(const Unit&) const { return false; }
    const bf16_t* m1; const bf16_t* gate; bf16_t* mm;
    __device__ __forceinline__ void operator()(AccRef acc, const Unit& u, int wr, int wc, int fr, int fq) const {
        const int row0 = u.pm * 256 + wr * 64 + fr, col0 = u.pn * 256 + wc * 32 + 8 * fq;
#pragma unroll
        for (int ai = 0; ai < 2; ++ai)
#pragma unroll
            for (int m = 0; m < 4; ++m) { const int row = row0 + ai * 128 + m * 16;
#pragma unroll
                for (int bj = 0; bj < 2; ++bj) { const int col = col0 + bj * 128; const u32x4 gv = *(const u32x4*)(gate + (size_t)row * VW + DM + col), mv = *(const u32x4*)(m1 + (size_t)row * DM + col); const f32x4 v0 = acc[ai][bj][m][0], v1 = acc[ai][bj][m][1];
                    f32x4 o0, o1; o0[0] = bf_lo(mv.x) + v0[0] * bf_lo(gv.x); o0[1] = bf_hi(mv.x) + v0[1] * bf_hi(gv.x); o0[2] = bf_lo(mv.y) + v0[2] * bf_lo(gv.y); o0[3] = bf_hi(mv.y) + v0[3] * bf_hi(gv.y);
                    o1[0] = bf_lo(mv.z) + v1[0] * bf_lo(gv.z); o1[1] = bf_hi(mv.z) + v1[1] * bf_hi(gv.z); o1[2] = bf_lo(mv.w) + v1[2] * bf_lo(gv.w); o1[3] = bf_hi(mv.w) + v1[3] * bf_hi(gv.w);
                    st_bf16x8(mm + (size_t)row * DM + col, o0, o1); } }
    }
};
template <bool SPLIT_> struct EpiResT {
    static constexpr bool SPLIT = SPLIT_;
    __device__ __forceinline__ bool swapped(const Unit&) const { return false; }
    const float *xa, *xb; float* xout; const float* gvec;
    __device__ __forceinline__ void rg(int ai, int m, const f32x4 (&v)[2][2], const Unit& u, int wr, int wc, int fr, int fq) const {
        const int row = u.pm * 256 + wr * 64 + fr + ai * 128 + m * 16, col0 = u.pn * 256 + wc * 32 + 8 * fq;
        const float* xr = row < TC ? xa + (size_t)row * DM : xb + (size_t)(row - TC) * DM; const float* gr = gvec + row_group(row) * 6144;
#pragma unroll
        for (int bj = 0; bj < 2; ++bj)
#pragma unroll
            for (int n = 0; n < 2; ++n) { const int col = col0 + bj * 128 + n * 4; const f32x4 xv = *(const f32x4*)(xr + col), gv = *(const f32x4*)(gr + col);
                *(f32x4*)(xout + (size_t)row * DM + col) = xv + gv * v[bj][n]; }
    }
    __device__ __forceinline__ void operator()(AccRef acc, const Unit& u, int wr, int wc, int fr, int fq) const {
#pragma unroll
        for (int a = 0; a < 2; ++a)
#pragma unroll
            for (int m = 0; m < 4; ++m) { const f32x4 v[2][2] = {{acc[a][0][m][0], acc[a][0][m][1]}, {acc[a][1][m][0], acc[a][1][m][1]}}; rg(a, m, v, u, wr, wc, fr, fq); }
    }
};
struct EpiF1 {
    static constexpr bool SPLIT = false;
    __device__ __forceinline__ bool swapped(const Unit&) const { return false; }
    bf16_t* uo;
    __device__ __forceinline__ void operator()(AccRef acc, const Unit& u, int wr, int wc, int fr, int fq) const {
        const int row0 = u.pm * 256 + wr * 64 + fr, col0 = u.pn * 256 + wc * 32 + 8 * fq;
#pragma unroll
        for (int ai = 0; ai < 2; ++ai)
#pragma unroll
            for (int m = 0; m < 4; ++m) { const int row = row0 + ai * 128 + m * 16;
#pragma unroll
                for (int bj = 0; bj < 2; ++bj) { f32x4 o[2];
#pragma unroll
                    for (int n = 0; n < 2; ++n) { const f32x4 v = acc[ai][bj][m][n];
#pragma unroll
                        for (int r = 0; r < 4; ++r) { const float t = fmaxf(v[r], 0.f); o[n][r] = t * t; } }
                    st_bf16x8(uo + (size_t)row * MLPW + col0 + bj * 128, o[0], o[1]); } }
    }
};

__device__ __forceinline__ void tconv_item(const float* __restrict__ src, bf16_t* __restrict__ dst, int K, int N, int item, bool permIn, float* tile  ) {
    const int tilesN = N >> 8, kt = item / tilesN, ntile = item - kt * tilesN, k0 = kt * 64, n0 = ntile * 256, tid = tid_opaque();
    { const int r = tid >> 6, c4 = (tid & 63) * 4; f32x4 v[8];
#pragma unroll
      for (int rr = 0; rr < 8; ++rr) v[rr] = __builtin_nontemporal_load((const f32x4*)(src + (size_t)(k0 + r + rr * 8) * N + n0 + c4));
#pragma unroll
      for (int rr = 0; rr < 8; ++rr) { float* t = tile + (r + rr * 8) * 257 + c4; t[0] = v[rr][0]; t[1] = v[rr][1]; t[2] = v[rr][2]; t[3] = v[rr][3]; } }
    __syncthreads();
#pragma unroll
    for (int q = 0; q < 4; ++q) { const int n = q * 64 + (tid >> 3), k8 = (tid & 7) * 8; float v[8];
#pragma unroll
      for (int e = 0; e < 8; ++e) v[e] = tile[(k8 + e) * 257 + n];
      int nn = n0 + n;
      if (permIn && nn < 2048) { const int c = nn & 1023, half = nn >> 10; nn = (c >> 7) * 256 + half * 128 + (c & 127); }
      u32x4 w; w.x = cvt_pk_bf16(v[0], v[1]); w.y = cvt_pk_bf16(v[2], v[3]); w.z = cvt_pk_bf16(v[4], v[5]); w.w = cvt_pk_bf16(v[6], v[7]);
      *(u32x4*)(dst + (size_t)nn * K + k0 + k8) = w; }
    __syncthreads();
}

__device__ void phase0(const Params& p, unsigned char* smem) {
    float* tile = (float*)smem;
    float* scond = (float*)(smem + 66048);
    float* red = (float*)(smem + 66048 + 36864);
    const int tid = tid_opaque();
    constexpr int NT_L = 1408, NT = 2 * NT_L, NMOD = 192;
    for (int it = blockIdx.x; it < NT + NMOD + 1; it += gridDim.x) {
        if (it < NT) {
            const int l = it / NT_L; int j = it - l * NT_L; unsigned char* wb = p.ws + WS_W + (size_t)l * WL_SZ;
            if (j < 640) tconv_item(p.in[9] + (size_t)l * DM * PW, (bf16_t*)(wb + WL_IN), DM, PW, j, true, tile);
            else if ((j -= 640) < 64) tconv_item(p.in[13] + (size_t)l * DM * DM, (bf16_t*)(wb + WL_CONV), DM, DM, j, false, tile);
            else if ((j -= 64) < 128) tconv_item(p.in[15] + (size_t)l * VW * DM, (bf16_t*)(wb + WL_RET), VW, DM, j, false, tile);
            else if ((j -= 128) < 64) tconv_item(p.in[16] + (size_t)l * DM * DM, (bf16_t*)(wb + WL_OUT), DM, DM, j, false, tile);
            else if ((j -= 64) < 256) tconv_item(p.in[17] + (size_t)l * DM * MLPW, (bf16_t*)(wb + WL_M1), DM, MLPW, j, false, tile);
            else { j -= 256; tconv_item(p.in[18] + (size_t)l * MLPW * DM, (bf16_t*)(wb + WL_M2), MLPW, DM, j, false, tile); }
        } else if (it < NT + NMOD) {
            const int j = it - NT, l = j / 96, c0 = (j % 96) * 64;
            for (int idx = tid; idx < 9 * 1024; idx += NTHR) { const int g = idx >> 10, k = idx & 1023; const float v = g == 0 ? p.in[4][k] : p.in[2][(g - 1) * 1024 + k]; scond[idx] = siluf_(v); }
            __syncthreads();
            const int col = tid & 63, kg = tid >> 6; float a[9];
#pragma unroll
            for (int g = 0; g < 9; ++g) a[g] = 0.f;
            const float* wm = p.in[7] + (size_t)l * DM * 6144 + c0 + col;
#pragma unroll 16
            for (int k = kg * 128; k < kg * 128 + 128; ++k) { const float w = __builtin_nontemporal_load(wm + (size_t)k * 6144);
#pragma unroll
                for (int g = 0; g < 9; ++g) a[g] += scond[g * 1024 + k] * w; }
#pragma unroll
            for (int g = 0; g < 9; ++g) red[(kg * 9 + g) * 64 + col] = a[g];
            __syncthreads();
            for (int o = tid; o < 9 * 64; o += NTHR) { const int g = o >> 6, cc = o & 63; float s = 0.f;
#pragma unroll
                for (int q = 0; q < 8; ++q) s += red[(q * 9 + g) * 64 + cc];
                ((float*)(p.ws + WS_MOD))[(size_t)(l * 9 + g) * 6144 + c0 + cc] = s + p.in[8][l * 6144 + c0 + cc]; }
            __syncthreads();
        } else {
            float* rc = (float*)(p.ws + WS_ROPE); float* rs = rc + 4096;
            if (tid < 64) ((unsigned*)(p.ws + WS_CNT))[tid] = 0u;
            for (int idx = tid; idx < 4096; idx += NTHR) { const int pos = idx >> 6, i = idx & 63; const float inv = exp2f(-(float)i * (13.287712379549449f / 64.f)); const float ang = (float)pos * inv;
                rc[idx] = __cosf(ang); rs[idx] = __sinf(ang); }
        }
    }
}

__device__ void norm_mod_phase(const float* xa, const float* xb, bf16_t* dst, const float* ng, const float* modl, int sh_chunk) {
    const int tid = tid_opaque(), lane = tid & 63, gw = blockIdx.x * 8 + (tid >> 6), nw = gridDim.x * 8;
    for (int row0 = gw; row0 < TT; row0 += 2 * nw) {
        f32x4 v[2][4]; float ss[2];
#pragma unroll
        for (int q = 0; q < 2; ++q) { const int row = min(row0 + q * nw, TT - 1); const float* xr = row < TC ? xa + (size_t)row * DM : xb + (size_t)(row - TC) * DM;
#pragma unroll
            for (int i = 0; i < 4; ++i) v[q][i] = __builtin_nontemporal_load((const f32x4*)(xr + i * 256 + lane * 4)); }
#pragma unroll
        for (int q = 0; q < 2; ++q) { float s = 0.f;
#pragma unroll
            for (int i = 0; i < 4; ++i) s += v[q][i][0] * v[q][i][0] + v[q][i][1] * v[q][i][1] + v[q][i][2] * v[q][i][2] + v[q][i][3] * v[q][i][3];
            ss[q] = s; }
#pragma unroll
        for (int q = 0; q < 2; ++q) { const int row = row0 + q * nw; if (row >= TT) break;
            const float rstd = rsqrtf(wave_sum(ss[q]) * (1.f / DM) + EPSV); const float* md = modl + row_group(row) * 6144;
#pragma unroll
            for (int i = 0; i < 4; ++i) { const int c = i * 256 + lane * 4; const f32x4 g = *(const f32x4*)(ng + c), sh = *(const f32x4*)(md + sh_chunk * 1024 + c), sc = *(const f32x4*)(md + (sh_chunk + 1) * 1024 + c);
                const f32x4 o = v[q][i] * rstd * g * (sc + 1.f) + sh; st_bf16x4(dst + (size_t)row * DM + c, o); } }
    }
}
__device__ void final_norm_phase(float* x, const float* ng) {
    const int tid = tid_opaque(), lane = tid & 63, gw = blockIdx.x * 8 + (tid >> 6), nw = gridDim.x * 8;
    for (int row = gw; row < TT; row += nw) {
        float* xr = x + (size_t)row * DM; f32x4 v[4]; float ss = 0.f;
#pragma unroll
        for (int i = 0; i < 4; ++i) { v[i] = __builtin_nontemporal_load((const f32x4*)(xr + i * 256 + lane * 4)); ss += v[i][0] * v[i][0] + v[i][1] * v[i][1] + v[i][2] * v[i][2] + v[i][3] * v[i][3]; }
        ss = wave_sum(ss); const float rstd = rsqrtf(ss * (1.f / DM) + EPSV);
#pragma unroll
        for (int i = 0; i < 4; ++i) { const int c = i * 256 + lane * 4; const f32x4 g = *(const f32x4*)(ng + c); __builtin_nontemporal_store(v[i] * rstd * g, (f32x4*)(xr + c)); }
    }
}

__device__ void conv_phase(const Params& p, int l, unsigned char* smem) {
    const int tid = tid_opaque(), lane = tid & 63, wv = tid >> 6;
    const bf16_t* aglu = (const bf16_t*)(p.ws + WS_R2); bf16_t* aconv = (bf16_t*)(p.ws + WS_R1);
    float* red = (float*)(smem + 46 * 2048);
    float* rst = red + 128;
    const int c0 = 2 * tid;
    float w0[31], w1[31];
#pragma unroll
    for (int j = 0; j < 31; ++j) { const f32x2 wv2 = *(const f32x2*)(p.in[10] + (size_t)(l * 31 + j) * DM + c0); w0[j] = wv2.x; w1[j] = wv2.y; }
    const f32x2 bias = *(const f32x2*)(p.in[11] + l * DM + c0), gn = *(const f32x2*)(p.in[12] + l * DM + c0);
    for (int it = blockIdx.x; it < TT / 16; it += gridDim.x) {
        const int t0 = it * 16, segl = t0 < TC ? 256 : 64, ss = t0 & ~(segl - 1), se = ss + segl;
        for (int idx = tid; idx < 46 * 128; idx += NTHR) { const int rr = idx >> 7, ch = idx & 127, tt = t0 - 15 + rr; u32x4 v = (u32x4){0u, 0u, 0u, 0u};
            if (tt >= ss && tt < se) v = *(const u32x4*)(aglu + (size_t)tt * DM + ch * 8);
            *(u32x4*)(smem + rr * 2048 + ch * 16) = v; }
        __syncthreads();
        float a0[16], a1[16];
#pragma unroll
        for (int t = 0; t < 16; ++t) { a0[t] = bias.x; a1[t] = bias.y; }
#pragma unroll
        for (int rr = 0; rr < 46; ++rr) { const unsigned uv = *(const unsigned*)(smem + rr * 2048 + c0 * 2); const float lo = bf_lo(uv), hi = bf_hi(uv);
#pragma unroll
            for (int t = 0; t < 16; ++t) { const int j = rr - t; if (j >= 0 && j < 31) { a0[t] += w0[j] * lo; a1[t] += w1[j] * hi; } } }
#pragma unroll
        for (int t = 0; t < 16; ++t) { const float s = wave_sum(a0[t] * a0[t] + a1[t] * a1[t]); if (lane == 0) red[wv * 16 + t] = s; }
        __syncthreads();
        if (tid < 16) { float s = 0.f;
#pragma unroll
            for (int q = 0; q < 8; ++q) s += red[q * 16 + tid];
            rst[tid] = rsqrtf(s * (1.f / DM) + EPSV); }
        __syncthreads();
#pragma unroll
        for (int t = 0; t < 16; ++t) { const float r = rst[t]; *(unsigned*)(aconv + (size_t)(t0 + t) * DM + c0) = cvt_pk_bf16(siluf_(a0[t] * r * gn.x), siluf_(a1[t] * r * gn.y)); }
        __syncthreads();
    }
}

__device__ void ret_phase(const Params& p, int l, unsigned char* smem) {
    LAS unsigned char* lds = (LAS unsigned char*)smem;
    const int tid = tid_opaque(), lane = tid & 63, w = __builtin_amdgcn_readfirstlane(tid >> 6), fr = lane & 15, fq = lane >> 4;
    const bf16_t* Qg = (const bf16_t*)(p.ws + WS_Q); const bf16_t* Kg = (const bf16_t*)(p.ws + WS_K); const bf16_t* KTg = (const bf16_t*)(p.ws + WS_KT); const bf16_t* VTg = (const bf16_t*)(p.ws + WS_VT);
    constexpr int QOFF = 0, KTOFF = 65536;
    const unsigned voffQ = (unsigned)(((2 * w + (lane >> 5)) * DM + (((lane & 31) ^ ((2 * w + (lane >> 5)) & 15))) * 8) * 2);
    const unsigned voffKT = (unsigned)(((4 * w + (lane >> 4)) * TT + (((lane & 15) ^ ((((2 * w + (lane >> 5)) & 12)) | ((lane >> 4) & 3)))) * 8) * 2);
    const unsigned voffK = (unsigned)(((16 * w + fr) * DM + fq * 8) * 2);
    const unsigned voffV = (unsigned)(((16 * w + fr) * TT + fq * 8) * 2);
    const unsigned voffY = (unsigned)(((4 * fq) * VW + 16 * w + fr) * 2);
    int xb[4];
#pragma unroll
    for (int k4 = 0; k4 < 4; ++k4) xb[k4] = ((k4 * 4 + fq) ^ fr) * 16;
    for (int it = blockIdx.x; it < 768; it += gridDim.x) {
        int es, dir, h, bb, tok0, nch; const bool lat = it < 256;
        { const int j = lat ? it : it - 256, x = j & 7, y = j >> 3; es = y & 3; const int cmb = (y >> 2) * 8 + x; dir = cmb & 1; h = (cmb >> 1) & 3; bb = cmb >> 3;
          tok0 = lat ? TC + bb * 2048 : bb * 256; nch = lat ? 16 : 2; }
        const float dl = p.in[14][l * 8 + dir * 4 + h]; const float lg2 = -log1pf(expf(-dl)) * 1.4426950408889634f;
        const float sdec = exp2f(128.f * lg2);
        const float zl = dir ? -lg2 : lg2, zb2 = (float)(dir ? 128 - 4 * fq : 4 * fq + 1) * lg2, kb2 = (float)(dir ? 8 * fq : 127 - 8 * fq) * lg2;
        const int pbase = dir ? (16 * w + 4 * fq - fr) : (fr - 16 * w - 4 * fq);
        f32x4 S[16];
        const unsigned voffS = (unsigned)((8 * fq * 512 + 16 * w + fr) * 4);
        if (lat) { const float* sp = p.in[3] + ((((size_t)bb * 2 + l) * 2 + dir) * 4 + h) * 256 * 512 + es * 128;
#pragma unroll
            for (int D = 0; D < 16; ++D)
#pragma unroll
                for (int r = 0; r < 4; ++r) S[D][r] = __builtin_nontemporal_load((const float*)((const char*)(sp + ((D >> 1) * 32 + 4 * (D & 1) + r) * 512) + voffS));
        } else {
#pragma unroll
            for (int D = 0; D < 16; ++D) S[D] = (f32x4){0.f, 0.f, 0.f, 0.f};
        }
        bf16_t* Yg = (bf16_t*)(p.ws + (dir ? WS_YB : WS_YF));
        for (int s = 0; s < nch; ++s) {
            const int c = dir ? nch - 1 - s : s, r0 = tok0 + c * 128;
            { const bf16_t* qu = Qg + (size_t)r0 * DM + h * 256; const bf16_t* ku = KTg + (size_t)(h * 256) * TT + r0;
#pragma unroll
              for (int n = 0; n < 8; ++n) {
                  __builtin_amdgcn_global_load_lds((const unsigned*)((const char*)(qu + (size_t)(n * 16) * DM) + voffQ), (LAS unsigned*)(lds + QOFF + (n * 8 + w) * 1024), 16, 0, 0);
                  __builtin_amdgcn_global_load_lds((const unsigned*)((const char*)(ku + (size_t)(n * 32) * TT) + voffKT), (LAS unsigned*)(lds + KTOFF + (n * 8 + w) * 1024), 16, 0, 0); } }
            bf16x8 Kf[8], Vf[4];
            { const char* kb = (const char*)(Kg + (size_t)r0 * DM + h * 256) + voffK;
#pragma unroll
              for (int ks = 0; ks < 4; ++ks) Kf[ks] = *(const bf16x8*)(kb + ks * 64); }
            asm volatile("s_waitcnt vmcnt(0)" ::: "memory");
            __syncthreads();
            { const char* kb = (const char*)(Kg + (size_t)r0 * DM + h * 256) + voffK;
#pragma unroll
              for (int ks = 4; ks < 8; ++ks) Kf[ks] = *(const bf16x8*)(kb + ks * 64); }
            f32x4 Z[8], PT[8];
#pragma unroll
            for (int i8 = 0; i8 < 8; ++i8) { Z[i8] = (f32x4){0.f, 0.f, 0.f, 0.f}; PT[i8] = (f32x4){0.f, 0.f, 0.f, 0.f}; }
#define QFRAG(ks, i8) (*(const LAS bf16x8*)(lds + QOFF + xb[(ks) & 3] + fr * 512 + (i8) * 8192 + ((ks) >> 2) * 256))
            { bf16x8 qa[4], qb[4];
#pragma unroll
              for (int j = 0; j < 4; ++j) qa[j] = QFRAG(0, j);
#pragma unroll
              for (int ks = 0; ks < 8; ++ks) { u32x4 t; t.x = cvt_pk_bf16(S[2 * ks][0], S[2 * ks][1]); t.y = cvt_pk_bf16(S[2 * ks][2], S[2 * ks][3]); t.z = cvt_pk_bf16(S[2 * ks + 1][0], S[2 * ks + 1][1]); t.w = cvt_pk_bf16(S[2 * ks + 1][2], S[2 * ks + 1][3]);
                  const bf16x8 Sb = __builtin_bit_cast(bf16x8, t);
#pragma unroll
                  for (int j = 0; j < 4; ++j) qb[j] = QFRAG(ks, 4 + j);
                  __builtin_amdgcn_sched_barrier(0);
#pragma unroll
                  for (int j = 0; j < 4; ++j) { Z[j] = __builtin_amdgcn_mfma_f32_16x16x32_bf16(qa[j], Sb, Z[j], 0, 0, 0); PT[j] = __builtin_amdgcn_mfma_f32_16x16x32_bf16(Kf[ks], qa[j], PT[j], 0, 0, 0); }
                  __builtin_amdgcn_sched_barrier(0);
                  if (ks < 7) {
#pragma unroll
                      for (int j = 0; j < 4; ++j) qa[j] = QFRAG(ks + 1, j); }
                  __builtin_amdgcn_sched_barrier(0);
#pragma unroll
                  for (int j = 0; j < 4; ++j) { Z[4 + j] = __builtin_amdgcn_mfma_f32_16x16x32_bf16(qb[j], Sb, Z[4 + j], 0, 0, 0); PT[4 + j] = __builtin_amdgcn_mfma_f32_16x16x32_bf16(Kf[ks], qb[j], PT[4 + j], 0, 0, 0); }
                  __builtin_amdgcn_sched_barrier(0); } }
#undef QFRAG
            { const char* vb = (const char*)(VTg + (size_t)(h * 512 + es * 128) * TT + r0) + voffV;
#pragma unroll
              for (int ks = 0; ks < 4; ++ks) Vf[ks] = *(const bf16x8*)(vb + ks * 64); }
            float zb2_ = zb2, zl_ = zl, kb2_ = kb2; int pbase_ = pbase;
            asm volatile("" : "+v"(zb2_), "+v"(zl_), "+v"(kb2_), "+v"(pbase_));
            { f32x4 zf, pf; const float z16 = __builtin_amdgcn_exp2f(16.f * zl_);
#pragma unroll
              for (int r = 0; r < 4; ++r) { zf[r] = __builtin_amdgcn_exp2f(zb2_ + (float)r * zl_); pf[r] = __builtin_amdgcn_exp2f((float)(pbase_ + (dir ? r : -r)) * lg2); }
#pragma unroll
              for (int i8 = 0; i8 < 8; ++i8) {
#pragma unroll
                  for (int r = 0; r < 4; ++r) { Z[i8][r] *= zf[r];
                      const int df = pbase_ + (dir ? -(i8 * 16 - r) : (i8 * 16 - r)); PT[i8][r] = df >= 0 ? PT[i8][r] * pf[r] : 0.f; }
                  zf *= z16; pf *= z16; } }
            __syncthreads();
#pragma unroll
            for (int i8 = 0; i8 < 8; ++i8) { const int i = i8 * 16 + fr; u32x2 t; t.x = cvt_pk_bf16(PT[i8][0], PT[i8][1]); t.y = cvt_pk_bf16(PT[i8][2], PT[i8][3]);
                *(LAS u32x2*)(lds + QOFF + i * 256 + (((2 * w + (fq >> 1)) ^ fr)) * 16 + (fq & 1) * 8) = t; }
            __syncthreads();
#define PFRAG(i8, ks) (*(const LAS bf16x8*)(lds + QOFF + xb[ks] + fr * 256 + (i8) * 4096))
            { bf16x8 pa[4], pb[4];
#pragma unroll
              for (int ks = 0; ks < 4; ++ks) pa[ks] = PFRAG(0, ks);
#pragma unroll
              for (int i8 = 0; i8 < 8; i8 += 2) {
#pragma unroll
                  for (int ks = 0; ks < 4; ++ks) pb[ks] = PFRAG(i8 + 1, ks);
                  __builtin_amdgcn_sched_barrier(0);
#pragma unroll
                  for (int ks = 0; ks < 4; ++ks) Z[i8] = __builtin_amdgcn_mfma_f32_16x16x32_bf16(pa[ks], Vf[ks], Z[i8], 0, 0, 0);
                  __builtin_amdgcn_sched_barrier(0);
                  if (i8 < 6) {
#pragma unroll
                      for (int ks = 0; ks < 4; ++ks) pa[ks] = PFRAG(i8 + 2, ks); }
                  __builtin_amdgcn_sched_barrier(0);
#pragma unroll
                  for (int ks = 0; ks < 4; ++ks) Z[i8 + 1] = __builtin_amdgcn_mfma_f32_16x16x32_bf16(pb[ks], Vf[ks], Z[i8 + 1], 0, 0, 0);
                  __builtin_amdgcn_sched_barrier(0); } }
#undef PFRAG
#pragma unroll
            for (int i8 = 0; i8 < 8; ++i8)
#pragma unroll
                for (int r = 0; r < 4; ++r) *(bf16_t*)((char*)(Yg + (size_t)(r0 + i8 * 16 + r) * VW + h * 512 + es * 128) + voffY) = bf16_1(Z[i8][r]);
            bf16x8 Vs[4];
            float kf8[8], kstep[4];
#pragma unroll
            for (int e = 0; e < 8; ++e) kf8[e] = __builtin_amdgcn_exp2f(kb2_ - (float)e * zl_);
            { const float k32 = __builtin_amdgcn_exp2f(-32.f * zl_); kstep[0] = 1.f; kstep[1] = k32; kstep[2] = k32 * k32; kstep[3] = kstep[2] * k32; }
#pragma unroll
            for (int ks = 0; ks < 4; ++ks) { const u32x4 t = __builtin_bit_cast(u32x4, Vf[ks]); float f[8]; f[0] = bf_lo(t.x); f[1] = bf_hi(t.x); f[2] = bf_lo(t.y); f[3] = bf_hi(t.y); f[4] = bf_lo(t.z); f[5] = bf_hi(t.z); f[6] = bf_lo(t.w); f[7] = bf_hi(t.w);
#pragma unroll
                for (int e = 0; e < 8; ++e) f[e] *= kf8[e] * kstep[ks];
                u32x4 o; o.x = cvt_pk_bf16(f[0], f[1]); o.y = cvt_pk_bf16(f[2], f[3]); o.z = cvt_pk_bf16(f[4], f[5]); o.w = cvt_pk_bf16(f[6], f[7]); Vs[ks] = __builtin_bit_cast(bf16x8, o); }
#define TFRAG(D, ks) (*(const LAS bf16x8*)(lds + KTOFF + xb[ks] + (8 * (fr >> 2) + (fr & 3)) * 256 + ((D) >> 1) * 8192 + ((D) & 1) * 1024))
            { bf16x8 ta[4], tb[4];
#pragma unroll
              for (int ks = 0; ks < 4; ++ks) ta[ks] = TFRAG(0, ks);
#pragma unroll
              for (int D = 0; D < 16; D += 2) { S[D] *= sdec; S[D + 1] *= sdec;
#pragma unroll
                  for (int ks = 0; ks < 4; ++ks) tb[ks] = TFRAG(D + 1, ks);
                  __builtin_amdgcn_sched_barrier(0);
#pragma unroll
                  for (int ks = 0; ks < 4; ++ks) S[D] = __builtin_amdgcn_mfma_f32_16x16x32_bf16(ta[ks], Vs[ks], S[D], 0, 0, 0);
                  __builtin_amdgcn_sched_barrier(0);
                  if (D < 14) {
#pragma unroll
                      for (int ks = 0; ks < 4; ++ks) ta[ks] = TFRAG(D + 2, ks); }
                  __builtin_amdgcn_sched_barrier(0);
#pragma unroll
                  for (int ks = 0; ks < 4; ++ks) S[D + 1] = __builtin_amdgcn_mfma_f32_16x16x32_bf16(tb[ks], Vs[ks], S[D + 1], 0, 0, 0);
                  __builtin_amdgcn_sched_barrier(0); } }
#undef TFRAG
            __syncthreads();
        }
        if (!lat) { float* so = p.out + (size_t)TT * DM + ((((size_t)bb * 2 + l) * 2 + dir) * 4 + h) * 256 * 512 + es * 128;
#pragma unroll
            for (int D = 0; D < 16; ++D)
#pragma unroll
                for (int r = 0; r < 4; ++r) __builtin_nontemporal_store(S[D][r], (float*)((char*)(so + ((D >> 1) * 32 + 4 * (D & 1) + r) * 512) + voffS)); }
    }
}

__device__ void comb_phase(const Params& p) {
    const int tid = tid_opaque(), lane = tid & 63, gw = blockIdx.x * 8 + (tid >> 6), nw = gridDim.x * 8;
    const bf16_t* yf = (const bf16_t*)(p.ws + WS_YF); const bf16_t* yb = (const bf16_t*)(p.ws + WS_YB); const bf16_t* rg = (const bf16_t*)(p.ws + WS_RG); bf16_t* ar = (bf16_t*)(p.ws + WS_Q);
    for (int tok = gw; tok < TT; tok += nw) {
        u32x4 a[4], b[4], g[4];
#pragma unroll
        for (int h = 0; h < 4; ++h) { const size_t off = (size_t)tok * VW + h * 512 + lane * 8; a[h] = __builtin_nontemporal_load((const u32x4*)(yf + off)); b[h] = __builtin_nontemporal_load((const u32x4*)(yb + off)); g[h] = __builtin_nontemporal_load((const u32x4*)(rg + off)); }
#pragma unroll
        for (int h = 0; h < 4; ++h) {
            float y[8];
#pragma unroll
            for (int e = 0; e < 4; ++e) { y[2 * e] = bf_lo(a[h][e]) + bf_lo(b[h][e]); y[2 * e + 1] = bf_hi(a[h][e]) + bf_hi(b[h][e]); }
            float s = 0.f;
#pragma unroll
            for (int e = 0; e < 8; ++e) s += y[e];
            const float mu = wave_sum(s) * (1.f / 512.f); float v = 0.f;
#pragma unroll
            for (int e = 0; e < 8; ++e) { y[e] -= mu; v += y[e] * y[e]; }
            const float rstd = rsqrtf(wave_sum(v) * (1.f / 512.f) + EPSV);
            u32x4 o;
#pragma unroll
            for (int e = 0; e < 4; ++e) o[e] = cvt_pk_bf16(y[2 * e] * rstd * bf_lo(g[h][e]), y[2 * e + 1] * rstd * bf_hi(g[h][e]));
            *(u32x4*)(ar + (size_t)tok * VW + h * 512 + lane * 8) = o;
        }
    }
}


#define XB_TMO      128
#define XB_XCNT(j)  (256  + 64 * (j))
#define XB_XSUB(j)  (1280 + 64 * (j))
#define XB_XGEN(j)  (2304 + 64 * (j))
#define XB_TOP      3328
#define XB_TOPGEN   3392
#define XCD_BAR_WORDS 3456
#define XB_SPIN_CAP (1u << 18)
__device__ __forceinline__ unsigned xb_ld(unsigned* p)              { return __hip_atomic_load(p, __ATOMIC_RELAXED, __HIP_MEMORY_SCOPE_AGENT); }
__device__ __forceinline__ unsigned xb_add(unsigned* p, unsigned v) { return __hip_atomic_fetch_add(p, v, __ATOMIC_RELAXED, __HIP_MEMORY_SCOPE_AGENT); }
__device__ __forceinline__ unsigned xb_xcc_id() { return (unsigned)__builtin_amdgcn_s_getreg((3 << 11) | 20) & 0xFu; }
#define XB_SPIN(cond, bar) do { unsigned _sp = 0; while (cond) { __builtin_amdgcn_s_sleep(1); \
    if ((++_sp & 255u) == 0u) { if (xb_ld(&(bar)[XB_TMO])) break; if (_sp > XB_SPIN_CAP) { atomicAdd(&(bar)[XB_TMO], 1u); break; } } } } while (0)
struct XcdBarrier { unsigned* bar; unsigned x; volatile LAS unsigned* st; };
__device__ __forceinline__ XcdBarrier xcd_barrier_post(unsigned* bar, volatile LAS unsigned* st) {
    XcdBarrier b; b.bar = bar; b.x = xb_xcc_id(); b.st = st;
    if (threadIdx.x == 0) (void)xb_add(&bar[XB_XCNT(b.x)], 1u);
    return b;
}
__device__ __forceinline__ void xcd_barrier_complete(unsigned* bar, unsigned x, unsigned& nloc, unsigned& nx) {
    const unsigned G = gridDim.x * gridDim.y * gridDim.z;
    unsigned sum, cnt, mine, sp = 0u;
    for (;;) {
        sum = 0u; cnt = 0u; mine = 0u;
#pragma unroll
        for (unsigned j = 0; j < 16; ++j) { const unsigned c = xb_ld(&bar[XB_XCNT(j)]); sum += c; cnt += (c > 0u) ? 1u : 0u; mine = (j == x) ? c : mine; }
        if (sum == G) break;
        __builtin_amdgcn_s_sleep(1);
        if ((++sp & 255u) == 0u) { if (xb_ld(&bar[XB_TMO])) break; if (sp > XB_SPIN_CAP) { atomicAdd(&bar[XB_TMO], 1u); break; } }
    }
    nloc = mine > 0u ? mine : 1u; nx = cnt > 0u ? cnt : 1u;
}
__device__ __forceinline__ void xcd_barrier(const XcdBarrier& b) {
    asm volatile("s_waitcnt vmcnt(0)" ::: "memory");
    __syncthreads();
    if (threadIdx.x == 0) {
        unsigned* bar = b.bar;
        __builtin_amdgcn_s_waitcnt(0);
        unsigned nloc = b.st[0], nx = b.st[1];
        if (nloc == 0u) { xcd_barrier_complete(bar, b.x, nloc, nx); b.st[0] = nloc; b.st[1] = nx; }
        const unsigned old = xb_add(&bar[XB_XSUB(b.x)], 1u);
        const unsigned gen = old / nloc;
        if (old + 1u == (gen + 1u) * nloc) {
            __builtin_amdgcn_fence(__ATOMIC_RELEASE, "agent");
            asm volatile("s_waitcnt vmcnt(0)" ::: "memory");
            const unsigned og = xb_add(&bar[XB_TOP], 1u);
            const unsigned tg = og / nx;
            if (og + 1u == (tg + 1u) * nx) xb_add(&bar[XB_TOPGEN], 1u);
            else XB_SPIN(xb_ld(&bar[XB_TOPGEN]) == tg, bar);
            __builtin_amdgcn_fence(__ATOMIC_ACQUIRE, "agent");
            xb_add(&bar[XB_XGEN(b.x)], 1u);
            asm volatile("s_waitcnt vmcnt(0)" ::: "memory");
        } else {
            XB_SPIN(xb_ld(&bar[XB_XGEN(b.x)]) == gen, bar);
            __builtin_amdgcn_fence(__ATOMIC_ACQUIRE, "agent");
            asm volatile("s_waitcnt vmcnt(0)" ::: "memory");
        }
    }
    __syncthreads();
}

__global__ void __launch_bounds__(NTHR) mega(Params p) {
    __shared__ __attribute__((aligned(16))) unsigned char smem[131072];
    cg::grid_group grid = cg::this_grid();
    LAS unsigned char* lds = (LAS unsigned char*)smem;
    unsigned char* ws = p.ws;
    float* xbuf = p.out;
    const float* modb = (const float*)(ws + WS_MOD);
    pg8::StaticOrder so;
    __shared__ __attribute__((aligned(16))) unsigned xb_st[4];
    if (threadIdx.x < 4) xb_st[threadIdx.x] = 0u;
    __syncthreads();
    if (blockIdx.x == 1) { const int t = tid_opaque(); for (int i = t; i < XCD_BAR_WORDS; i += NTHR) ((unsigned*)(ws + WS_BAR))[i] = 0u; }
    phase0(p, smem);
    grid.sync();
    const XcdBarrier xbar = xcd_barrier_post((unsigned*)(ws + WS_BAR), (volatile LAS unsigned*)xb_st);
    for (int l = 0; l < 2; ++l) {
        const unsigned char* wl = ws + WS_W + (size_t)l * WL_SZ;
        const float* modl = modb + (size_t)l * 9 * 6144;
        const float* xa = l == 0 ? p.in[0] : xbuf; const float* xb = l == 0 ? p.in[1] : xbuf + (size_t)TC * DM;
        norm_mod_phase(xa, xb, (bf16_t*)(ws + WS_R1), p.in[5] + l * DM, modl, 0);
        xcd_barrier(xbar);
        { pg8::Gemm g{(const bf16_t*)(ws + WS_R1), (const bf16_t*)(wl + WL_IN), TT, PW, DM, nullptr, nullptr}; so.init(TT, PW, gridDim.x, blockIdx.x);
          EpiG1 e{(bf16_t*)(ws + WS_R2), (bf16_t*)(ws + WS_Q), (bf16_t*)(ws + WS_K), (bf16_t*)(ws + WS_KT), (bf16_t*)(ws + WS_VT), (bf16_t*)(ws + WS_RG), (bf16_t*)(ws + WS_GATE), (const float*)(ws + WS_ROPE), (const float*)(ws + WS_ROPE) + 4096};
          pg8::gemm_phase(lds, g, so, e); }
        xcd_barrier(xbar);
        ret_phase(p, l, smem);
        conv_phase(p, l, smem);
        xcd_barrier(xbar);
        { pg8::Gemm g{(const bf16_t*)(ws + WS_R1), (const bf16_t*)(wl + WL_CONV), TT, DM, DM, nullptr, nullptr}; so.init(TT, DM, gridDim.x, blockIdx.x);
          EpiE1 e{(bf16_t*)(ws + WS_KT), (const bf16_t*)(ws + WS_GATE)};
          comb_phase(p);
          __syncthreads();
          pg8::gemm_phase(lds, g, so, e); }
        xcd_barrier(xbar);
        { pg8::Gemm g{(const bf16_t*)(ws + WS_Q), (const bf16_t*)(wl + WL_RET), TT, DM, VW, nullptr, nullptr}; so.init(TT, DM, gridDim.x, blockIdx.x);
          EpiE2 e{(const bf16_t*)(ws + WS_KT), (const bf16_t*)(ws + WS_GATE), (bf16_t*)(ws + WS_R2)};
          pg8::gemm_phase(lds, g, so, e); }
        xcd_barrier(xbar);
        { pg8::Gemm g{(const bf16_t*)(ws + WS_R2), (const bf16_t*)(wl + WL_OUT), TT, DM, DM, nullptr, nullptr}; so.init(TT, DM, gridDim.x, blockIdx.x);
          EpiResT<false> e{xa, xb, xbuf, modl + 2 * 1024};
          pg8::gemm_phase(lds, g, so, e); }
        xcd_barrier(xbar);
        norm_mod_phase(xbuf, xbuf + (size_t)TC * DM, (bf16_t*)(ws + WS_R1), p.in[6] + l * DM, modl, 3);
        xcd_barrier(xbar);
        { pg8::Gemm g{(const bf16_t*)(ws + WS_R1), (const bf16_t*)(wl + WL_M1), TT, MLPW, DM, nullptr, nullptr}; so.init(TT, MLPW, gridDim.x, blockIdx.x);
          EpiF1 e{(bf16_t*)(ws + WS_RG)};
          pg8::gemm_phase(lds, g, so, e); }
        xcd_barrier(xbar);
        { pg8::Gemm g{(const bf16_t*)(ws + WS_RG), (const bf16_t*)(wl + WL_M2), TT, DM, MLPW, (unsigned long long*)(ws + WS_DUMP), (unsigned*)(ws + WS_CNT)}; so.init(TT, DM, gridDim.x, blockIdx.x, true);
          EpiResT<true> e{xbuf, xbuf + (size_t)TC * DM, xbuf, modl + 5 * 1024};
          pg8::gemm_phase(lds, g, so, e); }
        xcd_barrier(xbar);
    }
    final_norm_phase(xbuf, p.in[19]);
}

extern "C" void kernel_launch(void* const* d_in, const int* in_sizes, int n_in, void* d_out, int out_size, void* d_ws, size_t ws_size, hipStream_t stream) {
    static int grid_blocks = 0;
    if (!grid_blocks) {
        int dev = 0, cus = 0, per_cu = 0;
        (void)hipGetDevice(&dev);
        (void)hipDeviceGetAttribute(&cus, hipDeviceAttributeMultiprocessorCount, dev);
        (void)hipOccupancyMaxActiveBlocksPerMultiprocessor(&per_cu, mega, NTHR, 0);
        if (per_cu < 1) per_cu = 1;
        grid_blocks = cus;
    }
    if (n_in != 20 || ws_size < WS_END) return;
    Params p{};
    for (int i = 0; i < 20; ++i) p.in[i] = (const float*)d_in[i];
    p.out = (float*)d_out; p.ws = (unsigned char*)d_ws;
    void* args[] = {&p};
    (void)hipLaunchCooperativeKernel((void*)mega, dim3(grid_blocks), dim3(NTHR), args, 0, stream);
}
```

```cpp
#include <hip/hip_runtime.h>
#include <hip/hip_cooperative_groups.h>
namespace cg = cooperative_groups;

#define LAS __attribute__((address_space(3)))
typedef unsigned short bf16_t;
typedef short bf16x8 __attribute__((ext_vector_type(8)));
typedef float f32x4 __attribute__((ext_vector_type(4)));
typedef float f32x2 __attribute__((ext_vector_type(2)));
typedef unsigned u32x2 __attribute__((ext_vector_type(2)));
typedef unsigned u32x4 __attribute__((ext_vector_type(4)));

constexpr int DM = 1024, TC = 4096, TL = 16384, TT = 20480, PW = 10240, MLPW = 4096, VW = 2048;
constexpr int NTHR = 512;
constexpr float EPSV = 1e-6f;
constexpr size_t MiB = (size_t)1 << 20;
constexpr size_t WS_W = 0;
constexpr size_t WL_IN = 0, WL_CONV = 20 * MiB, WL_RET = 22 * MiB, WL_OUT = 26 * MiB, WL_M1 = 28 * MiB, WL_M2 = 36 * MiB, WL_SZ = 44 * MiB;
constexpr size_t WS_MOD = 88 * MiB;
constexpr size_t WS_ROPE = 88 * MiB + 512 * 1024;
constexpr size_t WS_R1 = 90 * MiB;
constexpr size_t WS_R2 = 130 * MiB;
constexpr size_t WS_Q = 170 * MiB;
constexpr size_t WS_K = 210 * MiB;
constexpr size_t WS_KT = 250 * MiB;
constexpr size_t WS_VT = 290 * MiB;
constexpr size_t WS_RG = 370 * MiB;
constexpr size_t WS_GATE = 450 * MiB;
constexpr size_t WS_YF = 530 * MiB;
constexpr size_t WS_YB = 610 * MiB;
constexpr size_t WS_BAR = 88 * MiB + 448 * 1024;
constexpr size_t WS_DUMP = 690 * MiB;
constexpr size_t WS_CNT = 88 * MiB + 480 * 1024;
constexpr size_t WS_END = 754 * MiB;

struct Params { const float* in[20]; float* out; unsigned char* ws; };

typedef __bf16 bf16x2_t __attribute__((ext_vector_type(2)));
__device__ __forceinline__ unsigned cvt_pk_bf16(float lo, float hi) { const f32x2 f = {lo, hi}; const bf16x2_t v = __builtin_convertvector(f, bf16x2_t); return __builtin_bit_cast(unsigned, v); }
__device__ __forceinline__ float bf_lo(unsigned u) { return __uint_as_float(u << 16); }
__device__ __forceinline__ float bf_hi(unsigned u) { return __uint_as_float(u & 0xffff0000u); }
__device__ __forceinline__ float sigmoidf_(float x) { return __builtin_amdgcn_rcpf(1.f + __expf(-x)); }
__device__ __forceinline__ float siluf_(float x) { return x * sigmoidf_(x); }
__device__ __forceinline__ float wave_sum(float v) {
#pragma unroll
    for (int o = 32; o > 0; o >>= 1) v += __shfl_xor(v, o, 64);
    return v;
}
__device__ __forceinline__ int tid_opaque() { int t = threadIdx.x; asm volatile("" : "+v"(t)); return t; }
__device__ __forceinline__ int row_group(int row) { return row < TC ? 0 : 1 + ((row - TC) >> 11); }

namespace pg8 {
constexpr int BM = 256, BK = 64, HALF = 128, HTB = HALF * BK * 2, NXCD = 8, WGM = 8;
__device__ __forceinline__ int lds_byte(int r, int c) { const int st = (r >> 4) * 2 + (c >> 5), rr = r & 15, cc = c & 31, ob = rr * 64 + cc * 2; return st * 1024 + (ob ^ (((ob >> 9) & 1) << 5)); }
__device__ __forceinline__ void stage_rc(int b, int& R, int& C) { const int st = b / 1024, sb = b % 1024, swz = sb ^ (((sb >> 9) & 1) << 5); R = (st >> 1) * 16 + swz / 64; C = (st & 1) * 32 + (swz % 64) / 2; }
__device__ __forceinline__ int perm32(int rho) { const int n = rho >> 4, i = rho & 15; return 8 * (i >> 2) + 4 * n + (i & 3); }
struct Unit { int pm, pn, kq, ti; };
struct Gemm { const bf16_t* A; const bf16_t* Bt; int M, N, K; unsigned long long* dump; unsigned* cnt; };
struct StaticOrder {
    int nM, nN, nwg, G, c; bool split;
    __device__ void init(int M, int N, int G_, int c_, bool allow_split = false) { nM = M / BM; nN = N / BM; nwg = nM * nN; G = G_; c = c_; split = allow_split && nwg == 320 && G == 256; }
    __device__ bool next(int i, Unit& u) const {
        if (split) {
            const int x = c & 7, j = c >> 3;
            if (i == 0) { u.pm = x * 8 + (j & 7); u.pn = j >> 3; u.kq = -1; u.ti = 0; return true; }
            if (i == 1) { u.kq = x & 3; u.pm = 64 + (x >> 2) * 8 + (j >> 2); u.pn = j & 3; u.ti = (u.pm - 64) * 4 + u.pn; return true; }
            return false;
        }
        const long L = (long)i * G + c;
        if (L >= nwg) return false;
        int wgid = (int)L; { const int q = nwg / NXCD, r = nwg % NXCD, xcd = wgid % NXCD, off = wgid / NXCD; wgid = (xcd < r ? xcd * (q + 1) : r * (q + 1) + (xcd - r) * q) + off; }
        const int nig = WGM * nN, gid = wgid / nig, fm = gid * WGM, gsz = (nM - fm) < WGM ? (nM - fm) : WGM;
        u.pm = fm + ((wgid % nig) % gsz); u.pn = (wgid % nig) / gsz; u.kq = -1; u.ti = 0; return true;
    }
};

template <class Epi>
__device__ __forceinline__ void gemm_phase(LAS unsigned char* lds, const Gemm g, const StaticOrder& S, const Epi& E) {
    const int tid = tid_opaque(), wid = __builtin_amdgcn_readfirstlane(tid >> 6), lane = tid & 63, wr = wid >> 2, wc = wid & 3, fr = lane & 15, fq = lane >> 4;
    const int K = g.K;
    unsigned voffA[2], voffB[2];
#pragma unroll
    for (int i = 0; i < 2; ++i) { int R, C; stage_rc(tid * 16 + i * 8192, R, C); const int Rb = (R & ~31) + perm32(R & 31); voffA[i] = (unsigned)(R * K + C) * 2u; voffB[i] = (unsigned)(Rb * K + C) * 2u; }
    const size_t kstep = (size_t)(BK * 2);
    const size_t hstep = (size_t)HALF * K * 2;
    const size_t tstep = 2 * hstep;
    const unsigned ldsw = (unsigned)wid * 1024u;
    const int aoff = lds_byte(wr * 64 + fr, fq * 8), boff = lds_byte(wc * 32 + fr, fq * 8);
#define PG8_SA(b, h) (((b) * 2 + (h)) * HTB)
#define PG8_SB(b, h) ((4 + (b) * 2 + (h)) * HTB)
#define PG8_STAGE(bufoff, gbase, voff) do { _Pragma("unroll") for (int _i = 0; _i < 2; ++_i) \
        __builtin_amdgcn_global_load_lds((const unsigned*)((const char*)(gbase) + (voff)[_i]), (LAS unsigned*)(lds + (bufoff) + ldsw + _i * 8192), 16, 0, 0); } while (0)
#define PG8_LDA(dst, b, h) do { _Pragma("unroll") for (int m = 0; m < 4; ++m) _Pragma("unroll") for (int k = 0; k < 2; ++k) dst[m][k] = *(const LAS bf16x8*)(lds + PG8_SA(b, h) + aoff + m * 2048 + k * 1024); } while (0)
#define PG8_LDB(dst, b, h) do { _Pragma("unroll") for (int n = 0; n < 2; ++n) _Pragma("unroll") for (int k = 0; k < 2; ++k) dst[n][k] = *(const LAS bf16x8*)(lds + PG8_SB(b, h) + boff + n * 2048 + k * 1024); } while (0)
#define PG8_MMA(ai, bj, At, Bt) do { __builtin_amdgcn_s_setprio(1); _Pragma("unroll") for (int m = 0; m < 4; ++m) _Pragma("unroll") for (int n = 0; n < 2; ++n) _Pragma("unroll") for (int k = 0; k < 2; ++k) \
        acc[ai][bj][m][n] = __builtin_amdgcn_mfma_f32_16x16x32_bf16(Bt[n][k], At[m][k], acc[ai][bj][m][n], 0, 0, 0); __builtin_amdgcn_s_setprio(0); } while (0)
#define PG8_WAIT_V(n) asm volatile("s_waitcnt vmcnt(" #n ")" ::: "memory")
#define PG8_WAIT_L(n) asm volatile("s_waitcnt lgkmcnt(" #n ")" ::: "memory")
#define PG8_BAR __builtin_amdgcn_s_barrier()
#define PG8_SCHED __builtin_amdgcn_sched_barrier(0)
    Unit cur, nxt; int ui = 0;
    if (!S.next(0, cur)) return;
    f32x4 acc[2][2][4][2];
#pragma unroll
    for (int a = 0; a < 2; ++a)
#pragma unroll
        for (int b = 0; b < 2; ++b)
#pragma unroll
            for (int m = 0; m < 4; ++m)
#pragma unroll
                for (int n = 0; n < 2; ++n) acc[a][b][m][n] = (f32x4){0.f, 0.f, 0.f, 0.f};
    bf16x8 At[4][2], B0[2][2], B1[2][2];
    const char* cA = E.swapped(cur) ? (const char*)g.Bt + (size_t)cur.pn * tstep : (const char*)g.A + (size_t)cur.pm * tstep;
    const char* cB = E.swapped(cur) ? (const char*)g.A + (size_t)cur.pm * tstep : (const char*)g.Bt + (size_t)cur.pn * tstep;
    const size_t qstep = (size_t)(K >> 2) * 2;
    if (cur.kq >= 0) { cA += cur.kq * qstep; cB += cur.kq * qstep; }
    PG8_STAGE(PG8_SB(0, 0), cB, voffB); PG8_STAGE(PG8_SA(0, 0), cA, voffA); PG8_STAGE(PG8_SB(0, 1), cB + hstep, voffB); PG8_STAGE(PG8_SA(0, 1), cA + hstep, voffA);
    if (wr == 1) PG8_BAR;
    PG8_WAIT_V(4); PG8_BAR;
    PG8_STAGE(PG8_SB(1, 0), cB + kstep, voffB); PG8_STAGE(PG8_SA(1, 0), cA + kstep, voffA); PG8_STAGE(PG8_SB(1, 1), cB + hstep + kstep, voffB);
    PG8_WAIT_V(6); PG8_BAR;
    for (;;) {
        const bool has_next = S.next(ui + 1, nxt);
        const bool nsw = has_next && E.swapped(nxt);
        const char* nA = has_next ? (nsw ? (const char*)g.Bt + (size_t)nxt.pn * tstep : (const char*)g.A + (size_t)nxt.pm * tstep) : cA;
        const char* nB = has_next ? (nsw ? (const char*)g.A + (size_t)nxt.pm * tstep : (const char*)g.Bt + (size_t)nxt.pn * tstep) : cB;
        if (has_next && nxt.kq >= 0) { nA += nxt.kq * qstep; nB += nxt.kq * qstep; }
        const int nt = (cur.kq >= 0 ? (K >> 2) : K) / BK;
        for (int t = 0; t < nt; t += 2) {
            const bool last = (t == nt - 2);
            const char* a1 = cA + (size_t)(t + 1) * kstep;
            const char* a2 = last ? nA : cA + (size_t)(t + 2) * kstep; const char* b2 = last ? nB : cB + (size_t)(t + 2) * kstep;
            const char* a3 = a2 + kstep; const char* b3 = b2 + kstep;
            PG8_LDB(B0, 0, 0); PG8_SCHED; PG8_LDA(At, 0, 0); PG8_STAGE(PG8_SA(1, 1), a1 + hstep, voffA);
            PG8_WAIT_L(8); PG8_BAR; PG8_WAIT_L(0); PG8_MMA(0, 0, At, B0); PG8_BAR; PG8_SCHED;
            PG8_LDB(B1, 0, 1); PG8_STAGE(PG8_SB(0, 0), b2, voffB);
            PG8_BAR; PG8_WAIT_L(0); PG8_MMA(0, 1, At, B1); PG8_BAR;
            PG8_LDA(At, 0, 1); PG8_STAGE(PG8_SA(0, 0), a2, voffA);
            PG8_BAR; PG8_WAIT_L(0); PG8_MMA(1, 0, At, B0); PG8_BAR; PG8_SCHED;
            PG8_STAGE(PG8_SB(0, 1), b2 + hstep, voffB);
            PG8_WAIT_V(6); PG8_BAR; PG8_MMA(1, 1, At, B1); PG8_BAR;
            PG8_LDB(B0, 1, 0); PG8_SCHED; PG8_LDA(At, 1, 0); PG8_STAGE(PG8_SA(0, 1), a2 + hstep, voffA);
            PG8_WAIT_L(8); PG8_BAR; PG8_WAIT_L(0); PG8_MMA(0, 0, At, B0); PG8_BAR; PG8_SCHED;
            PG8_LDB(B1, 1, 1); PG8_STAGE(PG8_SB(1, 0), b3, voffB);
            PG8_BAR; PG8_WAIT_L(0); PG8_MMA(0, 1, At, B1); PG8_BAR;
            PG8_LDA(At, 1, 1); PG8_STAGE(PG8_SA(1, 0), a3, voffA);
            PG8_BAR; PG8_WAIT_L(0); PG8_MMA(1, 0, At, B0); PG8_BAR; PG8_SCHED;
            PG8_STAGE(PG8_SB(1, 1), b3 + hstep, voffB);
            PG8_WAIT_V(6); PG8_BAR; PG8_MMA(1, 1, At, B1); PG8_BAR;
        }
        if (cur.kq < 0) E(acc, cur, wr, wc, fr, fq);
        if (!has_next) break;
#pragma unroll
        for (int a = 0; a < 2; ++a)
#pragma unroll
            for (int b = 0; b < 2; ++b)
#pragma unroll
                for (int m = 0; m < 4; ++m)
#pragma unroll
                    for (int n = 0; n < 2; ++n) acc[a][b][m][n] = (f32x4){0.f, 0.f, 0.f, 0.f};
        cur = nxt; cA = nA; cB = nB; ++ui;
    }
    PG8_WAIT_V(0);
    if (wr == 0) PG8_BAR;
    PG8_BAR;
    if constexpr (Epi::SPLIT) {
    if (cur.kq >= 0) {
        const __amdgpu_buffer_rsrc_t drs = __builtin_amdgcn_make_buffer_rsrc((void*)(g.dump + (size_t)cur.ti * 4 * (64 * 512)), 0, 4 * 64 * 512 * 8, 0x00020000);
        unsigned lo = (unsigned)tid * 16u;
        { const unsigned qo = (unsigned)cur.kq * (64 * 512 * 8);
#pragma unroll
          for (int a = 0; a < 2; ++a)
#pragma unroll
              for (int b = 0; b < 2; ++b)
#pragma unroll
                  for (int m = 0; m < 4; ++m)
#pragma unroll
                      for (int n = 0; n < 2; ++n) { asm volatile("" : "+v"(lo));
                          __builtin_amdgcn_raw_buffer_store_b128(__builtin_bit_cast(u32x4, acc[a][b][m][n]), drs, qo + (unsigned)((((a * 2 + b) * 4 + m) * 2 + n) * (512 * 16)) + lo, 0,   16); } }
        asm volatile("s_waitcnt vmcnt(0)" ::: "memory");
        __syncthreads();
        if (tid == 0) { const unsigned old = __hip_atomic_fetch_add(g.cnt + cur.ti, 1u, __ATOMIC_RELAXED, __HIP_MEMORY_SCOPE_AGENT); *(LAS unsigned*)lds = old;
            if (old == 3u) __hip_atomic_store(g.cnt + cur.ti, 0u, __ATOMIC_RELAXED, __HIP_MEMORY_SCOPE_AGENT); }
        __syncthreads();
        const unsigned arrived = __builtin_amdgcn_readfirstlane(*(LAS unsigned*)lds);
        if (arrived == 3u) {
#pragma unroll
            for (int a = 0; a < 2; ++a)
#pragma unroll
                for (int m = 0; m < 4; ++m) { f32x4 v[2][2];
#pragma unroll
                    for (int b = 0; b < 2; ++b)
#pragma unroll
                        for (int n = 0; n < 2; ++n) { asm volatile("" : "+v"(lo)); const unsigned o = (unsigned)((((a * 2 + b) * 4 + m) * 2 + n) * (512 * 16)) + lo;
                            const f32x4 p0 = __builtin_bit_cast(f32x4, __builtin_amdgcn_raw_buffer_load_b128(drs, o, 0, 16)), p1 = __builtin_bit_cast(f32x4, __builtin_amdgcn_raw_buffer_load_b128(drs, o + 64 * 512 * 8, 0, 16)),
                                        p2 = __builtin_bit_cast(f32x4, __builtin_amdgcn_raw_buffer_load_b128(drs, o + 2 * 64 * 512 * 8, 0, 16)), p3 = __builtin_bit_cast(f32x4, __builtin_amdgcn_raw_buffer_load_b128(drs, o + 3 * 64 * 512 * 8, 0, 16));
                            v[b][n] = (p0 + p1) + (p2 + p3); }
                    E.rg(a, m, v, cur, wr, wc, fr, fq); if (m & 1) asm volatile("" ::: "memory"); }
        }
        __syncthreads();
    }
    }
#undef PG8_SA
#undef PG8_SB
#undef PG8_STAGE
#undef PG8_LDA
#undef PG8_LDB
#undef PG8_MMA
#undef PG8_WAIT_V
#undef PG8_WAIT_L
#undef PG8_BAR
#undef PG8_SCHED
}
}
using pg8::Unit;
typedef const f32x4 (&AccRef)[2][2][4][2];

__device__ __forceinline__ void st_bf16x4(bf16_t* p, f32x4 v) { u32x2 w; w.x = cvt_pk_bf16(v[0], v[1]); w.y = cvt_pk_bf16(v[2], v[3]); *(u32x2*)p = w; }
__device__ __forceinline__ void st_bf16x8(bf16_t* p, f32x4 a, f32x4 b) { u32x4 w; w.x = cvt_pk_bf16(a[0], a[1]); w.y = cvt_pk_bf16(a[2], a[3]); w.z = cvt_pk_bf16(b[0], b[1]); w.w = cvt_pk_bf16(b[2], b[3]); *(u32x4*)p = w; }
__device__ __forceinline__ bf16_t bf16_1(float v) { return (bf16_t)(cvt_pk_bf16(v, 0.f) & 0xffffu); }

struct EpiG1 {
    static constexpr bool SPLIT = false;
    __device__ __forceinline__ bool swapped(const Unit& u) const { return u.pn >= 16 && u.pn < 24; }
    bf16_t *aglu, *q, *k, *kt, *vt, *rg, *gate; const float *rcos, *rsin;
    __device__ __forceinline__ void operator()(AccRef acc, const Unit& u, int wr, int wc, int fr, int fq) const {
        const int pn = u.pn, row0 = u.pm * 256 + wr * 64 + fr, ct = wc * 32 + 8 * fq;
        if (pn < 8) {
#pragma unroll
            for (int ai = 0; ai < 2; ++ai)
#pragma unroll
                for (int m = 0; m < 4; ++m) { const int row = row0 + ai * 128 + m * 16; f32x4 o[2];
#pragma unroll
                    for (int n = 0; n < 2; ++n) { const f32x4 a = acc[ai][0][m][n], b = acc[ai][1][m][n];
#pragma unroll
                        for (int r = 0; r < 4; ++r) o[n][r] = a[r] * sigmoidf_(b[r]); }
                    st_bf16x8(aglu + (size_t)row * DM + pn * 128 + ct, o[0], o[1]); }
        } else if (pn < 16) {
            const bool isK = pn >= 12; const int h = (pn - 8) & 3; const float sc = isK ? 0.0625f : 1.0f; bf16_t* dst = isK ? k : q;
#pragma unroll
            for (int ai = 0; ai < 2; ++ai)
#pragma unroll
                for (int m = 0; m < 4; ++m) { const int row = row0 + ai * 128 + m * 16; const bool lat = row >= TC; const int pos = (row - TC) & 2047, gr = pos >> 6, gc = pos & 63; f32x4 o1[2], o2[2];
#pragma unroll
                    for (int n = 0; n < 2; ++n) { const int d1 = ct + n * 4; const f32x4 x1 = acc[ai][0][m][n] * sc, x2 = acc[ai][1][m][n] * sc; o1[n] = x1; o2[n] = x2;
                        if (lat) { const int ti = (d1 < 64) ? gr * 64 + d1 : gc * 64 + d1 - 64; const f32x4 cs = *(const f32x4*)(rcos + ti), sn = *(const f32x4*)(rsin + ti);
                            o1[n] = x1 * cs - x2 * sn; o2[n] = x2 * cs + x1 * sn; }
                        if (isK) {
#pragma unroll
                            for (int r = 0; r < 4; ++r) { kt[(size_t)(h * 256 + d1 + r) * TT + row] = bf16_1(o1[n][r]); kt[(size_t)(h * 256 + 128 + d1 + r) * TT + row] = bf16_1(o2[n][r]); } } }
                    st_bf16x8(dst + (size_t)row * DM + h * 256 + ct, o1[0], o1[1]); st_bf16x8(dst + (size_t)row * DM + h * 256 + 128 + ct, o2[0], o2[1]); }
        } else if (pn < 24) {
            const int e0 = (pn - 16) * 256 + wr * 64 + fr, t0 = u.pm * 256 + ct;
#pragma unroll
            for (int ai = 0; ai < 2; ++ai)
#pragma unroll
                for (int m = 0; m < 4; ++m) { bf16_t* vr = vt + (size_t)(e0 + ai * 128 + m * 16) * TT + t0;
#pragma unroll
                    for (int bj = 0; bj < 2; ++bj) st_bf16x8(vr + bj * 128, acc[ai][bj][m][0], acc[ai][bj][m][1]); }
        } else {
            const bool isG = pn >= 32; bf16_t* dst = isG ? gate : rg; const int cb = ((pn - 24) & 7) * 256;
#pragma unroll
            for (int ai = 0; ai < 2; ++ai)
#pragma unroll
                for (int m = 0; m < 4; ++m) { const int row = row0 + ai * 128 + m * 16;
#pragma unroll
                    for (int bj = 0; bj < 2; ++bj) { f32x4 o[2];
#pragma unroll
                        for (int n = 0; n < 2; ++n) { const f32x4 v = acc[ai][bj][m][n];
#pragma unroll
                            for (int r = 0; r < 4; ++r) { const float s = sigmoidf_(v[r]); o[n][r] = isG ? s : v[r] * s; } }
                        st_bf16x8(dst + (size_t)row * VW + cb + bj * 128 + ct, o[0], o[1]); } }
        }
    }
};

struct EpiE1 {
    static constexpr bool SPLIT = false;
    __device__ __forceinline__ bool swapped(const Unit&) const { return false; }
    bf16_t* m1; const bf16_t* gate;
    __device__ __forceinline__ void operator()(AccRef acc, const Unit& u, int wr, int wc, int fr, int fq) const {
        const int row0 = u.pm * 256 + wr * 64 + fr, col0 = u.pn * 256 + wc * 32 + 8 * fq;
#pragma unroll
        for (int ai = 0; ai < 2; ++ai)
#pragma unroll
            for (int m = 0; m < 4; ++m) { const int row = row0 + ai * 128 + m * 16;
#pragma unroll
                for (int bj = 0; bj < 2; ++bj) { const int col = col0 + bj * 128; const u32x4 gv = *(const u32x4*)(gate + (size_t)row * VW + col); const f32x4 v0 = acc[ai][bj][m][0], v1 = acc[ai][bj][m][1];
                    f32x4 o0, o1; o0[0] = v0[0] * bf_lo(gv.x); o0[1] = v0[1] * bf_hi(gv.x); o0[2] = v0[2] * bf_lo(gv.y); o0[3] = v0[3] * bf_hi(gv.y);
                    o1[0] = v1[0] * bf_lo(gv.z); o1[1] = v1[1] * bf_hi(gv.z); o1[2] = v1[2] * bf_lo(gv.w); o1[3] = v1[3] * bf_hi(gv.w);
                    st_bf16x8(m1 + (size_t)row * DM + col, o0, o1); } }
    }
};
struct EpiE2 {
    static constexpr bool SPLIT = false;
    __device__ __forceinline__ bool swapped(const Unit&) const { return false; }
    const bf16_t* m1; const bf16_t* gate; bf16_t* mm;
    __device__ __forceinline__ void operator()(AccRef acc, const Unit& u, int wr, int wc, int fr, int fq) const {
        const int row0 = u.pm * 256 + wr * 64 + fr, col0 = u.pn * 256 + wc * 32 + 8 * fq;
#pragma unroll
        for (int ai = 0; ai < 2; ++ai)
#pragma unroll
            for (int m = 0; m < 4; ++m) { const int row = row0 + ai * 128 + m * 16;
#pragma unroll
                for (int bj = 0; bj < 2; ++bj) { const int col = col0 + bj * 128; const u32x4 gv = *(const u32x4*)(gate + (size_t)row * VW + DM + col), mv = *(const u32x4*)(m1 + (size_t)row * DM + col); const f32x4 v0 = acc[ai][bj][m][0], v1 = acc[ai][bj][m][1];
                    f32x4 o0, o1; o0[0] = bf_lo(mv.x) + v0[0] * bf_lo(gv.x); o0[1] = bf_hi(mv.x) + v0[1] * bf_hi(gv.x); o0[2] = bf_lo(mv.y) + v0[2] * bf_lo(gv.y); o0[3] = bf_hi(mv.y) + v0[3] * bf_hi(gv.y);
                    o1[0] = bf_lo(mv.z) + v1[0] * bf_lo(gv.z); o1[1] = bf_hi(mv.z) + v1[1] * bf_hi(gv.z); o1[2] = bf_lo(mv.w) + v1[2] * bf_lo(gv.w); o1[3] = bf_hi(mv.w) + v1[3] * bf_hi(gv.w);
                    st_bf16x8(mm + (size_t)row * DM + col, o0, o1); } }
    }
};
template <bool SPLIT_> struct EpiResT {
    static constexpr bool SPLIT = SPLIT_;
    __device__ __forceinline__ bool swapped(const Unit&) const { return false; }
    const float *xa, *xb; float* xout; const float* gvec;
    __device__ __forceinline__ void rg(int ai, int m, const f32x4 (&v)[2][2], const Unit& u, int wr, int wc, int fr, int fq) const {
        const int row = u.pm * 256 + wr * 64 + fr + ai * 128 + m * 16, col0 = u.pn * 256 + wc * 32 + 8 * fq;
        const float* xr = row < TC ? xa + (size_t)row * DM : xb + (size_t)(row - TC) * DM; const float* gr = gvec + row_group(row) * 6144;
#pragma unroll
        for (int bj = 0; bj < 2; ++bj)
#pragma unroll
            for (int n = 0; n < 2; ++n) { const int col = col0 + bj * 128 + n * 4; const f32x4 xv = *(const f32x4*)(xr + col), gv = *(const f32x4*)(gr + col);
                *(f32x4*)(xout + (size_t)row * DM + col) = xv + gv * v[bj][n]; }
    }
    __device__ __forceinline__ void operator()(AccRef acc, const Unit& u, int wr, int wc, int fr, int fq) const {
#pragma unroll
        for (int a = 0; a < 2; ++a)
#pragma unroll
            for (int m = 0; m < 4; ++m) { const f32x4 v[2][2] = {{acc[a][0][m][0], acc[a][0][m][1]}, {acc[a][1][m][0], acc[a][1][m][1]}}; rg(a, m, v, u, wr, wc, fr, fq); }
    }
};
struct EpiF1 {
    static constexpr bool SPLIT = false;
    __device__ __forceinline__ bool swapped(const Unit&) const { return false; }
    bf16_t* uo;
    __device__ __forceinline__ void operator()(AccRef acc, const Unit& u, int wr, int wc, int fr, int fq) const {
        const int row0 = u.pm * 256 + wr * 64 + fr, col0 = u.pn * 256 + wc * 32 + 8 * fq;
#pragma unroll
        for (int ai = 0; ai < 2; ++ai)
#pragma unroll
            for (int m = 0; m < 4; ++m) { const int row = row0 + ai * 128 + m * 16;
#pragma unroll
                for (int bj = 0; bj < 2; ++bj) { f32x4 o[2];
#pragma unroll
                    for (int n = 0; n < 2; ++n) { const f32x4 v = acc[ai][bj][m][n];
#pragma unroll
                        for (int r = 0; r < 4; ++r) { const float t = fmaxf(v[r], 0.f); o[n][r] = t * t; } }
                    st_bf16x8(uo + (size_t)row * MLPW + col0 + bj * 128, o[0], o[1]); } }
    }
};

__device__ __forceinline__ void tconv_item(const float* __restrict__ src, bf16_t* __restrict__ dst, int K, int N, int item, bool permIn, float* tile  ) {
    const int tilesN = N >> 8, kt = item / tilesN, ntile = item - kt * tilesN, k0 = kt * 64, n0 = ntile * 256, tid = tid_opaque();
    { const int r = tid >> 6, c4 = (tid & 63) * 4; f32x4 v[8];
#pragma unroll
      for (int rr = 0; rr < 8; ++rr) v[rr] = __builtin_nontemporal_load((const f32x4*)(src + (size_t)(k0 + r + rr * 8) * N + n0 + c4));
#pragma unroll
      for (int rr = 0; rr < 8; ++rr) { float* t = tile + (r + rr * 8) * 257 + c4; t[0] = v[rr][0]; t[1] = v[rr][1]; t[2] = v[rr][2]; t[3] = v[rr][3]; } }
    __syncthreads();
#pragma unroll
    for (int q = 0; q < 4; ++q) { const int n = q * 64 + (tid >> 3), k8 = (tid & 7) * 8; float v[8];
#pragma unroll
      for (int e = 0; e < 8; ++e) v[e] = tile[(k8 + e) * 257 + n];
      int nn = n0 + n;
      if (permIn && nn < 2048) { const int c = nn & 1023, half = nn >> 10; nn = (c >> 7) * 256 + half * 128 + (c & 127); }
      u32x4 w; w.x = cvt_pk_bf16(v[0], v[1]); w.y = cvt_pk_bf16(v[2], v[3]); w.z = cvt_pk_bf16(v[4], v[5]); w.w = cvt_pk_bf16(v[6], v[7]);
      *(u32x4*)(dst + (size_t)nn * K + k0 + k8) = w; }
    __syncthreads();
}

__device__ void phase0(const Params& p, unsigned char* smem) {
    float* tile = (float*)smem;
    float* scond = (float*)(smem + 66048);
    float* red = (float*)(smem + 66048 + 36864);
    const int tid = tid_opaque();
    constexpr int NT_L = 1408, NT = 2 * NT_L, NMOD = 192;
    for (int it = blockIdx.x; it < NT + NMOD + 1; it += gridDim.x) {
        if (it < NT) {
            const int l = it / NT_L; int j = it - l * NT_L; unsigned char* wb = p.ws + WS_W + (size_t)l * WL_SZ;
            if (j < 640) tconv_item(p.in[9] + (size_t)l * DM * PW, (bf16_t*)(wb + WL_IN), DM, PW, j, true, tile);
            else if ((j -= 640) < 64) tconv_item(p.in[13] + (size_t)l * DM * DM, (bf16_t*)(wb + WL_CONV), DM, DM, j, false, tile);
            else if ((j -= 64) < 128) tconv_item(p.in[15] + (size_t)l * VW * DM, (bf16_t*)(wb + WL_RET), VW, DM, j, false, tile);
            else if ((j -= 128) < 64) tconv_item(p.in[16] + (size_t)l * DM * DM, (bf16_t*)(wb + WL_OUT), DM, DM, j, false, tile);
            else if ((j -= 64) < 256) tconv_item(p.in[17] + (size_t)l * DM * MLPW, (bf16_t*)(wb + WL_M1), DM, MLPW, j, false, tile);
            else { j -= 256; tconv_item(p.in[18] + (size_t)l * MLPW * DM, (bf16_t*)(wb + WL_M2), MLPW, DM, j, false, tile); }
        } else if (it < NT + NMOD) {
            const int j = it - NT, l = j / 96, c0 = (j % 96) * 64;
            for (int idx = tid; idx < 9 * 1024; idx += NTHR) { const int g = idx >> 10, k = idx & 1023; const float v = g == 0 ? p.in[4][k] : p.in[2][(g - 1) * 1024 + k]; scond[idx] = siluf_(v); }
            __syncthreads();
            const int col = tid & 63, kg = tid >> 6; float a[9];
#pragma unroll
            for (int g = 0; g < 9; ++g) a[g] = 0.f;
            const float* wm = p.in[7] + (size_t)l * DM * 6144 + c0 + col;
#pragma unroll 16
            for (int k = kg * 128; k < kg * 128 + 128; ++k) { const float w = __builtin_nontemporal_load(wm + (size_t)k * 6144);
#pragma unroll
                for (int g = 0; g < 9; ++g) a[g] += scond[g * 1024 + k] * w; }
#pragma unroll
            for (int g = 0; g < 9; ++g) red[(kg * 9 + g) * 64 + col] = a[g];
            __syncthreads();
            for (int o = tid; o < 9 * 64; o += NTHR) { const int g = o >> 6, cc = o & 63; float s = 0.f;
#pragma unroll
                for (int q = 0; q < 8; ++q) s += red[(q * 9 + g) * 64 + cc];
                ((float*)(p.ws + WS_MOD))[(size_t)(l * 9 + g) * 6144 + c0 + cc] = s + p.in[8][l * 6144 + c0 + cc]; }
            __syncthreads();
        } else {
            float* rc = (float*)(p.ws + WS_ROPE); float* rs = rc + 4096;
            if (tid < 64) ((unsigned*)(p.ws + WS_CNT))[tid] = 0u;
            for (int idx = tid; idx < 4096; idx += NTHR) { const int pos = idx >> 6, i = idx & 63; const float inv = exp2f(-(float)i * (13.287712379549449f / 64.f)); const float ang = (float)pos * inv;
                rc[idx] = __cosf(ang); rs[idx] = __sinf(ang); }
        }
    }
}

__device__ void norm_mod_phase(const float* xa, const float* xb, bf16_t* dst, const float* ng, const float* modl, int sh_chunk) {
    const int tid = tid_opaque(), lane = tid & 63, gw = blockIdx.x * 8 + (tid >> 6), nw = gridDim.x * 8;
    for (int row0 = gw; row0 < TT; row0 += 2 * nw) {
        f32x4 v[2][4]; float ss[2];
#pragma unroll
        for (int q = 0; q < 2; ++q) { const int row = min(row0 + q * nw, TT - 1); const float* xr = row < TC ? xa + (size_t)row * DM : xb + (size_t)(row - TC) * DM;
#pragma unroll
            for (int i = 0; i < 4; ++i) v[q][i] = __builtin_nontemporal_load((const f32x4*)(xr + i * 256 + lane * 4)); }
#pragma unroll
        for (int q = 0; q < 2; ++q) { float s = 0.f;
#pragma unroll
            for (int i = 0; i < 4; ++i) s += v[q][i][0] * v[q][i][0] + v[q][i][1] * v[q][i][1] + v[q][i][2] * v[q][i][2] + v[q][i][3] * v[q][i][3];
            ss[q] = s; }
#pragma unroll
        for (int q = 0; q < 2; ++q) { const int row = row0 + q * nw; if (row >= TT) break;
            const float rstd = rsqrtf(wave_sum(ss[q]) * (1.f / DM) + EPSV); const float* md = modl + row_group(row) * 6144;
#pragma unroll
            for (int i = 0; i < 4; ++i) { const int c = i * 256 + lane * 4; const f32x4 g = *(const f32x4*)(ng + c), sh = *(const f32x4*)(md + sh_chunk * 1024 + c), sc = *(const f32x4*)(md + (sh_chunk + 1) * 1024 + c);
                const f32x4 o = v[q][i] * rstd * g * (sc + 1.f) + sh; st_bf16x4(dst + (size_t)row * DM + c, o); } }
    }
}
__device__ void final_norm_phase(float* x, const float* ng) {
    const int tid = tid_opaque(), lane = tid & 63, gw = blockIdx.x * 8 + (tid >> 6), nw = gridDim.x * 8;
    for (int row = gw; row < TT; row += nw) {
        float* xr = x + (size_t)row * DM; f32x4 v[4]; float ss = 0.f;
#pragma unroll
        for (int i = 0; i < 4; ++i) { v[i] = __builtin_nontemporal_load((const f32x4*)(xr + i * 256 + lane * 4)); ss += v[i][0] * v[i][0] + v[i][1] * v[i][1] + v[i][2] * v[i][2] + v[i][3] * v[i][3]; }
        ss = wave_sum(ss); const float rstd = rsqrtf(ss * (1.f / DM) + EPSV);
#pragma unroll
        for (int i = 0; i < 4; ++i) { const int c = i * 256 + lane * 4; const f32x4 g = *(const f32x4*)(ng + c); __builtin_nontemporal_store(v[i] * rstd * g, (f32x4*)(xr + c)); }
    }
}

__device__ void conv_phase(const Params& p, int l, unsigned char* smem) {
    const int tid = tid_opaque(), lane = tid & 63, wv = tid >> 6;
    const bf16_t* aglu = (const bf16_t*)(p.ws + WS_R2); bf16_t* aconv = (bf16_t*)(p.ws + WS_R1);
    float* red = (float*)(smem + 46 * 2048);
    float* rst = red + 128;
    const int c0 = 2 * tid;
    float w0[31], w1[31];
#pragma unroll
    for (int j = 0; j < 31; ++j) { const f32x2 wv2 = *(const f32x2*)(p.in[10] + (size_t)(l * 31 + j) * DM + c0); w0[j] = wv2.x; w1[j] = wv2.y; }
    const f32x2 bias = *(const f32x2*)(p.in[11] + l * DM + c0), gn = *(const f32x2*)(p.in[12] + l * DM + c0);
    for (int it = blockIdx.x; it < TT / 16; it += gridDim.x) {
        const int t0 = it * 16, segl = t0 < TC ? 256 : 64, ss = t0 & ~(segl - 1), se = ss + segl;
        for (int idx = tid; idx < 46 * 128; idx += NTHR) { const int rr = idx >> 7, ch = idx & 127, tt = t0 - 15 + rr; u32x4 v = (u32x4){0u, 0u, 0u, 0u};
            if (tt >= ss && tt < se) v = *(const u32x4*)(aglu + (size_t)tt * DM + ch * 8);
            *(u32x4*)(smem + rr * 2048 + ch * 16) = v; }
        __syncthreads();
        float a0[16], a1[16];
#pragma unroll
        for (int t = 0; t < 16; ++t) { a0[t] = bias.x; a1[t] = bias.y; }
#pragma unroll
        for (int rr = 0; rr < 46; ++rr) { const unsigned uv = *(const unsigned*)(smem + rr * 2048 + c0 * 2); const float lo = bf_lo(uv), hi = bf_hi(uv);
#pragma unroll
            for (int t = 0; t < 16; ++t) { const int j = rr - t; if (j >= 0 && j < 31) { a0[t] += w0[j] * lo; a1[t] += w1[j] * hi; } } }
#pragma unroll
        for (int t = 0; t < 16; ++t) { const float s = wave_sum(a0[t] * a0[t] + a1[t] * a1[t]); if (lane == 0) red[wv * 16 + t] = s; }
        __syncthreads();
        if (tid < 16) { float s = 0.f;
#pragma unroll
            for (int q = 0; q < 8; ++q) s += red[q * 16 + tid];
            rst[tid] = rsqrtf(s * (1.f / DM) + EPSV); }
        __syncthreads();
#pragma unroll
        for (int t = 0; t < 16; ++t) { const float r = rst[t]; *(unsigned*)(aconv + (size_t)(t0 + t) * DM + c0) = cvt_pk_bf16(siluf_(a0[t] * r * gn.x), siluf_(a1[t] * r * gn.y)); }
        __syncthreads();
    }
}

__device__ void ret_phase(const Params& p, int l, unsigned char* smem) {
    LAS unsigned char* lds = (LAS unsigned char*)smem;
    const int tid = tid_opaque(), lane = tid & 63, w = __builtin_amdgcn_readfirstlane(tid >> 6), fr = lane & 15, fq = lane >> 4;
    const bf16_t* Qg = (const bf16_t*)(p.ws + WS_Q); const bf16_t* Kg = (const bf16_t*)(p.ws + WS_K); const bf16_t* KTg = (const bf16_t*)(p.ws + WS_KT); const bf16_t* VTg = (const bf16_t*)(p.ws + WS_VT);
    constexpr int QOFF = 0, KTOFF = 65536;
    const unsigned voffQ = (unsigned)(((2 * w + (lane >> 5)) * DM + (((lane & 31) ^ ((2 * w + (lane >> 5)) & 15))) * 8) * 2);
    const unsigned voffKT = (unsigned)(((4 * w + (lane >> 4)) * TT + (((lane & 15) ^ ((((2 * w + (lane >> 5)) & 12)) | ((lane >> 4) & 3)))) * 8) * 2);
    const unsigned voffK = (unsigned)(((16 * w + fr) * DM + fq * 8) * 2);
    const unsigned voffV = (unsigned)(((16 * w + fr) * TT + fq * 8) * 2);
    const unsigned voffY = (unsigned)(((4 * fq) * VW + 16 * w + fr) * 2);
    int xb[4];
#pragma unroll
    for (int k4 = 0; k4 < 4; ++k4) xb[k4] = ((k4 * 4 + fq) ^ fr) * 16;
    for (int it = blockIdx.x; it < 768; it += gridDim.x) {
        int es, dir, h, bb, tok0, nch; const bool lat = it < 256;
        { const int j = lat ? it : it - 256, x = j & 7, y = j >> 3; es = y & 3; const int cmb = (y >> 2) * 8 + x; dir = cmb & 1; h = (cmb >> 1) & 3; bb = cmb >> 3;
          tok0 = lat ? TC + bb * 2048 : bb * 256; nch = lat ? 16 : 2; }
        const float dl = p.in[14][l * 8 + dir * 4 + h]; const float lg2 = -log1pf(expf(-dl)) * 1.4426950408889634f;
        const float sdec = exp2f(128.f * lg2);
        const float zl = dir ? -lg2 : lg2, zb2 = (float)(dir ? 128 - 4 * fq : 4 * fq + 1) * lg2, kb2 = (float)(dir ? 8 * fq : 127 - 8 * fq) * lg2;
        const int pbase = dir ? (16 * w + 4 * fq - fr) : (fr - 16 * w - 4 * fq);
        f32x4 S[16];
        const unsigned voffS = (unsigned)((8 * fq * 512 + 16 * w + fr) * 4);
        if (lat) { const float* sp = p.in[3] + ((((size_t)bb * 2 + l) * 2 + dir) * 4 + h) * 256 * 512 + es * 128;
#pragma unroll
            for (int D = 0; D < 16; ++D)
#pragma unroll
                for (int r = 0; r < 4; ++r) S[D][r] = __builtin_nontemporal_load((const float*)((const char*)(sp + ((D >> 1) * 32 + 4 * (D & 1) + r) * 512) + voffS));
        } else {
#pragma unroll
            for (int D = 0; D < 16; ++D) S[D] = (f32x4){0.f, 0.f, 0.f, 0.f};
        }
        bf16_t* Yg = (bf16_t*)(p.ws + (dir ? WS_YB : WS_YF));
        for (int s = 0; s < nch; ++s) {
            const int c = dir ? nch - 1 - s : s, r0 = tok0 + c * 128;
            { const bf16_t* qu = Qg + (size_t)r0 * DM + h * 256; const bf16_t* ku = KTg + (size_t)(h * 256) * TT + r0;
#pragma unroll
              for (int n = 0; n < 8; ++n) {
                  __builtin_amdgcn_global_load_lds((const unsigned*)((const char*)(qu + (size_t)(n * 16) * DM) + voffQ), (LAS unsigned*)(lds + QOFF + (n * 8 + w) * 1024), 16, 0, 0);
                  __builtin_amdgcn_global_load_lds((const unsigned*)((const char*)(ku + (size_t)(n * 32) * TT) + voffKT), (LAS unsigned*)(lds + KTOFF + (n * 8 + w) * 1024), 16, 0, 0); } }
            bf16x8 Kf[8], Vf[4];
            { const char* kb = (const char*)(Kg + (size_t)r0 * DM + h * 256) + voffK;
#pragma unroll
              for (int ks = 0; ks < 4; ++ks) Kf[ks] = *(const bf16x8*)(kb + ks * 64); }
            asm volatile("s_waitcnt vmcnt(0)" ::: "memory");
            __syncthreads();
            { const char* kb = (const char*)(Kg + (size_t)r0 * DM + h * 256) + voffK;
#pragma unroll
              for (int ks = 4; ks < 8; ++ks) Kf[ks] = *(const bf16x8*)(kb + ks * 64); }
            f32x4 Z[8], PT[8];
#pragma unroll
            for (int i8 = 0; i8 < 8; ++i8) { Z[i8] = (f32x4){0.f, 0.f, 0.f, 0.f}; PT[i8] = (f32x4){0.f, 0.f, 0.f, 0.f}; }
#define QFRAG(ks, i8) (*(const LAS bf16x8*)(lds + QOFF + xb[(ks) & 3] + fr * 512 + (i8) * 8192 + ((ks) >> 2) * 256))
            { bf16x8 qa[4], qb[4];
#pragma unroll
              for (int j = 0; j < 4; ++j) qa[j] = QFRAG(0, j);
#pragma unroll
              for (int ks = 0; ks < 8; ++ks) { u32x4 t; t.x = cvt_pk_bf16(S[2 * ks][0], S[2 * ks][1]); t.y = cvt_pk_bf16(S[2 * ks][2], S[2 * ks][3]); t.z = cvt_pk_bf16(S[2 * ks + 1][0], S[2 * ks + 1][1]); t.w = cvt_pk_bf16(S[2 * ks + 1][2], S[2 * ks + 1][3]);
                  const bf16x8 Sb = __builtin_bit_cast(bf16x8, t);
#pragma unroll
                  for (int j = 0; j < 4; ++j) qb[j] = QFRAG(ks, 4 + j);
                  __builtin_amdgcn_sched_barrier(0);
#pragma unroll
                  for (int j = 0; j < 4; ++j) { Z[j] = __builtin_amdgcn_mfma_f32_16x16x32_bf16(qa[j], Sb, Z[j], 0, 0, 0); PT[j] = __builtin_amdgcn_mfma_f32_16x16x32_bf16(Kf[ks], qa[j], PT[j], 0, 0, 0); }
                  __builtin_amdgcn_sched_barrier(0);
                  if (ks < 7) {
#pragma unroll
                      for (int j = 0; j < 4; ++j) qa[j] = QFRAG(ks + 1, j); }
                  __builtin_amdgcn_sched_barrier(0);
#pragma unroll
                  for (int j = 0; j < 4; ++j) { Z[4 + j] = __builtin_amdgcn_mfma_f32_16x16x32_bf16(qb[j], Sb, Z[4 + j], 0, 0, 0); PT[4 + j] = __builtin_amdgcn_mfma_f32_16x16x32_bf16(Kf[ks], qb[j], PT[4 + j], 0, 0, 0); }
                  __builtin_amdgcn_sched_barrier(0); } }
#undef QFRAG
            { const char* vb = (const char*)(VTg + (size_t)(h * 512 + es * 128) * TT + r0) + voffV;
#pragma unroll
              for (int ks = 0; ks < 4; ++ks) Vf[ks] = *(const bf16x8*)(vb + ks * 64); }
            float zb2_ = zb2, zl_ = zl, kb2_ = kb2; int pbase_ = pbase;
            asm volatile("" : "+v"(zb2_), "+v"(zl_), "+v"(kb2_), "+v"(pbase_));
            { f32x4 zf, pf; const float z16 = __builtin_amdgcn_exp2f(16.f * zl_);
#pragma unroll
              for (int r = 0; r < 4; ++r) { zf[r] = __builtin_amdgcn_exp2f(zb2_ + (float)r * zl_); pf[r] = __builtin_amdgcn_exp2f((float)(pbase_ + (dir ? r : -r)) * lg2); }
#pragma unroll
              for (int i8 = 0; i8 < 8; ++i8) {
#pragma unroll
                  for (int r = 0; r < 4; ++r) { Z[i8][r] *= zf[r];
                      const int df = pbase_ + (dir ? -(i8 * 16 - r) : (i8 * 16 - r)); PT[i8][r] = df >= 0 ? PT[i8][r] * pf[r] : 0.f; }
                  zf *= z16; pf *= z16; } }
            __syncthreads();
#pragma unroll
            for (int i8 = 0; i8 < 8; ++i8) { const int i = i8 * 16 + fr; u32x2 t; t.x = cvt_pk_bf16(PT[i8][0], PT[i8][1]); t.y = cvt_pk_bf16(PT[i8][2], PT[i8][3]);
                *(LAS u32x2*)(lds + QOFF + i * 256 + (((2 * w + (fq >> 1)) ^ fr)) * 16 + (fq & 1) * 8) = t; }
            __syncthreads();
#define PFRAG(i8, ks) (*(const LAS bf16x8*)(lds + QOFF + xb[ks] + fr * 256 + (i8) * 4096))
            { bf16x8 pa[4], pb[4];
#pragma unroll
              for (int ks = 0; ks < 4; ++ks) pa[ks] = PFRAG(0, ks);
#pragma unroll
              for (int i8 = 0; i8 < 8; i8 += 2) {
#pragma unroll
                  for (int ks = 0; ks < 4; ++ks) pb[ks] = PFRAG(i8 + 1, ks);
                  __builtin_amdgcn_sched_barrier(0);
#pragma unroll
                  for (int ks = 0; ks < 4; ++ks) Z[i8] = __builtin_amdgcn_mfma_f32_16x16x32_bf16(pa[ks], Vf[ks], Z[i8], 0, 0, 0);
                  __builtin_amdgcn_sched_barrier(0);
                  if (i8 < 6) {
#pragma unroll
                      for (int ks = 0; ks < 4; ++ks) pa[ks] = PFRAG(i8 + 2, ks); }
                  __builtin_amdgcn_sched_barrier(0);
#pragma unroll
                  for (int ks = 0; ks < 4; ++ks) Z[i8 + 1] = __builtin_amdgcn_mfma_f32_16x16x32_bf16(pb[ks], Vf[ks], Z[i8 + 1], 0, 0, 0);
                  __builtin_amdgcn_sched_barrier(0); } }
#undef PFRAG
#pragma unroll
            for (int i8 = 0; i8 < 8; ++i8)
#pragma unroll
                for (int r = 0; r < 4; ++r) *(bf16_t*)((char*)(Yg + (size_t)(r0 + i8 * 16 + r) * VW + h * 512 + es * 128) + voffY) = bf16_1(Z[i8][r]);
            bf16x8 Vs[4];
            float kf8[8], kstep[4];
#pragma unroll
            for (int e = 0; e < 8; ++e) kf8[e] = __builtin_amdgcn_exp2f(kb2_ - (float)e * zl_);
            { const float k32 = __builtin_amdgcn_exp2f(-32.f * zl_); kstep[0] = 1.f; kstep[1] = k32; kstep[2] = k32 * k32; kstep[3] = kstep[2] * k32; }
#pragma unroll
            for (int ks = 0; ks < 4; ++ks) { const u32x4 t = __builtin_bit_cast(u32x4, Vf[ks]); float f[8]; f[0] = bf_lo(t.x); f[1] = bf_hi(t.x); f[2] = bf_lo(t.y); f[3] = bf_hi(t.y); f[4] = bf_lo(t.z); f[5] = bf_hi(t.z); f[6] = bf_lo(t.w); f[7] = bf_hi(t.w);
#pragma unroll
                for (int e = 0; e < 8; ++e) f[e] *= kf8[e] * kstep[ks];
                u32x4 o; o.x = cvt_pk_bf16(f[0], f[1]); o.y = cvt_pk_bf16(f[2], f[3]); o.z = cvt_pk_bf16(f[4], f[5]); o.w = cvt_pk_bf16(f[6], f[7]); Vs[ks] = __builtin_bit_cast(bf16x8, o); }
#define TFRAG(D, ks) (*(const LAS bf16x8*)(lds + KTOFF + xb[ks] + (8 * (fr >> 2) + (fr & 3)) * 256 + ((D) >> 1) * 8192 + ((D) & 1) * 1024))
            { bf16x8 ta[4], tb[4];
#pragma unroll
              for (int ks = 0; ks < 4; ++ks) ta[ks] = TFRAG(0, ks);
#pragma unroll
              for (int D = 0; D < 16; D += 2) { S[D] *= sdec; S[D + 1] *= sdec;
#pragma unroll
                  for (int ks = 0; ks < 4; ++ks) tb[ks] = TFRAG(D + 1, ks);
                  __builtin_amdgcn_sched_barrier(0);
#pragma unroll
                  for (int ks = 0; ks < 4; ++ks) S[D] = __builtin_amdgcn_mfma_f32_16x16x32_bf16(ta[ks], Vs[ks], S[D], 0, 0, 0);
                  __builtin_amdgcn_sched_barrier(0);
                  if (D < 14) {
#pragma unroll
                      for (int ks = 0; ks < 4; ++ks) ta[ks] = TFRAG(D + 2, ks); }
                  __builtin_amdgcn_sched_barrier(0);
#pragma unroll
                  for (int ks = 0; ks < 4; ++ks) S[D + 1] = __builtin_amdgcn_mfma_f32_16x16x32_bf16(tb[ks], Vs[ks], S[D + 1], 0, 0, 0);
                  __builtin_amdgcn_sched_barrier(0); } }
#undef TFRAG
            __syncthreads();
        }
        if (!lat) { float* so = p.out + (size_t)TT * DM + ((((size_t)bb * 2 + l) * 2 + dir) * 4 + h) * 256 * 512 + es * 128;
#pragma unroll
            for (int D = 0; D < 16; ++D)
#pragma unroll
                for (int r = 0; r < 4; ++r) __builtin_nontemporal_store(S[D][r], (float*)((char*)(so + ((D >> 1) * 32 + 4 * (D & 1) + r) * 512) + voffS)); }
    }
}

__device__ void comb_phase(const Params& p) {
    const int tid = tid_opaque(), lane = tid & 63, gw = blockIdx.x * 8 + (tid >> 6), nw = gridDim.x * 8;
    const bf16_t* yf = (const bf16_t*)(p.ws + WS_YF); const bf16_t* yb = (const bf16_t*)(p.ws + WS_YB); const bf16_t* rg = (const bf16_t*)(p.ws + WS_RG); bf16_t* ar = (bf16_t*)(p.ws + WS_Q);
    for (int tok = gw; tok < TT; tok += nw) {
        u32x4 a[4], b[4], g[4];
#pragma unroll
        for (int h = 0; h < 4; ++h) { const size_t off = (size_t)tok * VW + h * 512 + lane * 8; a[h] = __builtin_nontemporal_load((const u32x4*)(yf + off)); b[h] = __builtin_nontemporal_load((const u32x4*)(yb + off)); g[h] = __builtin_nontemporal_load((const u32x4*)(rg + off)); }
#pragma unroll
        for (int h = 0; h < 4; ++h) {
            float y[8];
#pragma unroll
            for (int e = 0; e < 4; ++e) { y[2 * e] = bf_lo(a[h][e]) + bf_lo(b[h][e]); y[2 * e + 1] = bf_hi(a[h][e]) + bf_hi(b[h][e]); }
            float s = 0.f;
#pragma unroll
            for (int e = 0; e < 8; ++e) s += y[e];
            const float mu = wave_sum(s) * (1.f / 512.f); float v = 0.f;
#pragma unroll
            for (int e = 0; e < 8; ++e) { y[e] -= mu; v += y[e] * y[e]; }
            const float rstd = rsqrtf(wave_sum(v) * (1.f / 512.f) + EPSV);
            u32x4 o;
#pragma unroll
            for (int e = 0; e < 4; ++e) o[e] = cvt_pk_bf16(y[2 * e] * rstd * bf_lo(g[h][e]), y[2 * e + 1] * rstd * bf_hi(g[h][e]));
            *(u32x4*)(ar + (size_t)tok * VW + h * 512 + lane * 8) = o;
        }
    }
}


#define XB_TMO      128
#define XB_XCNT(j)  (256  + 64 * (j))
#define XB_XSUB(j)  (1280 + 64 * (j))
#define XB_XGEN(j)  (2304 + 64 * (j))
#define XB_TOP      3328
#define XB_TOPGEN   3392
#define XCD_BAR_WORDS 3456
#define XB_SPIN_CAP (1u << 18)
__device__ __forceinline__ unsigned xb_ld(unsigned* p)              { return __hip_atomic_load(p, __ATOMIC_RELAXED, __HIP_MEMORY_SCOPE_AGENT); }
__device__ __forceinline__ unsigned xb_add(unsigned* p, unsigned v) { return __hip_atomic_fetch_add(p, v, __ATOMIC_RELAXED, __HIP_MEMORY_SCOPE_AGENT); }
__device__ __forceinline__ unsigned xb_xcc_id() { return (unsigned)__builtin_amdgcn_s_getreg((3 << 11) | 20) & 0xFu; }
#define XB_SPIN(cond, bar) do { unsigned _sp = 0; while (cond) { __builtin_amdgcn_s_sleep(1); \
    if ((++_sp & 255u) == 0u) { if (xb_ld(&(bar)[XB_TMO])) break; if (_sp > XB_SPIN_CAP) { atomicAdd(&(bar)[XB_TMO], 1u); break; } } } } while (0)
struct XcdBarrier { unsigned* bar; unsigned x; volatile LAS unsigned* st; };
__device__ __forceinline__ XcdBarrier xcd_barrier_post(unsigned* bar, volatile LAS unsigned* st) {
    XcdBarrier b; b.bar = bar; b.x = xb_xcc_id(); b.st = st;
    if (threadIdx.x == 0) (void)xb_add(&bar[XB_XCNT(b.x)], 1u);
    return b;
}
__device__ __forceinline__ void xcd_barrier_complete(unsigned* bar, unsigned x, unsigned& nloc, unsigned& nx) {
    const unsigned G = gridDim.x * gridDim.y * gridDim.z;
    unsigned sum, cnt, mine, sp = 0u;
    for (;;) {
        sum = 0u; cnt = 0u; mine = 0u;
#pragma unroll
        for (unsigned j = 0; j < 16; ++j) { const unsigned c = xb_ld(&bar[XB_XCNT(j)]); sum += c; cnt += (c > 0u) ? 1u : 0u; mine = (j == x) ? c : mine; }
        if (sum == G) break;
        __builtin_amdgcn_s_sleep(1);
        if ((++sp & 255u) == 0u) { if (xb_ld(&bar[XB_TMO])) break; if (sp > XB_SPIN_CAP) { atomicAdd(&bar[XB_TMO], 1u); break; } }
    }
    nloc = mine > 0u ? mine : 1u; nx = cnt > 0u ? cnt : 1u;
}
__device__ __forceinline__ void xcd_barrier(const XcdBarrier& b) {
    asm volatile("s_waitcnt vmcnt(0)" ::: "memory");
    __syncthreads();
    if (threadIdx.x == 0) {
        unsigned* bar = b.bar;
        __builtin_amdgcn_s_waitcnt(0);
        unsigned nloc = b.st[0], nx = b.st[1];
        if (nloc == 0u) { xcd_barrier_complete(bar, b.x, nloc, nx); b.st[0] = nloc; b.st[1] = nx; }
        const unsigned old = xb_add(&bar[XB_XSUB(b.x)], 1u);
        const unsigned gen = old / nloc;
        if (old + 1u == (gen + 1u) * nloc) {
            __builtin_amdgcn_fence(__ATOMIC_RELEASE, "agent");
            asm volatile("s_waitcnt vmcnt(0)" ::: "memory");
            const unsigned og = xb_add(&bar[XB_TOP], 1u);
            const unsigned tg = og / nx;
            if (og + 1u == (tg + 1u) * nx) xb_add(&bar[XB_TOPGEN], 1u);
            else XB_SPIN(xb_ld(&bar[XB_TOPGEN]) == tg, bar);
            __builtin_amdgcn_fence(__ATOMIC_ACQUIRE, "agent");
            xb_add(&bar[XB_XGEN(b.x)], 1u);
            asm volatile("s_waitcnt vmcnt(0)" ::: "memory");
        } else {
            XB_SPIN(xb_ld(&bar[XB_XGEN(b.x)]) == gen, bar);
            __builtin_amdgcn_fence(__ATOMIC_ACQUIRE, "agent");
            asm volatile("s_waitcnt vmcnt(0)" ::: "memory");
        }
    }
    __syncthreads();
}

__global__ void __launch_bounds__(NTHR) mega(Params p) {
    __shared__ __attribute__((aligned(16))) unsigned char smem[131072];
    cg::grid_group grid = cg::this_grid();
    LAS unsigned char* lds = (LAS unsigned char*)smem;
    unsigned char* ws = p.ws;
    float* xbuf = p.out;
    const float* modb = (const float*)(ws + WS_MOD);
    pg8::StaticOrder so;
    __shared__ __attribute__((aligned(16))) unsigned xb_st[4];
    if (threadIdx.x < 4) xb_st[threadIdx.x] = 0u;
    __syncthreads();
    if (blockIdx.x == 1) { const int t = tid_opaque(); for (int i = t; i < XCD_BAR_WORDS; i += NTHR) ((unsigned*)(ws + WS_BAR))[i] = 0u; }
    phase0(p, smem);
    grid.sync();
    const XcdBarrier xbar = xcd_barrier_post((unsigned*)(ws + WS_BAR), (volatile LAS unsigned*)xb_st);
    for (int l = 0; l < 2; ++l) {
        const unsigned char* wl = ws + WS_W + (size_t)l * WL_SZ;
        const float* modl = modb + (size_t)l * 9 * 6144;
        const float* xa = l == 0 ? p.in[0] : xbuf; const float* xb = l == 0 ? p.in[1] : xbuf + (size_t)TC * DM;
        norm_mod_phase(xa, xb, (bf16_t*)(ws + WS_R1), p.in[5] + l * DM, modl, 0);
        xcd_barrier(xbar);
        { pg8::Gemm g{(const bf16_t*)(ws + WS_R1), (const bf16_t*)(wl + WL_IN), TT, PW, DM, nullptr, nullptr}; so.init(TT, PW, gridDim.x, blockIdx.x);
          EpiG1 e{(bf16_t*)(ws + WS_R2), (bf16_t*)(ws + WS_Q), (bf16_t*)(ws + WS_K), (bf16_t*)(ws + WS_KT), (bf16_t*)(ws + WS_VT), (bf16_t*)(ws + WS_RG), (bf16_t*)(ws + WS_GATE), (const float*)(ws + WS_ROPE), (const float*)(ws + WS_ROPE) + 4096};
          pg8::gemm_phase(lds, g, so, e); }
        xcd_barrier(xbar);
        ret_phase(p, l, smem);
        conv_phase(p, l, smem);
        xcd_barrier(xbar);
        { pg8::Gemm g{(const bf16_t*)(ws + WS_R1), (const bf16_t*)(wl + WL_CONV), TT, DM, DM, nullptr, nullptr}; so.init(TT, DM, gridDim.x, blockIdx.x);
          EpiE1 e{(bf16_t*)(ws + WS_KT), (const bf16_t*)(ws + WS_GATE)};
          comb_phase(p);
          __syncthreads();
          pg8::gemm_phase(lds, g, so, e); }
        xcd_barrier(xbar);
        { pg8::Gemm g{(const bf16_t*)(ws + WS_Q), (const bf16_t*)(wl + WL_RET), TT, DM, VW, nullptr, nullptr}; so.init(TT, DM, gridDim.x, blockIdx.x);
          EpiE2 e{(const bf16_t*)(ws + WS_KT), (const bf16_t*)(ws + WS_GATE), (bf16_t*)(ws + WS_R2)};
          pg8::gemm_phase(lds, g, so, e); }
        xcd_barrier(xbar);
        { pg8::Gemm g{(const bf16_t*)(ws + WS_R2), (const bf16_t*)(wl + WL_OUT), TT, DM, DM, nullptr, nullptr}; so.init(TT, DM, gridDim.x, blockIdx.x);
          EpiResT<false> e{xa, xb, xbuf, modl + 2 * 1024};
          pg8::gemm_phase(lds, g, so, e); }
        xcd_barrier(xbar);
        norm_mod_phase(xbuf, xbuf + (size_t)TC * DM, (bf16_t*)(ws + WS_R1), p.in[6] + l * DM, modl, 3);
        xcd_barrier(xbar);
        { pg8::Gemm g{(const bf16_t*)(ws + WS_R1), (const bf16_t*)(wl + WL_M1), TT, MLPW, DM, nullptr, nullptr}; so.init(TT, MLPW, gridDim.x, blockIdx.x);
          EpiF1 e{(bf16_t*)(ws + WS_RG)};
          pg8::gemm_phase(lds, g, so, e); }
        xcd_barrier(xbar);
        { pg8::Gemm g{(const bf16_t*)(ws + WS_RG), (const bf16_t*)(wl + WL_M2), TT, DM, MLPW, (unsigned long long*)(ws + WS_DUMP), (unsigned*)(ws + WS_CNT)}; so.init(TT, DM, gridDim.x, blockIdx.x, true);
          EpiResT<true> e{xbuf, xbuf + (size_t)TC * DM, xbuf, modl + 5 * 1024};
          pg8::gemm_phase(lds, g, so, e); }
        xcd_barrier(xbar);
    }
    final_norm_phase(xbuf, p.in[19]);
}

extern "C" void kernel_launch(void* const* d_in, const int* in_sizes, int n_in, void* d_out, int out_size, void* d_ws, size_t ws_size, hipStream_t stream) {
    static int grid_blocks = 0;
    if (!grid_blocks) {
        int dev = 0, cus = 0, per_cu = 0;
        (void)hipGetDevice(&dev);
        (void)hipDeviceGetAttribute(&cus, hipDeviceAttributeMultiprocessorCount, dev);
        (void)hipOccupancyMaxActiveBlocksPerMultiprocessor(&per_cu, mega, NTHR, 0);
        if (per_cu < 1) per_cu = 1;
        grid_blocks = cus;
    }
    if (n_in != 20 || ws_size < WS_END) return;
    Params p{};
    for (int i = 0; i < 20; ++i) p.in[i] = (const float*)d_in[i];
    p.out = (float*)d_out; p.ws = (unsigned char*)d_ws;
    void* args[] = {&p};
    (void)hipLaunchCooperativeKernel((void*)mega, dim3(grid_blocks), dim3(NTHR), args, 0, stream);
}
```

```cpp
#include <hip/hip_runtime.h>
#include <hip/hip_cooperative_groups.h>
namespace cg = cooperative_groups;

#define LAS __attribute__((address_space(3)))
typedef unsigned short bf16_t;
typedef short bf16x8 __attribute__((ext_vector_type(8)));
typedef float f32x4 __attribute__((ext_vector_type(4)));
typedef float f32x2 __attribute__((ext_vector_type(2)));
typedef unsigned u32x2 __attribute__((ext_vector_type(2)));
typedef unsigned u32x4 __attribute__((ext_vector_type(4)));

constexpr int DM = 1024, TC = 4096, TL = 16384, TT = 20480, PW = 10240, MLPW = 4096, VW = 2048;
constexpr int NTHR = 512;
constexpr float EPSV = 1e-6f;
constexpr size_t MiB = (size_t)1 << 20;
constexpr size_t WS_W = 0;
constexpr size_t WL_IN = 0, WL_CONV = 20 * MiB, WL_RET = 22 * MiB, WL_OUT = 26 * MiB, WL_M1 = 28 * MiB, WL_M2 = 36 * MiB, WL_SZ = 44 * MiB;
constexpr size_t WS_MOD = 88 * MiB;
constexpr size_t WS_ROPE = 88 * MiB + 512 * 1024;
constexpr size_t WS_R1 = 90 * MiB;
constexpr size_t WS_R2 = 130 * MiB;
constexpr size_t WS_Q = 170 * MiB;
constexpr size_t WS_K = 210 * MiB;
constexpr size_t WS_KT = 250 * MiB;
constexpr size_t WS_VT = 290 * MiB;
constexpr size_t WS_RG = 370 * MiB;
constexpr size_t WS_GATE = 450 * MiB;
constexpr size_t WS_YF = 530 * MiB;
constexpr size_t WS_YB = 610 * MiB;
constexpr size_t WS_BAR = 88 * MiB + 448 * 1024;
constexpr size_t WS_DUMP = 690 * MiB;
constexpr size_t WS_CNT = 88 * MiB + 480 * 1024;
constexpr size_t WS_END = 754 * MiB;

struct Params { const float* in[20]; float* out; unsigned char* ws; };

typedef __bf16 bf16x2_t __attribute__((ext_vector_type(2)));
__device__ __forceinline__ unsigned cvt_pk_bf16(float lo, float hi) { const f32x2 f = {lo, hi}; const bf16x2_t v = __builtin_convertvector(f, bf16x2_t); return __builtin_bit_cast(unsigned, v); }
__device__ __forceinline__ float bf_lo(unsigned u) { return __uint_as_float(u << 16); }
__device__ __forceinline__ float bf_hi(unsigned u) { return __uint_as_float(u & 0xffff0000u); }
__device__ __forceinline__ float sigmoidf_(float x) { return __builtin_amdgcn_rcpf(1.f + __expf(-x)); }
__device__ __forceinline__ float siluf_(float x) { return x * sigmoidf_(x); }
__device__ __forceinline__ float wave_sum(float v) {
#pragma unroll
    for (int o = 32; o > 0; o >>= 1) v += __shfl_xor(v, o, 64);
    return v;
}
__device__ __forceinline__ int tid_opaque() { int t = threadIdx.x; asm volatile("" : "+v"(t)); return t; }
__device__ __forceinline__ int row_group(int row) { return row < TC ? 0 : 1 + ((row - TC) >> 11); }

namespace pg8 {
constexpr int BM = 256, BK = 64, HALF = 128, HTB = HALF * BK * 2, NXCD = 8, WGM = 8;
__device__ __forceinline__ int lds_byte(int r, int c) { const int st = (r >> 4) * 2 + (c >> 5), rr = r & 15, cc = c & 31, ob = rr * 64 + cc * 2; return st * 1024 + (ob ^ (((ob >> 9) & 1) << 5)); }
__device__ __forceinline__ void stage_rc(int b, int& R, int& C) { const int st = b / 1024, sb = b % 1024, swz = sb ^ (((sb >> 9) & 1) << 5); R = (st >> 1) * 16 + swz / 64; C = (st & 1) * 32 + (swz % 64) / 2; }
__device__ __forceinline__ int perm32(int rho) { const int n = rho >> 4, i = rho & 15; return 8 * (i >> 2) + 4 * n + (i & 3); }
struct Unit { int pm, pn, kq, ti; };
struct Gemm { const bf16_t* A; const bf16_t* Bt; int M, N, K; unsigned long long* dump; unsigned* cnt; };
struct StaticOrder {
    int nM, nN, nwg, G, c; bool split;
    __device__ void init(int M, int N, int G_, int c_, bool allow_split = false) { nM = M / BM; nN = N / BM; nwg = nM * nN; G = G_; c = c_; split = allow_split && nwg == 320 && G == 256; }
    __device__ bool next(int i, Unit& u) const {
        if (split) {
            const int x = c & 7, j = c >> 3;
            if (i == 0) { u.pm = x * 8 + (j & 7); u.pn = j >> 3; u.kq = -1; u.ti = 0; return true; }
            if (i == 1) { u.kq = x & 3; u.pm = 64 + (x >> 2) * 8 + (j >> 2); u.pn = j & 3; u.ti = (u.pm - 64) * 4 + u.pn; return true; }
            return false;
        }
        const long L = (long)i * G + c;
        if (L >= nwg) return false;
        int wgid = (int)L; { const int q = nwg / NXCD, r = nwg % NXCD, xcd = wgid % NXCD, off = wgid / NXCD; wgid = (xcd < r ? xcd * (q + 1) : r * (q + 1) + (xcd - r) * q) + off; }
        const int nig = WGM * nN, gid = wgid / nig, fm = gid * WGM, gsz = (nM - fm) < WGM ? (nM - fm) : WGM;
        u.pm = fm + ((wgid % nig) % gsz); u.pn = (wgid % nig) / gsz; u.kq = -1; u.ti = 0; return true;
    }
};

template <class Epi>
__device__ __forceinline__ void gemm_phase(LAS unsigned char* lds, const Gemm g, const StaticOrder& S, const Epi& E) {
    const int tid = tid_opaque(), wid = __builtin_amdgcn_readfirstlane(tid >> 6), lane = tid & 63, wr = wid >> 2, wc = wid & 3, fr = lane & 15, fq = lane >> 4;
    const int K = g.K;
    unsigned voffA[2], voffB[2];
#pragma unroll
    for (int i = 0; i < 2; ++i) { int R, C; stage_rc(tid * 16 + i * 8192, R, C); const int Rb = (R & ~31) + perm32(R & 31); voffA[i] = (unsigned)(R * K + C) * 2u; voffB[i] = (unsigned)(Rb * K + C) * 2u; }
    const size_t kstep = (size_t)(BK * 2);
    const size_t hstep = (size_t)HALF * K * 2;
    const size_t tstep = 2 * hstep;
    const unsigned ldsw = (unsigned)wid * 1024u;
    const int aoff = lds_byte(wr * 64 + fr, fq * 8), boff = lds_byte(wc * 32 + fr, fq * 8);
#define PG8_SA(b, h) (((b) * 2 + (h)) * HTB)
#define PG8_SB(b, h) ((4 + (b) * 2 + (h)) * HTB)
#define PG8_STAGE(bufoff, gbase, voff) do { _Pragma("unroll") for (int _i = 0; _i < 2; ++_i) \
        __builtin_amdgcn_global_load_lds((const unsigned*)((const char*)(gbase) + (voff)[_i]), (LAS unsigned*)(lds + (bufoff) + ldsw + _i * 8192), 16, 0, 0); } while (0)
#define PG8_LDA(dst, b, h) do { _Pragma("unroll") for (int m = 0; m < 4; ++m) _Pragma("unroll") for (int k = 0; k < 2; ++k) dst[m][k] = *(const LAS bf16x8*)(lds + PG8_SA(b, h) + aoff + m * 2048 + k * 1024); } while (0)
#define PG8_LDB(dst, b, h) do { _Pragma("unroll") for (int n = 0; n < 2; ++n) _Pragma("unroll") for (int k = 0; k < 2; ++k) dst[n][k] = *(const LAS bf16x8*)(lds + PG8_SB(b, h) + boff + n * 2048 + k * 1024); } while (0)
#define PG8_MMA(ai, bj, At, Bt) do { __builtin_amdgcn_s_setprio(1); _Pragma("unroll") for (int m = 0; m < 4; ++m) _Pragma("unroll") for (int n = 0; n < 2; ++n) _Pragma("unroll") for (int k = 0; k < 2; ++k) \
        acc[ai][bj][m][n] = __builtin_amdgcn_mfma_f32_16x16x32_bf16(Bt[n][k], At[m][k], acc[ai][bj][m][n], 0, 0, 0); __builtin_amdgcn_s_setprio(0); } while (0)
#define PG8_WAIT_V(n) asm volatile("s_waitcnt vmcnt(" #n ")" ::: "memory")
#define PG8_WAIT_L(n) asm volatile("s_waitcnt lgkmcnt(" #n ")" ::: "memory")
#define PG8_BAR __builtin_amdgcn_s_barrier()
#define PG8_SCHED __builtin_amdgcn_sched_barrier(0)
    Unit cur, nxt; int ui = 0;
    if (!S.next(0, cur)) return;
    f32x4 acc[2][2][4][2];
#pragma unroll
    for (int a = 0; a < 2; ++a)
#pragma unroll
        for (int b = 0; b < 2; ++b)
#pragma unroll
            for (int m = 0; m < 4; ++m)
#pragma unroll
                for (int n = 0; n < 2; ++n) acc[a][b][m][n] = (f32x4){0.f, 0.f, 0.f, 0.f};
    bf16x8 At[4][2], B0[2][2], B1[2][2];
    const char* cA = E.swapped(cur) ? (const char*)g.Bt + (size_t)cur.pn * tstep : (const char*)g.A + (size_t)cur.pm * tstep;
    const char* cB = E.swapped(cur) ? (const char*)g.A + (size_t)cur.pm * tstep : (const char*)g.Bt + (size_t)cur.pn * tstep;
    const size_t qstep = (size_t)(K >> 2) * 2;
    if (cur.kq >= 0) { cA += cur.kq * qstep; cB += cur.kq * qstep; }
    PG8_STAGE(PG8_SB(0, 0), cB, voffB); PG8_STAGE(PG8_SA(0, 0), cA, voffA); PG8_STAGE(PG8_SB(0, 1), cB + hstep, voffB); PG8_STAGE(PG8_SA(0, 1), cA + hstep, voffA);
    if (wr == 1) PG8_BAR;
    PG8_WAIT_V(4); PG8_BAR;
    PG8_STAGE(PG8_SB(1, 0), cB + kstep, voffB); PG8_STAGE(PG8_SA(1, 0), cA + kstep, voffA); PG8_STAGE(PG8_SB(1, 1), cB + hstep + kstep, voffB);
    PG8_WAIT_V(6); PG8_BAR;
    for (;;) {
        const bool has_next = S.next(ui + 1, nxt);
        const bool nsw = has_next && E.swapped(nxt);
        const char* nA = has_next ? (nsw ? (const char*)g.Bt + (size_t)nxt.pn * tstep : (const char*)g.A + (size_t)nxt.pm * tstep) : cA;
        const char* nB = has_next ? (nsw ? (const char*)g.A + (size_t)nxt.pm * tstep : (const char*)g.Bt + (size_t)nxt.pn * tstep) : cB;
        if (has_next && nxt.kq >= 0) { nA += nxt.kq * qstep; nB += nxt.kq * qstep; }
        const int nt = (cur.kq >= 0 ? (K >> 2) : K) / BK;
        for (int t = 0; t < nt; t += 2) {
            const bool last = (t == nt - 2);
            const char* a1 = cA + (size_t)(t + 1) * kstep;
            const char* a2 = last ? nA : cA + (size_t)(t + 2) * kstep; const char* b2 = last ? nB : cB + (size_t)(t + 2) * kstep;
            const char* a3 = a2 + kstep; const char* b3 = b2 + kstep;
            PG8_LDB(B0, 0, 0); PG8_SCHED; PG8_LDA(At, 0, 0); PG8_STAGE(PG8_SA(1, 1), a1 + hstep, voffA);
            PG8_WAIT_L(8); PG8_BAR; PG8_WAIT_L(0); PG8_MMA(0, 0, At, B0); PG8_BAR; PG8_SCHED;
            PG8_LDB(B1, 0, 1); PG8_STAGE(PG8_SB(0, 0), b2, voffB);
            PG8_BAR; PG8_WAIT_L(0); PG8_MMA(0, 1, At, B1); PG8_BAR;
            PG8_LDA(At, 0, 1); PG8_STAGE(PG8_SA(0, 0), a2, voffA);
            PG8_BAR; PG8_WAIT_L(0); PG8_MMA(1, 0, At, B0); PG8_BAR; PG8_SCHED;
            PG8_STAGE(PG8_SB(0, 1), b2 + hstep, voffB);
            PG8_WAIT_V(6); PG8_BAR; PG8_MMA(1, 1, At, B1); PG8_BAR;
            PG8_LDB(B0, 1, 0); PG8_SCHED; PG8_LDA(At, 1, 0); PG8_STAGE(PG8_SA(0, 1), a2 + hstep, voffA);
            PG8_WAIT_L(8); PG8_BAR; PG8_WAIT_L(0); PG8_MMA(0, 0, At, B0); PG8_BAR; PG8_SCHED;
            PG8_LDB(B1, 1, 1); PG8_STAGE(PG8_SB(1, 0), b3, voffB);
            PG8_BAR; PG8_WAIT_L(0); PG8_MMA(0, 1, At, B1); PG8_BAR;
            PG8_LDA(At, 1, 1); PG8_STAGE(PG8_SA(1, 0), a3, voffA);
            PG8_BAR; PG8_WAIT_L(0); PG8_MMA(1, 0, At, B0); PG8_BAR; PG8_SCHED;
            PG8_STAGE(PG8_SB(1, 1), b3 + hstep, voffB);
            PG8_WAIT_V(6); PG8_BAR; PG8_MMA(1, 1, At, B1); PG8_BAR;
        }
        if (cur.kq < 0) E(acc, cur, wr, wc, fr, fq);
        if (!has_next) break;
#pragma unroll
        for (int a = 0; a < 2; ++a)
#pragma unroll
            for (int b = 0; b < 2; ++b)
#pragma unroll
                for (int m = 0; m < 4; ++m)
#pragma unroll
                    for (int n = 0; n < 2; ++n) acc[a][b][m][n] = (f32x4){0.f, 0.f, 0.f, 0.f};
        cur = nxt; cA = nA; cB = nB; ++ui;
    }
    PG8_WAIT_V(0);
    if (wr == 0) PG8_BAR;
    PG8_BAR;
    if constexpr (Epi::SPLIT) {
    if (cur.kq >= 0) {
        const __amdgpu_buffer_rsrc_t drs = __builtin_amdgcn_make_buffer_rsrc((void*)(g.dump + (size_t)cur.ti * 4 * (64 * 512)), 0, 4 * 64 * 512 * 8, 0x00020000);
        unsigned lo = (unsigned)tid * 16u;
        { const unsigned qo = (unsigned)cur.kq * (64 * 512 * 8);
#pragma unroll
          for (int a = 0; a < 2; ++a)
#pragma unroll
              for (int b = 0; b < 2; ++b)
#pragma unroll
                  for (int m = 0; m < 4; ++m)
#pragma unroll
                      for (int n = 0; n < 2; ++n) { asm volatile("" : "+v"(lo));
                          __builtin_amdgcn_raw_buffer_store_b128(__builtin_bit_cast(u32x4, acc[a][b][m][n]), drs, qo + (unsigned)((((a * 2 + b) * 4 + m) * 2 + n) * (512 * 16)) + lo, 0,   16); } }
        asm volatile("s_waitcnt vmcnt(0)" ::: "memory");
        __syncthreads();
        if (tid == 0) { __hip_atomic_fetch_add(g.cnt + 2 * cur.ti, 1u, __ATOMIC_RELAXED, __HIP_MEMORY_SCOPE_AGENT);
            unsigned spins = 0; while (__hip_atomic_load(g.cnt + 2 * cur.ti, __ATOMIC_RELAXED, __HIP_MEMORY_SCOPE_AGENT) < 4u) { __builtin_amdgcn_s_sleep(2); if (++spins > (1u << 22)) break; } }
        __syncthreads();
#pragma unroll
        for (int a = 0; a < 2; ++a)
#pragma unroll
            for (int m = 0; m < 4; ++m) { if (((a * 4 + m) >> 1) != cur.kq) continue;
                f32x4 v[2][2];
#pragma unroll
                for (int b = 0; b < 2; ++b)
#pragma unroll
                    for (int n = 0; n < 2; ++n) { asm volatile("" : "+v"(lo)); const unsigned o = (unsigned)((((a * 2 + b) * 4 + m) * 2 + n) * (512 * 16)) + lo;
                        const f32x4 p0 = __builtin_bit_cast(f32x4, __builtin_amdgcn_raw_buffer_load_b128(drs, o, 0, 16)), p1 = __builtin_bit_cast(f32x4, __builtin_amdgcn_raw_buffer_load_b128(drs, o + 64 * 512 * 8, 0, 16)),
                                    p2 = __builtin_bit_cast(f32x4, __builtin_amdgcn_raw_buffer_load_b128(drs, o + 2 * 64 * 512 * 8, 0, 16)), p3 = __builtin_bit_cast(f32x4, __builtin_amdgcn_raw_buffer_load_b128(drs, o + 3 * 64 * 512 * 8, 0, 16));
                        v[b][n] = (p0 + p1) + (p2 + p3); }
                E.rg(a, m, v, cur, wr, wc, fr, fq); }
        asm volatile("s_waitcnt vmcnt(0)" ::: "memory");
        __syncthreads();
        if (tid == 0) { const unsigned old = __hip_atomic_fetch_add(g.cnt + 2 * cur.ti + 1, 1u, __ATOMIC_RELAXED, __HIP_MEMORY_SCOPE_AGENT);
            if (old == 3u) { __hip_atomic_store(g.cnt + 2 * cur.ti, 0u, __ATOMIC_RELAXED, __HIP_MEMORY_SCOPE_AGENT); __hip_atomic_store(g.cnt + 2 * cur.ti + 1, 0u, __ATOMIC_RELAXED, __HIP_MEMORY_SCOPE_AGENT); } }
        __syncthreads();
    }
    }
#undef PG8_SA
#undef PG8_SB
#undef PG8_STAGE
#undef PG8_LDA
#undef PG8_LDB
#undef PG8_MMA
#undef PG8_WAIT_V
#undef PG8_WAIT_L
#undef PG8_BAR
#undef PG8_SCHED
}
}
using pg8::Unit;
typedef const f32x4 (&AccRef)[2][2][4][2];

__device__ __forceinline__ void st_bf16x4(bf16_t* p, f32x4 v) { u32x2 w; w.x = cvt_pk_bf16(v[0], v[1]); w.y = cvt_pk_bf16(v[2], v[3]); *(u32x2*)p = w; }
__device__ __forceinline__ void st_bf16x8(bf16_t* p, f32x4 a, f32x4 b) { u32x4 w; w.x = cvt_pk_bf16(a[0], a[1]); w.y = cvt_pk_bf16(a[2], a[3]); w.z = cvt_pk_bf16(b[0], b[1]); w.w = cvt_pk_bf16(b[2], b[3]); *(u32x4*)p = w; }
__device__ __forceinline__ bf16_t bf16_1(float v) { return (bf16_t)(cvt_pk_bf16(v, 0.f) & 0xffffu); }

struct EpiG1 {
    static constexpr bool SPLIT = false;
    __device__ __forceinline__ bool swapped(const Unit& u) const { return u.pn >= 16 && u.pn < 24; }
    bf16_t *aglu, *q, *k, *kt, *vt, *rg, *gate; const float *rcos, *rsin;
    __device__ __forceinline__ void operator()(AccRef acc, const Unit& u, int wr, int wc, int fr, int fq) const {
        const int pn = u.pn, row0 = u.pm * 256 + wr * 64 + fr, ct = wc * 32 + 8 * fq;
        if (pn < 8) {
#pragma unroll
            for (int ai = 0; ai < 2; ++ai)
#pragma unroll
                for (int m = 0; m < 4; ++m) { const int row = row0 + ai * 128 + m * 16; f32x4 o[2];
#pragma unroll
                    for (int n = 0; n < 2; ++n) { const f32x4 a = acc[ai][0][m][n], b = acc[ai][1][m][n];
#pragma unroll
                        for (int r = 0; r < 4; ++r) o[n][r] = a[r] * sigmoidf_(b[r]); }
                    st_bf16x8(aglu + (size_t)row * DM + pn * 128 + ct, o[0], o[1]); }
        } else if (pn < 16) {
            const bool isK = pn >= 12; const int h = (pn - 8) & 3; const float sc = isK ? 0.0625f : 1.0f; bf16_t* dst = isK ? k : q;
#pragma unroll
            for (int ai = 0; ai < 2; ++ai)
#pragma unroll
                for (int m = 0; m < 4; ++m) { const int row = row0 + ai * 128 + m * 16; const bool lat = row >= TC; const int pos = (row - TC) & 2047, gr = pos >> 6, gc = pos & 63; f32x4 o1[2], o2[2];
#pragma unroll
                    for (int n = 0; n < 2; ++n) { const int d1 = ct + n * 4; const f32x4 x1 = acc[ai][0][m][n] * sc, x2 = acc[ai][1][m][n] * sc; o1[n] = x1; o2[n] = x2;
                        if (lat) { const int ti = (d1 < 64) ? gr * 64 + d1 : gc * 64 + d1 - 64; const f32x4 cs = *(const f32x4*)(rcos + ti), sn = *(const f32x4*)(rsin + ti);
                            o1[n] = x1 * cs - x2 * sn; o2[n] = x2 * cs + x1 * sn; }
                        if (isK) {
#pragma unroll
                            for (int r = 0; r < 4; ++r) { kt[(size_t)(h * 256 + d1 + r) * TT + row] = bf16_1(o1[n][r]); kt[(size_t)(h * 256 + 128 + d1 + r) * TT + row] = bf16_1(o2[n][r]); } } }
                    st_bf16x8(dst + (size_t)row * DM + h * 256 + ct, o1[0], o1[1]); st_bf16x8(dst + (size_t)row * DM + h * 256 + 128 + ct, o2[0], o2[1]); }
        } else if (pn < 24) {
            const int e0 = (pn - 16) * 256 + wr * 64 + fr, t0 = u.pm * 256 + ct;
#pragma unroll
            for (int ai = 0; ai < 2; ++ai)
#pragma unroll
                for (int m = 0; m < 4; ++m) { bf16_t* vr = vt + (size_t)(e0 + ai * 128 + m * 16) * TT + t0;
#pragma unroll
                    for (int bj = 0; bj < 2; ++bj) st_bf16x8(vr + bj * 128, acc[ai][bj][m][0], acc[ai][bj][m][1]); }
        } else {
            const bool isG = pn >= 32; bf16_t* dst = isG ? gate : rg; const int cb = ((pn - 24) & 7) * 256;
#pragma unroll
            for (int ai = 0; ai < 2; ++ai)
#pragma unroll
                for (int m = 0; m < 4; ++m) { const int row = row0 + ai * 128 + m * 16;
#pragma unroll
                    for (int bj = 0; bj < 2; ++bj) { f32x4 o[2];
#pragma unroll
                        for (int n = 0; n < 2; ++n) { const f32x4 v = acc[ai][bj][m][n];
#pragma unroll
                            for (int r = 0; r < 4; ++r) { const float s = sigmoidf_(v[r]); o[n][r] = isG ? s : v[r] * s; } }
                        st_bf16x8(dst + (size_t)row * VW + cb + bj * 128 + ct, o[0], o[1]); } }
        }
    }
};

struct EpiE1 {
    static constexpr bool SPLIT = false;
    __device__ __forceinline__ bool swapped(const Unit&) const { return false; }
    bf16_t* m1; const bf16_t* gate;
    __device__ __forceinline__ void operator()(AccRef acc, const Unit& u, int wr, int wc, int fr, int fq) const {
        const int row0 = u.pm * 256 + wr * 64 + fr, col0 = u.pn * 256 + wc * 32 + 8 * fq;
#pragma unroll
        for (int ai = 0; ai < 2; ++ai)
#pragma unroll
            for (int m = 0; m < 4; ++m) { const int row = row0 + ai * 128 + m * 16;
#pragma unroll
                for (int bj = 0; bj < 2; ++bj) { const int col = col0 + bj * 128; const u32x4 gv = *(const u32x4*)(gate + (size_t)row * VW + col); const f32x4 v0 = acc[ai][bj][m][0], v1 = acc[ai][bj][m][1];
                    f32x4 o0, o1; o0[0] = v0[0] * bf_lo(gv.x); o0[1] = v0[1] * bf_hi(gv.x); o0[2] = v0[2] * bf_lo(gv.y); o0[3] = v0[3] * bf_hi(gv.y);
                    o1[0] = v1[0] * bf_lo(gv.z); o1[1] = v1[1] * bf_hi(gv.z); o1[2] = v1[2] * bf_lo(gv.w); o1[3] = v1[3] * bf_hi(gv.w);
                    st_bf16x8(m1 + (size_t)row * DM + col, o0, o1); } }
    }
};
struct EpiE2 {
    static constexpr bool SPLIT = false;
    __device__ __forceinline__ bool swapped(const Unit&) const { return false; }
    const bf16_t* m1; const bf16_t* gate; bf16_t* mm;
    __device__ __forceinline__ void operator()(AccRef acc, const Unit& u, int wr, int wc, int fr, int fq) const {
        const int row0 = u.pm * 256 + wr * 64 + fr, col0 = u.pn * 256 + wc * 32 + 8 * fq;
#pragma unroll
        for (int ai = 0; ai < 2; ++ai)
#pragma unroll
            for (int m = 0; m < 4; ++m) { const int row = row0 + ai * 128 + m * 16;
#pragma unroll
                for (int bj = 0; bj < 2; ++bj) { const int col = col0 + bj * 128; const u32x4 gv = *(const u32x4*)(gate + (size_t)row * VW + DM + col), mv = *(const u32x4*)(m1 + (size_t)row * DM + col); const f32x4 v0 = acc[ai][bj][m][0], v1 = acc[ai][bj][m][1];
                    f32x4 o0, o1; o0[0] = bf_lo(mv.x) + v0[0] * bf_lo(gv.x); o0[1] = bf_hi(mv.x) + v0[1] * bf_hi(gv.x); o0[2] = bf_lo(mv.y) + v0[2] * bf_lo(gv.y); o0[3] = bf_hi(mv.y) + v0[3] * bf_hi(gv.y);
                    o1[0] = bf_lo(mv.z) + v1[0] * bf_lo(gv.z); o1[1] = bf_hi(mv.z) + v1[1] * bf_hi(gv.z); o1[2] = bf_lo(mv.w) + v1[2] * bf_lo(gv.w); o1[3] = bf_hi(mv.w) + v1[3] * bf_hi(gv.w);
                    st_bf16x8(mm + (size_t)row * DM + col, o0, o1); } }
    }
};
template <bool SPLIT_> struct EpiResT {
    static constexpr bool SPLIT = SPLIT_;
    __device__ __forceinline__ bool swapped(const Unit&) const { return false; }
    const float *xa, *xb; float* xout; const float* gvec;
    __device__ __forceinline__ void rg(int ai, int m, const f32x4 (&v)[2][2], const Unit& u, int wr, int wc, int fr, int fq) const {
        const int row = u.pm * 256 + wr * 64 + fr + ai * 128 + m * 16, col0 = u.pn * 256 + wc * 32 + 8 * fq;
        const float* xr = row < TC ? xa + (size_t)row * DM : xb + (size_t)(row - TC) * DM; const float* gr = gvec + row_group(row) * 6144;
#pragma unroll
        for (int bj = 0; bj < 2; ++bj)
#pragma unroll
            for (int n = 0; n < 2; ++n) { const int col = col0 + bj * 128 + n * 4; const f32x4 xv = *(const f32x4*)(xr + col), gv = *(const f32x4*)(gr + col);
                *(f32x4*)(xout + (size_t)row * DM + col) = xv + gv * v[bj][n]; }
    }
    __device__ __forceinline__ void operator()(AccRef acc, const Unit& u, int wr, int wc, int fr, int fq) const {
#pragma unroll
        for (int a = 0; a < 2; ++a)
#pragma unroll
            for (int m = 0; m < 4; ++m) { const f32x4 v[2][2] = {{acc[a][0][m][0], acc[a][0][m][1]}, {acc[a][1][m][0], acc[a][1][m][1]}}; rg(a, m, v, u, wr, wc, fr, fq); }
    }
};
struct EpiF1 {
    static constexpr bool SPLIT = false;
    __device__ __forceinline__ bool swapped(const Unit&) const { return false; }
    bf16_t* uo;
    __device__ __forceinline__ void operator()(AccRef acc, const Unit& u, int wr, int wc, int fr, int fq) const {
        const int row0 = u.pm * 256 + wr * 64 + fr, col0 = u.pn * 256 + wc * 32 + 8 * fq;
#pragma unroll
        for (int ai = 0; ai < 2; ++ai)
#pragma unroll
            for (int m = 0; m < 4; ++m) { const int row = row0 + ai * 128 + m * 16;
#pragma unroll
                for (int bj = 0; bj < 2; ++bj) { f32x4 o[2];
#pragma unroll
                    for (int n = 0; n < 2; ++n) { const f32x4 v = acc[ai][bj][m][n];
#pragma unroll
                        for (int r = 0; r < 4; ++r) { const float t = fmaxf(v[r], 0.f); o[n][r] = t * t; } }
                    st_bf16x8(uo + (size_t)row * MLPW + col0 + bj * 128, o[0], o[1]); } }
    }
};

__device__ __forceinline__ void tconv_item(const float* __restrict__ src, bf16_t* __restrict__ dst, int K, int N, int item, bool permIn, float* tile  ) {
    const int tilesN = N >> 8, kt = item / tilesN, ntile = item - kt * tilesN, k0 = kt * 64, n0 = ntile * 256, tid = tid_opaque();
    { const int r = tid >> 6, c4 = (tid & 63) * 4; f32x4 v[8];
#pragma unroll
      for (int rr = 0; rr < 8; ++rr) v[rr] = __builtin_nontemporal_load((const f32x4*)(src + (size_t)(k0 + r + rr * 8) * N + n0 + c4));
#pragma unroll
      for (int rr = 0; rr < 8; ++rr) { float* t = tile + (r + rr * 8) * 257 + c4; t[0] = v[rr][0]; t[1] = v[rr][1]; t[2] = v[rr][2]; t[3] = v[rr][3]; } }
    __syncthreads();
#pragma unroll
    for (int q = 0; q < 4; ++q) { const int n = q * 64 + (tid >> 3), k8 = (tid & 7) * 8; float v[8];
#pragma unroll
      for (int e = 0; e < 8; ++e) v[e] = tile[(k8 + e) * 257 + n];
      int nn = n0 + n;
      if (permIn && nn < 2048) { const int c = nn & 1023, half = nn >> 10; nn = (c >> 7) * 256 + half * 128 + (c & 127); }
      u32x4 w; w.x = cvt_pk_bf16(v[0], v[1]); w.y = cvt_pk_bf16(v[2], v[3]); w.z = cvt_pk_bf16(v[4], v[5]); w.w = cvt_pk_bf16(v[6], v[7]);
      *(u32x4*)(dst + (size_t)nn * K + k0 + k8) = w; }
    __syncthreads();
}

__device__ void phase0(const Params& p, unsigned char* smem) {
    float* tile = (float*)smem;
    float* scond = (float*)(smem + 66048);
    float* red = (float*)(smem + 66048 + 36864);
    const int tid = tid_opaque();
    constexpr int NT_L = 1408, NT = 2 * NT_L, NMOD = 192;
    for (int it = blockIdx.x; it < NT + NMOD + 1; it += gridDim.x) {
        if (it < NT) {
            const int l = it / NT_L; int j = it - l * NT_L; unsigned char* wb = p.ws + WS_W + (size_t)l * WL_SZ;
            if (j < 640) tconv_item(p.in[9] + (size_t)l * DM * PW, (bf16_t*)(wb + WL_IN), DM, PW, j, true, tile);
            else if ((j -= 640) < 64) tconv_item(p.in[13] + (size_t)l * DM * DM, (bf16_t*)(wb + WL_CONV), DM, DM, j, false, tile);
            else if ((j -= 64) < 128) tconv_item(p.in[15] + (size_t)l * VW * DM, (bf16_t*)(wb + WL_RET), VW, DM, j, false, tile);
            else if ((j -= 128) < 64) tconv_item(p.in[16] + (size_t)l * DM * DM, (bf16_t*)(wb + WL_OUT), DM, DM, j, false, tile);
            else if ((j -= 64) < 256) tconv_item(p.in[17] + (size_t)l * DM * MLPW, (bf16_t*)(wb + WL_M1), DM, MLPW, j, false, tile);
            else { j -= 256; tconv_item(p.in[18] + (size_t)l * MLPW * DM, (bf16_t*)(wb + WL_M2), MLPW, DM, j, false, tile); }
        } else if (it < NT + NMOD) {
            const int j = it - NT, l = j / 96, c0 = (j % 96) * 64;
            for (int idx = tid; idx < 9 * 1024; idx += NTHR) { const int g = idx >> 10, k = idx & 1023; const float v = g == 0 ? p.in[4][k] : p.in[2][(g - 1) * 1024 + k]; scond[idx] = siluf_(v); }
            __syncthreads();
            const int col = tid & 63, kg = tid >> 6; float a[9];
#pragma unroll
            for (int g = 0; g < 9; ++g) a[g] = 0.f;
            const float* wm = p.in[7] + (size_t)l * DM * 6144 + c0 + col;
#pragma unroll 16
            for (int k = kg * 128; k < kg * 128 + 128; ++k) { const float w = __builtin_nontemporal_load(wm + (size_t)k * 6144);
#pragma unroll
                for (int g = 0; g < 9; ++g) a[g] += scond[g * 1024 + k] * w; }
#pragma unroll
            for (int g = 0; g < 9; ++g) red[(kg * 9 + g) * 64 + col] = a[g];
            __syncthreads();
            for (int o = tid; o < 9 * 64; o += NTHR) { const int g = o >> 6, cc = o & 63; float s = 0.f;
#pragma unroll
                for (int q = 0; q < 8; ++q) s += red[(q * 9 + g) * 64 + cc];
                ((float*)(p.ws + WS_MOD))[(size_t)(l * 9 + g) * 6144 + c0 + cc] = s + p.in[8][l * 6144 + c0 + cc]; }
            __syncthreads();
        } else {
            float* rc = (float*)(p.ws + WS_ROPE); float* rs = rc + 4096;
            if (tid < 128) ((unsigned*)(p.ws + WS_CNT))[tid] = 0u;
            for (int idx = tid; idx < 4096; idx += NTHR) { const int pos = idx >> 6, i = idx & 63; const float inv = exp2f(-(float)i * (13.287712379549449f / 64.f)); const float ang = (float)pos * inv;
                rc[idx] = __cosf(ang); rs[idx] = __sinf(ang); }
        }
    }
}

__device__ void norm_mod_phase(const float* xa, const float* xb, bf16_t* dst, const float* ng, const float* modl, int sh_chunk) {
    const int tid = tid_opaque(), lane = tid & 63, gw = blockIdx.x * 8 + (tid >> 6), nw = gridDim.x * 8;
    for (int row0 = gw; row0 < TT; row0 += 2 * nw) {
        f32x4 v[2][4]; float ss[2];
#pragma unroll
        for (int q = 0; q < 2; ++q) { const int row = min(row0 + q * nw, TT - 1); const float* xr = row < TC ? xa + (size_t)row * DM : xb + (size_t)(row - TC) * DM;
#pragma unroll
            for (int i = 0; i < 4; ++i) v[q][i] = __builtin_nontemporal_load((const f32x4*)(xr + i * 256 + lane * 4)); }
#pragma unroll
        for (int q = 0; q < 2; ++q) { float s = 0.f;
#pragma unroll
            for (int i = 0; i < 4; ++i) s += v[q][i][0] * v[q][i][0] + v[q][i][1] * v[q][i][1] + v[q][i][2] * v[q][i][2] + v[q][i][3] * v[q][i][3];
            ss[q] = s; }
#pragma unroll
        for (int q = 0; q < 2; ++q) { const int row = row0 + q * nw; if (row >= TT) break;
            const float rstd = rsqrtf(wave_sum(ss[q]) * (1.f / DM) + EPSV); const float* md = modl + row_group(row) * 6144;
#pragma unroll
            for (int i = 0; i < 4; ++i) { const int c = i * 256 + lane * 4; const f32x4 g = *(const f32x4*)(ng + c), sh = *(const f32x4*)(md + sh_chunk * 1024 + c), sc = *(const f32x4*)(md + (sh_chunk + 1) * 1024 + c);
                const f32x4 o = v[q][i] * rstd * g * (sc + 1.f) + sh; st_bf16x4(dst + (size_t)row * DM + c, o); } }
    }
}
__device__ void final_norm_phase(float* x, const float* ng) {
    const int tid = tid_opaque(), lane = tid & 63, gw = blockIdx.x * 8 + (tid >> 6), nw = gridDim.x * 8;
    for (int row = gw; row < TT; row += nw) {
        float* xr = x + (size_t)row * DM; f32x4 v[4]; float ss = 0.f;
#pragma unroll
        for (int i = 0; i < 4; ++i) { v[i] = __builtin_nontemporal_load((const f32x4*)(xr + i * 256 + lane * 4)); ss += v[i][0] * v[i][0] + v[i][1] * v[i][1] + v[i][2] * v[i][2] + v[i][3] * v[i][3]; }
        ss = wave_sum(ss); const float rstd = rsqrtf(ss * (1.f / DM) + EPSV);
#pragma unroll
        for (int i = 0; i < 4; ++i) { const int c = i * 256 + lane * 4; const f32x4 g = *(const f32x4*)(ng + c); __builtin_nontemporal_store(v[i] * rstd * g, (f32x4*)(xr + c)); }
    }
}

__device__ void conv_phase(const Params& p, int l, unsigned char* smem) {
    const int tid = tid_opaque(), lane = tid & 63, wv = tid >> 6;
    const bf16_t* aglu = (const bf16_t*)(p.ws + WS_R2); bf16_t* aconv = (bf16_t*)(p.ws + WS_R1);
    float* red = (float*)(smem + 46 * 2048);
    float* rst = red + 128;
    const int c0 = 2 * tid;
    float w0[31], w1[31];
#pragma unroll
    for (int j = 0; j < 31; ++j) { const f32x2 wv2 = *(const f32x2*)(p.in[10] + (size_t)(l * 31 + j) * DM + c0); w0[j] = wv2.x; w1[j] = wv2.y; }
    const f32x2 bias = *(const f32x2*)(p.in[11] + l * DM + c0), gn = *(const f32x2*)(p.in[12] + l * DM + c0);
    for (int it = blockIdx.x; it < TT / 16; it += gridDim.x) {
        const int t0 = it * 16, segl = t0 < TC ? 256 : 64, ss = t0 & ~(segl - 1), se = ss + segl;
        for (int idx = tid; idx < 46 * 128; idx += NTHR) { const int rr = idx >> 7, ch = idx & 127, tt = t0 - 15 + rr; u32x4 v = (u32x4){0u, 0u, 0u, 0u};
            if (tt >= ss && tt < se) v = *(const u32x4*)(aglu + (size_t)tt * DM + ch * 8);
            *(u32x4*)(smem + rr * 2048 + ch * 16) = v; }
        __syncthreads();
        float a0[16], a1[16];
#pragma unroll
        for (int t = 0; t < 16; ++t) { a0[t] = bias.x; a1[t] = bias.y; }
#pragma unroll
        for (int rr = 0; rr < 46; ++rr) { const unsigned uv = *(const unsigned*)(smem + rr * 2048 + c0 * 2); const float lo = bf_lo(uv), hi = bf_hi(uv);
#pragma unroll
            for (int t = 0; t < 16; ++t) { const int j = rr - t; if (j >= 0 && j < 31) { a0[t] += w0[j] * lo; a1[t] += w1[j] * hi; } } }
#pragma unroll
        for (int t = 0; t < 16; ++t) { const float s = wave_sum(a0[t] * a0[t] + a1[t] * a1[t]); if (lane == 0) red[wv * 16 + t] = s; }
        __syncthreads();
        if (tid < 16) { float s = 0.f;
#pragma unroll
            for (int q = 0; q < 8; ++q) s += red[q * 16 + tid];
            rst[tid] = rsqrtf(s * (1.f / DM) + EPSV); }
        __syncthreads();
#pragma unroll
        for (int t = 0; t < 16; ++t) { const float r = rst[t]; *(unsigned*)(aconv + (size_t)(t0 + t) * DM + c0) = cvt_pk_bf16(siluf_(a0[t] * r * gn.x), siluf_(a1[t] * r * gn.y)); }
        __syncthreads();
    }
}

__device__ void ret_phase(const Params& p, int l, unsigned char* smem) {
    LAS unsigned char* lds = (LAS unsigned char*)smem;
    const int tid = tid_opaque(), lane = tid & 63, w = __builtin_amdgcn_readfirstlane(tid >> 6), fr = lane & 15, fq = lane >> 4;
    const bf16_t* Qg = (const bf16_t*)(p.ws + WS_Q); const bf16_t* Kg = (const bf16_t*)(p.ws + WS_K); const bf16_t* KTg = (const bf16_t*)(p.ws + WS_KT); const bf16_t* VTg = (const bf16_t*)(p.ws + WS_VT);
    constexpr int QOFF = 0, KTOFF = 65536;
    const unsigned voffQ = (unsigned)(((2 * w + (lane >> 5)) * DM + (((lane & 31) ^ ((2 * w + (lane >> 5)) & 15))) * 8) * 2);
    const unsigned voffKT = (unsigned)(((4 * w + (lane >> 4)) * TT + (((lane & 15) ^ ((((2 * w + (lane >> 5)) & 12)) | ((lane >> 4) & 3)))) * 8) * 2);
    const unsigned voffK = (unsigned)(((16 * w + fr) * DM + fq * 8) * 2);
    const unsigned voffV = (unsigned)(((16 * w + fr) * TT + fq * 8) * 2);
    const unsigned voffY = (unsigned)(((4 * fq) * VW + 16 * w + fr) * 2);
    int xb[4];
#pragma unroll
    for (int k4 = 0; k4 < 4; ++k4) xb[k4] = ((k4 * 4 + fq) ^ fr) * 16;
    for (int it = blockIdx.x; it < 768; it += gridDim.x) {
        int es, dir, h, bb, tok0, nch; const bool lat = it < 256;
        { const int j = lat ? it : it - 256, x = j & 7, y = j >> 3; es = y & 3; const int cmb = (y >> 2) * 8 + x; dir = cmb & 1; h = (cmb >> 1) & 3; bb = cmb >> 3;
          tok0 = lat ? TC + bb * 2048 : bb * 256; nch = lat ? 16 : 2; }
        const float dl = p.in[14][l * 8 + dir * 4 + h]; const float lg2 = -log1pf(expf(-dl)) * 1.4426950408889634f;
        const float sdec = exp2f(128.f * lg2);
        const float zl = dir ? -lg2 : lg2, zb2 = (float)(dir ? 128 - 4 * fq : 4 * fq + 1) * lg2, kb2 = (float)(dir ? 8 * fq : 127 - 8 * fq) * lg2;
        const int pbase = dir ? (16 * w + 4 * fq - fr) : (fr - 16 * w - 4 * fq);
        f32x4 S[16];
        const unsigned voffS = (unsigned)((8 * fq * 512 + 16 * w + fr) * 4);
        if (lat) { const float* sp = p.in[3] + ((((size_t)bb * 2 + l) * 2 + dir) * 4 + h) * 256 * 512 + es * 128;
#pragma unroll
            for (int D = 0; D < 16; ++D)
#pragma unroll
                for (int r = 0; r < 4; ++r) S[D][r] = __builtin_nontemporal_load((const float*)((const char*)(sp + ((D >> 1) * 32 + 4 * (D & 1) + r) * 512) + voffS));
        } else {
#pragma unroll
            for (int D = 0; D < 16; ++D) S[D] = (f32x4){0.f, 0.f, 0.f, 0.f};
        }
        bf16_t* Yg = (bf16_t*)(p.ws + (dir ? WS_YB : WS_YF));
        for (int s = 0; s < nch; ++s) {
            const int c = dir ? nch - 1 - s : s, r0 = tok0 + c * 128;
            { const bf16_t* qu = Qg + (size_t)r0 * DM + h * 256; const bf16_t* ku = KTg + (size_t)(h * 256) * TT + r0;
#pragma unroll
              for (int n = 0; n < 8; ++n) {
                  __builtin_amdgcn_global_load_lds((const unsigned*)((const char*)(qu + (size_t)(n * 16) * DM) + voffQ), (LAS unsigned*)(lds + QOFF + (n * 8 + w) * 1024), 16, 0, 0);
                  __builtin_amdgcn_global_load_lds((const unsigned*)((const char*)(ku + (size_t)(n * 32) * TT) + voffKT), (LAS unsigned*)(lds + KTOFF + (n * 8 + w) * 1024), 16, 0, 0); } }
            bf16x8 Kf[8], Vf[4];
            { const char* kb = (const char*)(Kg + (size_t)r0 * DM + h * 256) + voffK;
#pragma unroll
              for (int ks = 0; ks < 4; ++ks) Kf[ks] = *(const bf16x8*)(kb + ks * 64); }
            asm volatile("s_waitcnt vmcnt(0)" ::: "memory");
            __syncthreads();
            { const char* kb = (const char*)(Kg + (size_t)r0 * DM + h * 256) + voffK;
#pragma unroll
              for (int ks = 4; ks < 8; ++ks) Kf[ks] = *(const bf16x8*)(kb + ks * 64); }
            f32x4 Z[8], PT[8];
#pragma unroll
            for (int i8 = 0; i8 < 8; ++i8) { Z[i8] = (f32x4){0.f, 0.f, 0.f, 0.f}; PT[i8] = (f32x4){0.f, 0.f, 0.f, 0.f}; }
#define QFRAG(ks, i8) (*(const LAS bf16x8*)(lds + QOFF + xb[(ks) & 3] + fr * 512 + (i8) * 8192 + ((ks) >> 2) * 256))
            { bf16x8 qa[4], qb[4];
#pragma unroll
              for (int j = 0; j < 4; ++j) qa[j] = QFRAG(0, j);
#pragma unroll
              for (int ks = 0; ks < 8; ++ks) { u32x4 t; t.x = cvt_pk_bf16(S[2 * ks][0], S[2 * ks][1]); t.y = cvt_pk_bf16(S[2 * ks][2], S[2 * ks][3]); t.z = cvt_pk_bf16(S[2 * ks + 1][0], S[2 * ks + 1][1]); t.w = cvt_pk_bf16(S[2 * ks + 1][2], S[2 * ks + 1][3]);
                  const bf16x8 Sb = __builtin_bit_cast(bf16x8, t);
#pragma unroll
                  for (int j = 0; j < 4; ++j) qb[j] = QFRAG(ks, 4 + j);
                  __builtin_amdgcn_sched_barrier(0);
#pragma unroll
                  for (int j = 0; j < 4; ++j) { Z[j] = __builtin_amdgcn_mfma_f32_16x16x32_bf16(qa[j], Sb, Z[j], 0, 0, 0); PT[j] = __builtin_amdgcn_mfma_f32_16x16x32_bf16(Kf[ks], qa[j], PT[j], 0, 0, 0); }
                  __builtin_amdgcn_sched_barrier(0);
                  if (ks < 7) {
#pragma unroll
                      for (int j = 0; j < 4; ++j) qa[j] = QFRAG(ks + 1, j); }
                  __builtin_amdgcn_sched_barrier(0);
#pragma unroll
                  for (int j = 0; j < 4; ++j) { Z[4 + j] = __builtin_amdgcn_mfma_f32_16x16x32_bf16(qb[j], Sb, Z[4 + j], 0, 0, 0); PT[4 + j] = __builtin_amdgcn_mfma_f32_16x16x32_bf16(Kf[ks], qb[j], PT[4 + j], 0, 0, 0); }
                  __builtin_amdgcn_sched_barrier(0); } }
#undef QFRAG
            { const char* vb = (const char*)(VTg + (size_t)(h * 512 + es * 128) * TT + r0) + voffV;
#pragma unroll
              for (int ks = 0; ks < 4; ++ks) Vf[ks] = *(const bf16x8*)(vb + ks * 64); }
            float zb2_ = zb2, zl_ = zl, kb2_ = kb2; int pbase_ = pbase;
            asm volatile("" : "+v"(zb2_), "+v"(zl_), "+v"(kb2_), "+v"(pbase_));
            { f32x4 zf, pf; const float z16 = __builtin_amdgcn_exp2f(16.f * zl_);
#pragma unroll
              for (int r = 0; r < 4; ++r) { zf[r] = __builtin_amdgcn_exp2f(zb2_ + (float)r * zl_); pf[r] = __builtin_amdgcn_exp2f((float)(pbase_ + (dir ? r : -r)) * lg2); }
#pragma unroll
              for (int i8 = 0; i8 < 8; ++i8) {
#pragma unroll
                  for (int r = 0; r < 4; ++r) { Z[i8][r] *= zf[r];
                      const int df = pbase_ + (dir ? -(i8 * 16 - r) : (i8 * 16 - r)); PT[i8][r] = df >= 0 ? PT[i8][r] * pf[r] : 0.f; }
                  zf *= z16; pf *= z16; } }
            __syncthreads();
#pragma unroll
            for (int i8 = 0; i8 < 8; ++i8) { const int i = i8 * 16 + fr; u32x2 t; t.x = cvt_pk_bf16(PT[i8][0], PT[i8][1]); t.y = cvt_pk_bf16(PT[i8][2], PT[i8][3]);
                *(LAS u32x2*)(lds + QOFF + i * 256 + (((2 * w + (fq >> 1)) ^ fr)) * 16 + (fq & 1) * 8) = t; }
            __syncthreads();
#define PFRAG(i8, ks) (*(const LAS bf16x8*)(lds + QOFF + xb[ks] + fr * 256 + (i8) * 4096))
            { bf16x8 pa[4], pb[4];
#pragma unroll
              for (int ks = 0; ks < 4; ++ks) pa[ks] = PFRAG(0, ks);
#pragma unroll
              for (int i8 = 0; i8 < 8; i8 += 2) {
#pragma unroll
                  for (int ks = 0; ks < 4; ++ks) pb[ks] = PFRAG(i8 + 1, ks);
                  __builtin_amdgcn_sched_barrier(0);
#pragma unroll
                  for (int ks = 0; ks < 4; ++ks) Z[i8] = __builtin_amdgcn_mfma_f32_16x16x32_bf16(pa[ks], Vf[ks], Z[i8], 0, 0, 0);
                  __builtin_amdgcn_sched_barrier(0);
                  if (i8 < 6) {
#pragma unroll
                      for (int ks = 0; ks < 4; ++ks) pa[ks] = PFRAG(i8 + 2, ks); }
                  __builtin_amdgcn_sched_barrier(0);
#pragma unroll
                  for (int ks = 0; ks < 4; ++ks) Z[i8 + 1] = __builtin_amdgcn_mfma_f32_16x16x32_bf16(pb[ks], Vf[ks], Z[i8 + 1], 0, 0, 0);
                  __builtin_amdgcn_sched_barrier(0); } }
#undef PFRAG
#pragma unroll
            for (int i8 = 0; i8 < 8; ++i8)
#pragma unroll
                for (int r = 0; r < 4; ++r) *(bf16_t*)((char*)(Yg + (size_t)(r0 + i8 * 16 + r) * VW + h * 512 + es * 128) + voffY) = bf16_1(Z[i8][r]);
            bf16x8 Vs[4];
            float kf8[8], kstep[4];
#pragma unroll
            for (int e = 0; e < 8; ++e) kf8[e] = __builtin_amdgcn_exp2f(kb2_ - (float)e * zl_);
            { const float k32 = __builtin_amdgcn_exp2f(-32.f * zl_); kstep[0] = 1.f; kstep[1] = k32; kstep[2] = k32 * k32; kstep[3] = kstep[2] * k32; }
#pragma unroll
            for (int ks = 0; ks < 4; ++ks) { const u32x4 t = __builtin_bit_cast(u32x4, Vf[ks]); float f[8]; f[0] = bf_lo(t.x); f[1] = bf_hi(t.x); f[2] = bf_lo(t.y); f[3] = bf_hi(t.y); f[4] = bf_lo(t.z); f[5] = bf_hi(t.z); f[6] = bf_lo(t.w); f[7] = bf_hi(t.w);
#pragma unroll
                for (int e = 0; e < 8; ++e) f[e] *= kf8[e] * kstep[ks];
                u32x4 o; o.x = cvt_pk_bf16(f[0], f[1]); o.y = cvt_pk_bf16(f[2], f[3]); o.z = cvt_pk_bf16(f[4], f[5]); o.w = cvt_pk_bf16(f[6], f[7]); Vs[ks] = __builtin_bit_cast(bf16x8, o); }
#define TFRAG(D, ks) (*(const LAS bf16x8*)(lds + KTOFF + xb[ks] + (8 * (fr >> 2) + (fr & 3)) * 256 + ((D) >> 1) * 8192 + ((D) & 1) * 1024))
            { bf16x8 ta[4], tb[4];
#pragma unroll
              for (int ks = 0; ks < 4; ++ks) ta[ks] = TFRAG(0, ks);
#pragma unroll
              for (int D = 0; D < 16; D += 2) { S[D] *= sdec; S[D + 1] *= sdec;
#pragma unroll
                  for (int ks = 0; ks < 4; ++ks) tb[ks] = TFRAG(D + 1, ks);
                  __builtin_amdgcn_sched_barrier(0);
#pragma unroll
                  for (int ks = 0; ks < 4; ++ks) S[D] = __builtin_amdgcn_mfma_f32_16x16x32_bf16(ta[ks], Vs[ks], S[D], 0, 0, 0);
                  __builtin_amdgcn_sched_barrier(0);
                  if (D < 14) {
#pragma unroll
                      for (int ks = 0; ks < 4; ++ks) ta[ks] = TFRAG(D + 2, ks); }
                  __builtin_amdgcn_sched_barrier(0);
#pragma unroll
                  for (int ks = 0; ks < 4; ++ks) S[D + 1] = __builtin_amdgcn_mfma_f32_16x16x32_bf16(tb[ks], Vs[ks], S[D + 1], 0, 0, 0);
                  __builtin_amdgcn_sched_barrier(0); } }
#undef TFRAG
            __syncthreads();
        }
        if (!lat) { float* so = p.out + (size_t)TT * DM + ((((size_t)bb * 2 + l) * 2 + dir) * 4 + h) * 256 * 512 + es * 128;
#pragma unroll
            for (int D = 0; D < 16; ++D)
#pragma unroll
                for (int r = 0; r < 4; ++r) __builtin_nontemporal_store(S[D][r], (float*)((char*)(so + ((D >> 1) * 32 + 4 * (D & 1) + r) * 512) + voffS)); }
    }
}

__device__ void comb_phase(const Params& p) {
    const int tid = tid_opaque(), lane = tid & 63, gw = blockIdx.x * 8 + (tid >> 6), nw = gridDim.x * 8;
    const bf16_t* yf = (const bf16_t*)(p.ws + WS_YF); const bf16_t* yb = (const bf16_t*)(p.ws + WS_YB); const bf16_t* rg = (const bf16_t*)(p.ws + WS_RG); bf16_t* ar = (bf16_t*)(p.ws + WS_Q);
    for (int tok = gw; tok < TT; tok += nw) {
        u32x4 a[4], b[4], g[4];
#pragma unroll
        for (int h = 0; h < 4; ++h) { const size_t off = (size_t)tok * VW + h * 512 + lane * 8; a[h] = __builtin_nontemporal_load((const u32x4*)(yf + off)); b[h] = __builtin_nontemporal_load((const u32x4*)(yb + off)); g[h] = __builtin_nontemporal_load((const u32x4*)(rg + off)); }
#pragma unroll
        for (int h = 0; h < 4; ++h) {
            float y[8];
#pragma unroll
            for (int e = 0; e < 4; ++e) { y[2 * e] = bf_lo(a[h][e]) + bf_lo(b[h][e]); y[2 * e + 1] = bf_hi(a[h][e]) + bf_hi(b[h][e]); }
            float s = 0.f;
#pragma unroll
            for (int e = 0; e < 8; ++e) s += y[e];
            const float mu = wave_sum(s) * (1.f / 512.f); float v = 0.f;
#pragma unroll
            for (int e = 0; e < 8; ++e) { y[e] -= mu; v += y[e] * y[e]; }
            const float rstd = rsqrtf(wave_sum(v) * (1.f / 512.f) + EPSV);
            u32x4 o;
#pragma unroll
            for (int e = 0; e < 4; ++e) o[e] = cvt_pk_bf16(y[2 * e] * rstd * bf_lo(g[h][e]), y[2 * e + 1] * rstd * bf_hi(g[h][e]));
            *(u32x4*)(ar + (size_t)tok * VW + h * 512 + lane * 8) = o;
        }
    }
}


#define XB_TMO      128
#define XB_XCNT(j)  (256  + 64 * (j))
#define XB_XSUB(j)  (1280 + 64 * (j))
#define XB_XGEN(j)  (2304 + 64 * (j))
#define XB_TOP      3328
#define XB_TOPGEN   3392
#define XCD_BAR_WORDS 3456
#define XB_SPIN_CAP (1u << 18)
__device__ __forceinline__ unsigned xb_ld(unsigned* p)              { return __hip_atomic_load(p, __ATOMIC_RELAXED, __HIP_MEMORY_SCOPE_AGENT); }
__device__ __forceinline__ unsigned xb_add(unsigned* p, unsigned v) { return __hip_atomic_fetch_add(p, v, __ATOMIC_RELAXED, __HIP_MEMORY_SCOPE_AGENT); }
__device__ __forceinline__ unsigned xb_xcc_id() { return (unsigned)__builtin_amdgcn_s_getreg((3 << 11) | 20) & 0xFu; }
#define XB_SPIN(cond, bar) do { unsigned _sp = 0; while (cond) { __builtin_amdgcn_s_sleep(1); \
    if ((++_sp & 255u) == 0u) { if (xb_ld(&(bar)[XB_TMO])) break; if (_sp > XB_SPIN_CAP) { atomicAdd(&(bar)[XB_TMO], 1u); break; } } } } while (0)
struct XcdBarrier { unsigned* bar; unsigned x; volatile LAS unsigned* st; };
__device__ __forceinline__ XcdBarrier xcd_barrier_post(unsigned* bar, volatile LAS unsigned* st) {
    XcdBarrier b; b.bar = bar; b.x = xb_xcc_id(); b.st = st;
    if (threadIdx.x == 0) (void)xb_add(&bar[XB_XCNT(b.x)], 1u);
    return b;
}
__device__ __forceinline__ void xcd_barrier_complete(unsigned* bar, unsigned x, unsigned& nloc, unsigned& nx) {
    const unsigned G = gridDim.x * gridDim.y * gridDim.z;
    unsigned sum, cnt, mine, sp = 0u;
    for (;;) {
        sum = 0u; cnt = 0u; mine = 0u;
#pragma unroll
        for (unsigned j = 0; j < 16; ++j) { const unsigned c = xb_ld(&bar[XB_XCNT(j)]); sum += c; cnt += (c > 0u) ? 1u : 0u; mine = (j == x) ? c : mine; }
        if (sum == G) break;
        __builtin_amdgcn_s_sleep(1);
        if ((++sp & 255u) == 0u) { if (xb_ld(&bar[XB_TMO])) break; if (sp > XB_SPIN_CAP) { atomicAdd(&bar[XB_TMO], 1u); break; } }
    }
    nloc = mine > 0u ? mine : 1u; nx = cnt > 0u ? cnt : 1u;
}
__device__ __forceinline__ void xcd_barrier(const XcdBarrier& b) {
    asm volatile("s_waitcnt vmcnt(0)" ::: "memory");
    __syncthreads();
    if (threadIdx.x == 0) {
        unsigned* bar = b.bar;
        __builtin_amdgcn_s_waitcnt(0);
        unsigned nloc = b.st[0], nx = b.st[1];
        if (nloc == 0u) { xcd_barrier_complete(bar, b.x, nloc, nx); b.st[0] = nloc; b.st[1] = nx; }
        const unsigned old = xb_add(&bar[XB_XSUB(b.x)], 1u);
        const unsigned gen = old / nloc;
        if (old + 1u == (gen + 1u) * nloc) {
            __builtin_amdgcn_fence(__ATOMIC_RELEASE, "agent");
            asm volatile("s_waitcnt vmcnt(0)" ::: "memory");
            const unsigned og = xb_add(&bar[XB_TOP], 1u);
            const unsigned tg = og / nx;
            if (og + 1u == (tg + 1u) * nx) xb_add(&bar[XB_TOPGEN], 1u);
            else XB_SPIN(xb_ld(&bar[XB_TOPGEN]) == tg, bar);
            __builtin_amdgcn_fence(__ATOMIC_ACQUIRE, "agent");
            xb_add(&bar[XB_XGEN(b.x)], 1u);
            asm volatile("s_waitcnt vmcnt(0)" ::: "memory");
        } else {
            XB_SPIN(xb_ld(&bar[XB_XGEN(b.x)]) == gen, bar);
            __builtin_amdgcn_fence(__ATOMIC_ACQUIRE, "agent");
            asm volatile("s_waitcnt vmcnt(0)" ::: "memory");
        }
    }
    __syncthreads();
}

__global__ void __launch_bounds__(NTHR) mega(Params p) {
    __shared__ __attribute__((aligned(16))) unsigned char smem[131072];
    cg::grid_group grid = cg::this_grid();
    LAS unsigned char* lds = (LAS unsigned char*)smem;
    unsigned char* ws = p.ws;
    float* xbuf = p.out;
    const float* modb = (const float*)(ws + WS_MOD);
    pg8::StaticOrder so;
    __shared__ __attribute__((aligned(16))) unsigned xb_st[4];
    if (threadIdx.x < 4) xb_st[threadIdx.x] = 0u;
    __syncthreads();
    if (blockIdx.x == 1) { const int t = tid_opaque(); for (int i = t; i < XCD_BAR_WORDS; i += NTHR) ((unsigned*)(ws + WS_BAR))[i] = 0u; }
    phase0(p, smem);
    grid.sync();
    const XcdBarrier xbar = xcd_barrier_post((unsigned*)(ws + WS_BAR), (volatile LAS unsigned*)xb_st);
    for (int l = 0; l < 2; ++l) {
        const unsigned char* wl = ws + WS_W + (size_t)l * WL_SZ;
        const float* modl = modb + (size_t)l * 9 * 6144;
        const float* xa = l == 0 ? p.in[0] : xbuf; const float* xb = l == 0 ? p.in[1] : xbuf + (size_t)TC * DM;
        norm_mod_phase(xa, xb, (bf16_t*)(ws + WS_R1), p.in[5] + l * DM, modl, 0);
        xcd_barrier(xbar);
        { pg8::Gemm g{(const bf16_t*)(ws + WS_R1), (const bf16_t*)(wl + WL_IN), TT, PW, DM, nullptr, nullptr}; so.init(TT, PW, gridDim.x, blockIdx.x);
          EpiG1 e{(bf16_t*)(ws + WS_R2), (bf16_t*)(ws + WS_Q), (bf16_t*)(ws + WS_K), (bf16_t*)(ws + WS_KT), (bf16_t*)(ws + WS_VT), (bf16_t*)(ws + WS_RG), (bf16_t*)(ws + WS_GATE), (const float*)(ws + WS_ROPE), (const float*)(ws + WS_ROPE) + 4096};
          pg8::gemm_phase(lds, g, so, e); }
        xcd_barrier(xbar);
        ret_phase(p, l, smem);
        conv_phase(p, l, smem);
        xcd_barrier(xbar);
        { pg8::Gemm g{(const bf16_t*)(ws + WS_R1), (const bf16_t*)(wl + WL_CONV), TT, DM, DM, nullptr, nullptr}; so.init(TT, DM, gridDim.x, blockIdx.x);
          EpiE1 e{(bf16_t*)(ws + WS_KT), (const bf16_t*)(ws + WS_GATE)};
          comb_phase(p);
          __syncthreads();
          pg8::gemm_phase(lds, g, so, e); }
        xcd_barrier(xbar);
        { pg8::Gemm g{(const bf16_t*)(ws + WS_Q), (const bf16_t*)(wl + WL_RET), TT, DM, VW, nullptr, nullptr}; so.init(TT, DM, gridDim.x, blockIdx.x);
          EpiE2 e{(const bf16_t*)(ws + WS_KT), (const bf16_t*)(ws + WS_GATE), (bf16_t*)(ws + WS_R2)};
          pg8::gemm_phase(lds, g, so, e); }
        xcd_barrier(xbar);
        { pg8::Gemm g{(const bf16_t*)(ws + WS_R2), (const bf16_t*)(wl + WL_OUT), TT, DM, DM, nullptr, nullptr}; so.init(TT, DM, gridDim.x, blockIdx.x);
          EpiResT<false> e{xa, xb, xbuf, modl + 2 * 1024};
          pg8::gemm_phase(lds, g, so, e); }
        xcd_barrier(xbar);
        norm_mod_phase(xbuf, xbuf + (size_t)TC * DM, (bf16_t*)(ws + WS_R1), p.in[6] + l * DM, modl, 3);
        xcd_barrier(xbar);
        { pg8::Gemm g{(const bf16_t*)(ws + WS_R1), (const bf16_t*)(wl + WL_M1), TT, MLPW, DM, nullptr, nullptr}; so.init(TT, MLPW, gridDim.x, blockIdx.x);
          EpiF1 e{(bf16_t*)(ws + WS_RG)};
          pg8::gemm_phase(lds, g, so, e); }
        xcd_barrier(xbar);
        { pg8::Gemm g{(const bf16_t*)(ws + WS_RG), (const bf16_t*)(wl + WL_M2), TT, DM, MLPW, (unsigned long long*)(ws + WS_DUMP), (unsigned*)(ws + WS_CNT)}; so.init(TT, DM, gridDim.x, blockIdx.x, true);
          EpiResT<true> e{xbuf, xbuf + (size_t)TC * DM, xbuf, modl + 5 * 1024};
          pg8::gemm_phase(lds, g, so, e); }
        xcd_barrier(xbar);
    }
    final_norm_phase(xbuf, p.in[19]);
}

extern "C" void kernel_launch(void* const* d_in, const int* in_sizes, int n_in, void* d_out, int out_size, void* d_ws, size_t ws_size, hipStream_t stream) {
    static int grid_blocks = 0;
    if (!grid_blocks) {
        int dev = 0, cus = 0, per_cu = 0;
        (void)hipGetDevice(&dev);
        (void)hipDeviceGetAttribute(&cus, hipDeviceAttributeMultiprocessorCount, dev);
        (void)hipOccupancyMaxActiveBlocksPerMultiprocessor(&per_cu, mega, NTHR, 0);
        if (per_cu < 1) per_cu = 1;
        grid_blocks = cus;
    }
    if (n_in != 20 || ws_size < WS_END) return;
    Params p{};
    for (int i = 0; i < 20; ++i) p.in[i] = (const float*)d_in[i];
    p.out = (float*)d_out; p.ws = (unsigned char*)d_ws;
    void* args[] = {&p};
    (void)hipLaunchCooperativeKernel((void*)mega, dim3(grid_blocks), dim3(NTHR), args, 0, stream);
}
```

```cpp
#include <hip/hip_runtime.h>
#include <hip/hip_cooperative_groups.h>
namespace cg = cooperative_groups;

#define LAS __attribute__((address_space(3)))
typedef unsigned short bf16_t;
typedef short bf16x8 __attribute__((ext_vector_type(8)));
typedef float f32x4 __attribute__((ext_vector_type(4)));
typedef float f32x2 __attribute__((ext_vector_type(2)));
typedef unsigned u32x2 __attribute__((ext_vector_type(2)));
typedef unsigned u32x4 __attribute__((ext_vector_type(4)));

constexpr int DM = 1024, TC = 4096, TL = 16384, TT = 20480, PW = 10240, MLPW = 4096, VW = 2048;
constexpr int NTHR = 512;
constexpr float EPSV = 1e-6f;
constexpr size_t MiB = (size_t)1 << 20;
constexpr size_t WS_W = 0;
constexpr size_t WL_IN = 0, WL_CONV = 20 * MiB, WL_RET = 22 * MiB, WL_OUT = 26 * MiB, WL_M1 = 28 * MiB, WL_M2 = 36 * MiB, WL_SZ = 44 * MiB;
constexpr size_t WS_MOD = 88 * MiB;
constexpr size_t WS_ROPE = 88 * MiB + 512 * 1024;
constexpr size_t WS_R1 = 90 * MiB;
constexpr size_t WS_R2 = 130 * MiB;
constexpr size_t WS_Q = 170 * MiB;
constexpr size_t WS_K = 210 * MiB;
constexpr size_t WS_KT = 250 * MiB;
constexpr size_t WS_VT = 290 * MiB;
constexpr size_t WS_RG = 370 * MiB;
constexpr size_t WS_GATE = 450 * MiB;
constexpr size_t WS_YF = 530 * MiB;
constexpr size_t WS_YB = 610 * MiB;
constexpr size_t WS_BAR = 88 * MiB + 448 * 1024;
constexpr size_t WS_DUMP = 690 * MiB;
constexpr size_t WS_CNT = 88 * MiB + 480 * 1024;
constexpr size_t WS_END = 754 * MiB;

struct Params { const float* in[20]; float* out; unsigned char* ws; };

typedef __bf16 bf16x2_t __attribute__((ext_vector_type(2)));
__device__ __forceinline__ unsigned cvt_pk_bf16(float lo, float hi) { const f32x2 f = {lo, hi}; const bf16x2_t v = __builtin_convertvector(f, bf16x2_t); return __builtin_bit_cast(unsigned, v); }
__device__ __forceinline__ float bf_lo(unsigned u) { return __uint_as_float(u << 16); }
__device__ __forceinline__ float bf_hi(unsigned u) { return __uint_as_float(u & 0xffff0000u); }
__device__ __forceinline__ float sigmoidf_(float x) { return __builtin_amdgcn_rcpf(1.f + __expf(-x)); }
__device__ __forceinline__ float siluf_(float x) { return x * sigmoidf_(x); }
__device__ __forceinline__ float wave_sum(float v) {
#pragma unroll
    for (int o = 32; o > 0; o >>= 1) v += __shfl_xor(v, o, 64);
    return v;
}
__device__ __forceinline__ int tid_opaque() { int t = threadIdx.x; asm volatile("" : "+v"(t)); return t; }
__device__ __forceinline__ int row_group(int row) { return row < TC ? 0 : 1 + ((row - TC) >> 11); }

namespace pg8 {
constexpr int BM = 256, BK = 64, HALF = 128, HTB = HALF * BK * 2, NXCD = 8, WGM = 8;
__device__ __forceinline__ int lds_byte(int r, int c) { const int st = (r >> 4) * 2 + (c >> 5), rr = r & 15, cc = c & 31, ob = rr * 64 + cc * 2; return st * 1024 + (ob ^ (((ob >> 9) & 1) << 5)); }
__device__ __forceinline__ void stage_rc(int b, int& R, int& C) { const int st = b / 1024, sb = b % 1024, swz = sb ^ (((sb >> 9) & 1) << 5); R = (st >> 1) * 16 + swz / 64; C = (st & 1) * 32 + (swz % 64) / 2; }
__device__ __forceinline__ int perm32(int rho) { const int n = rho >> 4, i = rho & 15; return 8 * (i >> 2) + 4 * n + (i & 3); }
struct Unit { int pm, pn, kq, ti; };
struct Gemm { const bf16_t* A; const bf16_t* Bt; int M, N, K; unsigned long long* dump; unsigned* cnt; };
struct StaticOrder {
    int nM, nN, nwg, G, c; bool split;
    __device__ void init(int M, int N, int G_, int c_, bool allow_split = false) { nM = M / BM; nN = N / BM; nwg = nM * nN; G = G_; c = c_; split = allow_split && nwg == 320 && G == 256; }
    __device__ bool next(int i, Unit& u) const {
        if (split) {
            const int x = c & 7, j = c >> 3;
            if (i == 0) { u.pm = x * 8 + (j & 7); u.pn = j >> 3; u.kq = -1; u.ti = 0; return true; }
            if (i == 1) { u.kq = x & 3; u.pm = 64 + (x >> 2) * 8 + (j >> 2); u.pn = j & 3; u.ti = (u.pm - 64) * 4 + u.pn; return true; }
            return false;
        }
        const long L = (long)i * G + c;
        if (L >= nwg) return false;
        int wgid = (int)L; { const int q = nwg / NXCD, r = nwg % NXCD, xcd = wgid % NXCD, off = wgid / NXCD; wgid = (xcd < r ? xcd * (q + 1) : r * (q + 1) + (xcd - r) * q) + off; }
        const int nig = WGM * nN, gid = wgid / nig, fm = gid * WGM, gsz = (nM - fm) < WGM ? (nM - fm) : WGM;
        u.pm = fm + ((wgid % nig) % gsz); u.pn = (wgid % nig) / gsz; u.kq = -1; u.ti = 0; return true;
    }
};

template <class Epi>
__device__ __forceinline__ void gemm_phase(LAS unsigned char* lds, const Gemm g, const StaticOrder& S, const Epi& E) {
    const int tid = tid_opaque(), wid = __builtin_amdgcn_readfirstlane(tid >> 6), lane = tid & 63, wr = wid >> 2, wc = wid & 3, fr = lane & 15, fq = lane >> 4;
    const int K = g.K;
    unsigned voffA[2], voffB[2];
#pragma unroll
    for (int i = 0; i < 2; ++i) { int R, C; stage_rc(tid * 16 + i * 8192, R, C); const int Rb = (R & ~31) + perm32(R & 31); voffA[i] = (unsigned)(R * K + C) * 2u; voffB[i] = (unsigned)(Rb * K + C) * 2u; }
    const size_t kstep = (size_t)(BK * 2);
    const size_t hstep = (size_t)HALF * K * 2;
    const size_t tstep = 2 * hstep;
    const unsigned ldsw = (unsigned)wid * 1024u;
    const int aoff = lds_byte(wr * 64 + fr, fq * 8), boff = lds_byte(wc * 32 + fr, fq * 8);
#define PG8_SA(b, h) (((b) * 2 + (h)) * HTB)
#define PG8_SB(b, h) ((4 + (b) * 2 + (h)) * HTB)
#define PG8_STAGE(bufoff, gbase, voff) do { _Pragma("unroll") for (int _i = 0; _i < 2; ++_i) \
        __builtin_amdgcn_global_load_lds((const unsigned*)((const char*)(gbase) + (voff)[_i]), (LAS unsigned*)(lds + (bufoff) + ldsw + _i * 8192), 16, 0, 0); } while (0)
#define PG8_LDA(dst, b, h) do { _Pragma("unroll") for (int m = 0; m < 4; ++m) _Pragma("unroll") for (int k = 0; k < 2; ++k) dst[m][k] = *(const LAS bf16x8*)(lds + PG8_SA(b, h) + aoff + m * 2048 + k * 1024); } while (0)
#define PG8_LDB(dst, b, h) do { _Pragma("unroll") for (int n = 0; n < 2; ++n) _Pragma("unroll") for (int k = 0; k < 2; ++k) dst[n][k] = *(const LAS bf16x8*)(lds + PG8_SB(b, h) + boff + n * 2048 + k * 1024); } while (0)
#define PG8_MMA(ai, bj, At, Bt) do { __builtin_amdgcn_s_setprio(1); _Pragma("unroll") for (int m = 0; m < 4; ++m) _Pragma("unroll") for (int n = 0; n < 2; ++n) _Pragma("unroll") for (int k = 0; k < 2; ++k) \
        acc[ai][bj][m][n] = __builtin_amdgcn_mfma_f32_16x16x32_bf16(Bt[n][k], At[m][k], acc[ai][bj][m][n], 0, 0, 0); __builtin_amdgcn_s_setprio(0); } while (0)
#define PG8_WAIT_V(n) asm volatile("s_waitcnt vmcnt(" #n ")" ::: "memory")
#define PG8_WAIT_L(n) asm volatile("s_waitcnt lgkmcnt(" #n ")" ::: "memory")
#define PG8_BAR __builtin_amdgcn_s_barrier()
#define PG8_SCHED __builtin_amdgcn_sched_barrier(0)
    Unit cur, nxt; int ui = 0;
    if (!S.next(0, cur)) return;
    f32x4 acc[2][2][4][2];
#pragma unroll
    for (int a = 0; a < 2; ++a)
#pragma unroll
        for (int b = 0; b < 2; ++b)
#pragma unroll
            for (int m = 0; m < 4; ++m)
#pragma unroll
                for (int n = 0; n < 2; ++n) acc[a][b][m][n] = (f32x4){0.f, 0.f, 0.f, 0.f};
    bf16x8 At[4][2], B0[2][2], B1[2][2];
    const char* cA = E.swapped(cur) ? (const char*)g.Bt + (size_t)cur.pn * tstep : (const char*)g.A + (size_t)cur.pm * tstep;
    const char* cB = E.swapped(cur) ? (const char*)g.A + (size_t)cur.pm * tstep : (const char*)g.Bt + (size_t)cur.pn * tstep;
    const size_t qstep = (size_t)(K >> 2) * 2;
    if (cur.kq >= 0) { cA += cur.kq * qstep; cB += cur.kq * qstep; }
    PG8_STAGE(PG8_SB(0, 0), cB, voffB); PG8_STAGE(PG8_SA(0, 0), cA, voffA); PG8_STAGE(PG8_SB(0, 1), cB + hstep, voffB); PG8_STAGE(PG8_SA(0, 1), cA + hstep, voffA);
    if (wr == 1) PG8_BAR;
    PG8_WAIT_V(4); PG8_BAR;
    PG8_STAGE(PG8_SB(1, 0), cB + kstep, voffB); PG8_STAGE(PG8_SA(1, 0), cA + kstep, voffA); PG8_STAGE(PG8_SB(1, 1), cB + hstep + kstep, voffB);
    PG8_WAIT_V(6); PG8_BAR;
    for (;;) {
        const bool has_next = S.next(ui + 1, nxt);
        const bool nsw = has_next && E.swapped(nxt);
        const char* nA = has_next ? (nsw ? (const char*)g.Bt + (size_t)nxt.pn * tstep : (const char*)g.A + (size_t)nxt.pm * tstep) : cA;
        const char* nB = has_next ? (nsw ? (const char*)g.A + (size_t)nxt.pm * tstep : (const char*)g.Bt + (size_t)nxt.pn * tstep) : cB;
        if (has_next && nxt.kq >= 0) { nA += nxt.kq * qstep; nB += nxt.kq * qstep; }
        const int nt = (cur.kq >= 0 ? (K >> 2) : K) / BK;
        for (int t = 0; t < nt; t += 2) {
            const bool last = (t == nt - 2);
            const char* a1 = cA + (size_t)(t + 1) * kstep;
            const char* a2 = last ? nA : cA + (size_t)(t + 2) * kstep; const char* b2 = last ? nB : cB + (size_t)(t + 2) * kstep;
            const char* a3 = a2 + kstep; const char* b3 = b2 + kstep;
            PG8_LDB(B0, 0, 0); PG8_SCHED; PG8_LDA(At, 0, 0); PG8_STAGE(PG8_SA(1, 1), a1 + hstep, voffA);
            PG8_WAIT_L(8); PG8_BAR; PG8_WAIT_L(0); PG8_MMA(0, 0, At, B0); PG8_BAR; PG8_SCHED;
            PG8_LDB(B1, 0, 1); PG8_STAGE(PG8_SB(0, 0), b2, voffB);
            PG8_BAR; PG8_WAIT_L(0); PG8_MMA(0, 1, At, B1); PG8_BAR;
            PG8_LDA(At, 0, 1); PG8_STAGE(PG8_SA(0, 0), a2, voffA);
            PG8_BAR; PG8_WAIT_L(0); PG8_MMA(1, 0, At, B0); PG8_BAR; PG8_SCHED;
            PG8_STAGE(PG8_SB(0, 1), b2 + hstep, voffB);
            PG8_WAIT_V(6); PG8_BAR; PG8_MMA(1, 1, At, B1); PG8_BAR;
            PG8_LDB(B0, 1, 0); PG8_SCHED; PG8_LDA(At, 1, 0); PG8_STAGE(PG8_SA(0, 1), a2 + hstep, voffA);
            PG8_WAIT_L(8); PG8_BAR; PG8_WAIT_L(0); PG8_MMA(0, 0, At, B0); PG8_BAR; PG8_SCHED;
            PG8_LDB(B1, 1, 1); PG8_STAGE(PG8_SB(1, 0), b3, voffB);
            PG8_BAR; PG8_WAIT_L(0); PG8_MMA(0, 1, At, B1); PG8_BAR;
            PG8_LDA(At, 1, 1); PG8_STAGE(PG8_SA(1, 0), a3, voffA);
            PG8_BAR; PG8_WAIT_L(0); PG8_MMA(1, 0, At, B0); PG8_BAR; PG8_SCHED;
            PG8_STAGE(PG8_SB(1, 1), b3 + hstep, voffB);
            PG8_WAIT_V(6); PG8_BAR; PG8_MMA(1, 1, At, B1); PG8_BAR;
        }
        if (cur.kq < 0) E(acc, cur, wr, wc, fr, fq);
        if (!has_next) break;
#pragma unroll
        for (int a = 0; a < 2; ++a)
#pragma unroll
            for (int b = 0; b < 2; ++b)
#pragma unroll
                for (int m = 0; m < 4; ++m)
#pragma unroll
                    for (int n = 0; n < 2; ++n) acc[a][b][m][n] = (f32x4){0.f, 0.f, 0.f, 0.f};
        cur = nxt; cA = nA; cB = nB; ++ui;
    }
    PG8_WAIT_V(0);
    if (wr == 0) PG8_BAR;
    PG8_BAR;
    if constexpr (Epi::SPLIT) {
    if (cur.kq >= 0) {
        const __amdgpu_buffer_rsrc_t drs = __builtin_amdgcn_make_buffer_rsrc((void*)(g.dump + (size_t)cur.ti * 4 * (64 * 512)), 0, 4 * 64 * 512 * 8, 0x00020000);
        unsigned lo = (unsigned)tid * 16u;
        { const unsigned qo = (unsigned)cur.kq * (64 * 512 * 8);
#pragma unroll
          for (int a = 0; a < 2; ++a)
#pragma unroll
              for (int b = 0; b < 2; ++b)
#pragma unroll
                  for (int m = 0; m < 4; ++m)
#pragma unroll
                      for (int n = 0; n < 2; ++n) { asm volatile("" : "+v"(lo));
                          __builtin_amdgcn_raw_buffer_store_b128(__builtin_bit_cast(u32x4, acc[a][b][m][n]), drs, qo + (unsigned)((((a * 2 + b) * 4 + m) * 2 + n) * (512 * 16)) + lo, 0,   16); } }
        asm volatile("s_waitcnt vmcnt(0)" ::: "memory");
        __syncthreads();
        if (tid == 0) { __hip_atomic_fetch_add(g.cnt + 2 * cur.ti, 1u, __ATOMIC_RELAXED, __HIP_MEMORY_SCOPE_AGENT);
            unsigned spins = 0; while (__hip_atomic_load(g.cnt + 2 * cur.ti, __ATOMIC_RELAXED, __HIP_MEMORY_SCOPE_AGENT) < 4u) { __builtin_amdgcn_s_sleep(2); if (++spins > (1u << 22)) break; } }
        __syncthreads();
#pragma unroll
        for (int a = 0; a < 2; ++a)
#pragma unroll
            for (int m = 0; m < 4; ++m) { if (((a * 4 + m) >> 1) != cur.kq) continue;
                f32x4 v[2][2];
#pragma unroll
                for (int b = 0; b < 2; ++b)
#pragma unroll
                    for (int n = 0; n < 2; ++n) { asm volatile("" : "+v"(lo)); const unsigned o = (unsigned)((((a * 2 + b) * 4 + m) * 2 + n) * (512 * 16)) + lo;
                        const f32x4 p0 = __builtin_bit_cast(f32x4, __builtin_amdgcn_raw_buffer_load_b128(drs, o, 0, 16)), p1 = __builtin_bit_cast(f32x4, __builtin_amdgcn_raw_buffer_load_b128(drs, o + 64 * 512 * 8, 0, 16)),
                                    p2 = __builtin_bit_cast(f32x4, __builtin_amdgcn_raw_buffer_load_b128(drs, o + 2 * 64 * 512 * 8, 0, 16)), p3 = __builtin_bit_cast(f32x4, __builtin_amdgcn_raw_buffer_load_b128(drs, o + 3 * 64 * 512 * 8, 0, 16));
                        v[b][n] = (p0 + p1) + (p2 + p3); }
                E.rg(a, m, v, cur, wr, wc, fr, fq); }
        asm volatile("s_waitcnt vmcnt(0)" ::: "memory");
        __syncthreads();
        if (tid == 0) { const unsigned old = __hip_atomic_fetch_add(g.cnt + 2 * cur.ti + 1, 1u, __ATOMIC_RELAXED, __HIP_MEMORY_SCOPE_AGENT);
            if (old == 3u) { __hip_atomic_store(g.cnt + 2 * cur.ti, 0u, __ATOMIC_RELAXED, __HIP_MEMORY_SCOPE_AGENT); __hip_atomic_store(g.cnt + 2 * cur.ti + 1, 0u, __ATOMIC_RELAXED, __HIP_MEMORY_SCOPE_AGENT); } }
        __syncthreads();
    }
    }
#undef PG8_SA
#undef PG8_SB
#undef PG8_STAGE
#undef PG8_LDA
#undef PG8_LDB
#undef PG8_MMA
#undef PG8_WAIT_V
#undef PG8_WAIT_L
#undef PG8_BAR
#undef PG8_SCHED
}
}
using pg8::Unit;
typedef const f32x4 (&AccRef)[2][2][4][2];

__device__ __forceinline__ void st_bf16x4(bf16_t* p, f32x4 v) { u32x2 w; w.x = cvt_pk_bf16(v[0], v[1]); w.y = cvt_pk_bf16(v[2], v[3]); *(u32x2*)p = w; }
__device__ __forceinline__ void st_bf16x8(bf16_t* p, f32x4 a, f32x4 b) { u32x4 w; w.x = cvt_pk_bf16(a[0], a[1]); w.y = cvt_pk_bf16(a[2], a[3]); w.z = cvt_pk_bf16(b[0], b[1]); w.w = cvt_pk_bf16(b[2], b[3]); *(u32x4*)p = w; }
__device__ __forceinline__ bf16_t bf16_1(float v) { return (bf16_t)(cvt_pk_bf16(v, 0.f) & 0xffffu); }

struct EpiG1 {
    static constexpr bool SPLIT = false;
    __device__ __forceinline__ bool swapped(const Unit& u) const { return u.pn >= 16 && u.pn < 24; }
    bf16_t *aglu, *q, *k, *kt, *vt, *rg, *gate; const float *rcos, *rsin;
    __device__ __forceinline__ void operator()(AccRef acc, const Unit& u, int wr, int wc, int fr, int fq) const {
        const int pn = u.pn, row0 = u.pm * 256 + wr * 64 + fr, ct = wc * 32 + 8 * fq;
        if (pn < 8) {
#pragma unroll
            for (int ai = 0; ai < 2; ++ai)
#pragma unroll
                for (int m = 0; m < 4; ++m) { const int row = row0 + ai * 128 + m * 16; f32x4 o[2];
#pragma unroll
                    for (int n = 0; n < 2; ++n) { const f32x4 a = acc[ai][0][m][n], b = acc[ai][1][m][n];
#pragma unroll
                        for (int r = 0; r < 4; ++r) o[n][r] = a[r] * sigmoidf_(b[r]); }
                    st_bf16x8(aglu + (size_t)row * DM + pn * 128 + ct, o[0], o[1]); }
        } else if (pn < 16) {
            const bool isK = pn >= 12; const int h = (pn - 8) & 3; const float sc = isK ? 0.0625f : 1.0f; bf16_t* dst = isK ? k : q;
#pragma unroll
            for (int ai = 0; ai < 2; ++ai)
#pragma unroll
                for (int m = 0; m < 4; ++m) { const int row = row0 + ai * 128 + m * 16; const bool lat = row >= TC; const int pos = (row - TC) & 2047, gr = pos >> 6, gc = pos & 63; f32x4 o1[2], o2[2];
#pragma unroll
                    for (int n = 0; n < 2; ++n) { const int d1 = ct + n * 4; const f32x4 x1 = acc[ai][0][m][n] * sc, x2 = acc[ai][1][m][n] * sc; o1[n] = x1; o2[n] = x2;
                        if (lat) { const int ti = (d1 < 64) ? gr * 64 + d1 : gc * 64 + d1 - 64; const f32x4 cs = *(const f32x4*)(rcos + ti), sn = *(const f32x4*)(rsin + ti);
                            o1[n] = x1 * cs - x2 * sn; o2[n] = x2 * cs + x1 * sn; }
                        if (isK) {
#pragma unroll
                            for (int r = 0; r < 4; ++r) { kt[(size_t)(h * 256 + d1 + r) * TT + row] = bf16_1(o1[n][r]); kt[(size_t)(h * 256 + 128 + d1 + r) * TT + row] = bf16_1(o2[n][r]); } } }
                    st_bf16x8(dst + (size_t)row * DM + h * 256 + ct, o1[0], o1[1]); st_bf16x8(dst + (size_t)row * DM + h * 256 + 128 + ct, o2[0], o2[1]); }
        } else if (pn < 24) {
            const int e0 = (pn - 16) * 256 + wr * 64 + fr, t0 = u.pm * 256 + ct;
#pragma unroll
            for (int ai = 0; ai < 2; ++ai)
#pragma unroll
                for (int m = 0; m < 4; ++m) { bf16_t* vr = vt + (size_t)(e0 + ai * 128 + m * 16) * TT + t0;
#pragma unroll
                    for (int bj = 0; bj < 2; ++bj) st_bf16x8(vr + bj * 128, acc[ai][bj][m][0], acc[ai][bj][m][1]); }
        } else {
            const bool isG = pn >= 32; bf16_t* dst = isG ? gate : rg; const int cb = ((pn - 24) & 7) * 256;
#pragma unroll
            for (int ai = 0; ai < 2; ++ai)
#pragma unroll
                for (int m = 0; m < 4; ++m) { const int row = row0 + ai * 128 + m * 16;
#pragma unroll
                    for (int bj = 0; bj < 2; ++bj) { f32x4 o[2];
#pragma unroll
                        for (int n = 0; n < 2; ++n) { const f32x4 v = acc[ai][bj][m][n];
#pragma unroll
                            for (int r = 0; r < 4; ++r) { const float s = sigmoidf_(v[r]); o[n][r] = isG ? s : v[r] * s; } }
                        st_bf16x8(dst + (size_t)row * VW + cb + bj * 128 + ct, o[0], o[1]); } }
        }
    }
};

struct EpiE1 {
    static constexpr bool SPLIT = false;
    __device__ __forceinline__ bool swapped(const Unit&) const { return false; }
    bf16_t* m1; const bf16_t* gate;
    __device__ __forceinline__ void operator()(AccRef acc, const Unit& u, int wr, int wc, int fr, int fq) const {
        const int row0 = u.pm * 256 + wr * 64 + fr, col0 = u.pn * 256 + wc * 32 + 8 * fq;
#pragma unroll
        for (int ai = 0; ai < 2; ++ai)
#pragma unroll
            for (int m = 0; m < 4; ++m) { const int row = row0 + ai * 128 + m * 16;
#pragma unroll
                for (int bj = 0; bj < 2; ++bj) { const int col = col0 + bj * 128; const u32x4 gv = *(const u32x4*)(gate + (size_t)row * VW + col); const f32x4 v0 = acc[ai][bj][m][0], v1 = acc[ai][bj][m][1];
                    f32x4 o0, o1; o0[0] = v0[0] * bf_lo(gv.x); o0[1] = v0[1] * bf_hi(gv.x); o0[2] = v0[2] * bf_lo(gv.y); o0[3] = v0[3] * bf_hi(gv.y);
                    o1[0] = v1[0] * bf_lo(gv.z); o1[1] = v1[1] * bf_hi(gv.z); o1[2] = v1[2] * bf_lo(gv.w); o1[3] = v1[3] * bf_hi(gv.w);
                    st_bf16x8(m1 + (size_t)row * DM + col, o0, o1); } }
    }
};
struct EpiE2 {
    static constexpr bool SPLIT = true;
    __device__ __forceinline__ bool swapped(const Unit&) const { return false; }
    const bf16_t* m1; const bf16_t* gate; bf16_t* mm;
    __device__ __forceinline__ void rg(int ai, int m, const f32x4 (&v)[2][2], const Unit& u, int wr, int wc, int fr, int fq) const {
        const int row = u.pm * 256 + wr * 64 + fr + ai * 128 + m * 16, col0 = u.pn * 256 + wc * 32 + 8 * fq;
#pragma unroll
        for (int bj = 0; bj < 2; ++bj) { const int col = col0 + bj * 128; const u32x4 gv = *(const u32x4*)(gate + (size_t)row * VW + DM + col), mv = *(const u32x4*)(m1 + (size_t)row * DM + col); const f32x4 v0 = v[bj][0], v1 = v[bj][1];
            f32x4 o0, o1; o0[0] = bf_lo(mv.x) + v0[0] * bf_lo(gv.x); o0[1] = bf_hi(mv.x) + v0[1] * bf_hi(gv.x); o0[2] = bf_lo(mv.y) + v0[2] * bf_lo(gv.y); o0[3] = bf_hi(mv.y) + v0[3] * bf_hi(gv.y);
            o1[0] = bf_lo(mv.z) + v1[0] * bf_lo(gv.z); o1[1] = bf_hi(mv.z) + v1[1] * bf_hi(gv.z); o1[2] = bf_lo(mv.w) + v1[2] * bf_lo(gv.w); o1[3] = bf_hi(mv.w) + v1[3] * bf_hi(gv.w);
            st_bf16x8(mm + (size_t)row * DM + col, o0, o1); }
    }
    __device__ __forceinline__ void operator()(AccRef acc, const Unit& u, int wr, int wc, int fr, int fq) const {
#pragma unroll
        for (int a = 0; a < 2; ++a)
#pragma unroll
            for (int m = 0; m < 4; ++m) { const f32x4 v[2][2] = {{acc[a][0][m][0], acc[a][0][m][1]}, {acc[a][1][m][0], acc[a][1][m][1]}}; rg(a, m, v, u, wr, wc, fr, fq); }
    }
};
template <bool SPLIT_> struct EpiResT {
    static constexpr bool SPLIT = SPLIT_;
    __device__ __forceinline__ bool swapped(const Unit&) const { return false; }
    const float *xa, *xb; float* xout; const float* gvec;
    __device__ __forceinline__ void rg(int ai, int m, const f32x4 (&v)[2][2], const Unit& u, int wr, int wc, int fr, int fq) const {
        const int row = u.pm * 256 + wr * 64 + fr + ai * 128 + m * 16, col0 = u.pn * 256 + wc * 32 + 8 * fq;
        const float* xr = row < TC ? xa + (size_t)row * DM : xb + (size_t)(row - TC) * DM; const float* gr = gvec + row_group(row) * 6144;
#pragma unroll
        for (int bj = 0; bj < 2; ++bj)
#pragma unroll
            for (int n = 0; n < 2; ++n) { const int col = col0 + bj * 128 + n * 4; const f32x4 xv = *(const f32x4*)(xr + col), gv = *(const f32x4*)(gr + col);
                *(f32x4*)(xout + (size_t)row * DM + col) = xv + gv * v[bj][n]; }
    }
    __device__ __forceinline__ void operator()(AccRef acc, const Unit& u, int wr, int wc, int fr, int fq) const {
#pragma unroll
        for (int a = 0; a < 2; ++a)
#pragma unroll
            for (int m = 0; m < 4; ++m) { const f32x4 v[2][2] = {{acc[a][0][m][0], acc[a][0][m][1]}, {acc[a][1][m][0], acc[a][1][m][1]}}; rg(a, m, v, u, wr, wc, fr, fq); }
    }
};
struct EpiF1 {
    static constexpr bool SPLIT = false;
    __device__ __forceinline__ bool swapped(const Unit&) const { return false; }
    bf16_t* uo;
    __device__ __forceinline__ void operator()(AccRef acc, const Unit& u, int wr, int wc, int fr, int fq) const {
        const int row0 = u.pm * 256 + wr * 64 + fr, col0 = u.pn * 256 + wc * 32 + 8 * fq;
#pragma unroll
        for (int ai = 0; ai < 2; ++ai)
#pragma unroll
            for (int m = 0; m < 4; ++m) { const int row = row0 + ai * 128 + m * 16;
#pragma unroll
                for (int bj = 0; bj < 2; ++bj) { f32x4 o[2];
#pragma unroll
                    for (int n = 0; n < 2; ++n) { const f32x4 v = acc[ai][bj][m][n];
#pragma unroll
                        for (int r = 0; r < 4; ++r) { const float t = fmaxf(v[r], 0.f); o[n][r] = t * t; } }
                    st_bf16x8(uo + (size_t)row * MLPW + col0 + bj * 128, o[0], o[1]); } }
    }
};

__device__ __forceinline__ void tconv_item(const float* __restrict__ src, bf16_t* __restrict__ dst, int K, int N, int item, bool permIn, float* tile  ) {
    const int tilesN = N >> 8, kt = item / tilesN, ntile = item - kt * tilesN, k0 = kt * 64, n0 = ntile * 256, tid = tid_opaque();
    { const int r = tid >> 6, c4 = (tid & 63) * 4; f32x4 v[8];
#pragma unroll
      for (int rr = 0; rr < 8; ++rr) v[rr] = __builtin_nontemporal_load((const f32x4*)(src + (size_t)(k0 + r + rr * 8) * N + n0 + c4));
#pragma unroll
      for (int rr = 0; rr < 8; ++rr) { float* t = tile + (r + rr * 8) * 257 + c4; t[0] = v[rr][0]; t[1] = v[rr][1]; t[2] = v[rr][2]; t[3] = v[rr][3]; } }
    __syncthreads();
#pragma unroll
    for (int q = 0; q < 4; ++q) { const int n = q * 64 + (tid >> 3), k8 = (tid & 7) * 8; float v[8];
#pragma unroll
      for (int e = 0; e < 8; ++e) v[e] = tile[(k8 + e) * 257 + n];
      int nn = n0 + n;
      if (permIn && nn < 2048) { const int c = nn & 1023, half = nn >> 10; nn = (c >> 7) * 256 + half * 128 + (c & 127); }
      u32x4 w; w.x = cvt_pk_bf16(v[0], v[1]); w.y = cvt_pk_bf16(v[2], v[3]); w.z = cvt_pk_bf16(v[4], v[5]); w.w = cvt_pk_bf16(v[6], v[7]);
      *(u32x4*)(dst + (size_t)nn * K + k0 + k8) = w; }
    __syncthreads();
}

__device__ void phase0(const Params& p, unsigned char* smem) {
    float* tile = (float*)smem;
    float* scond = (float*)(smem + 66048);
    float* red = (float*)(smem + 66048 + 36864);
    const int tid = tid_opaque();
    constexpr int NT_L = 1408, NT = 2 * NT_L, NMOD = 192;
    for (int it = blockIdx.x; it < NT + NMOD + 1; it += gridDim.x) {
        if (it < NT) {
            const int l = it / NT_L; int j = it - l * NT_L; unsigned char* wb = p.ws + WS_W + (size_t)l * WL_SZ;
            if (j < 640) tconv_item(p.in[9] + (size_t)l * DM * PW, (bf16_t*)(wb + WL_IN), DM, PW, j, true, tile);
            else if ((j -= 640) < 64) tconv_item(p.in[13] + (size_t)l * DM * DM, (bf16_t*)(wb + WL_CONV), DM, DM, j, false, tile);
            else if ((j -= 64) < 128) tconv_item(p.in[15] + (size_t)l * VW * DM, (bf16_t*)(wb + WL_RET), VW, DM, j, false, tile);
            else if ((j -= 128) < 64) tconv_item(p.in[16] + (size_t)l * DM * DM, (bf16_t*)(wb + WL_OUT), DM, DM, j, false, tile);
            else if ((j -= 64) < 256) tconv_item(p.in[17] + (size_t)l * DM * MLPW, (bf16_t*)(wb + WL_M1), DM, MLPW, j, false, tile);
            else { j -= 256; tconv_item(p.in[18] + (size_t)l * MLPW * DM, (bf16_t*)(wb + WL_M2), MLPW, DM, j, false, tile); }
        } else if (it < NT + NMOD) {
            const int j = it - NT, l = j / 96, c0 = (j % 96) * 64;
            for (int idx = tid; idx < 9 * 1024; idx += NTHR) { const int g = idx >> 10, k = idx & 1023; const float v = g == 0 ? p.in[4][k] : p.in[2][(g - 1) * 1024 + k]; scond[idx] = siluf_(v); }
            __syncthreads();
            const int col = tid & 63, kg = tid >> 6; float a[9];
#pragma unroll
            for (int g = 0; g < 9; ++g) a[g] = 0.f;
            const float* wm = p.in[7] + (size_t)l * DM * 6144 + c0 + col;
#pragma unroll 16
            for (int k = kg * 128; k < kg * 128 + 128; ++k) { const float w = __builtin_nontemporal_load(wm + (size_t)k * 6144);
#pragma unroll
                for (int g = 0; g < 9; ++g) a[g] += scond[g * 1024 + k] * w; }
#pragma unroll
            for (int g = 0; g < 9; ++g) red[(kg * 9 + g) * 64 + col] = a[g];
            __syncthreads();
            for (int o = tid; o < 9 * 64; o += NTHR) { const int g = o >> 6, cc = o & 63; float s = 0.f;
#pragma unroll
                for (int q = 0; q < 8; ++q) s += red[(q * 9 + g) * 64 + cc];
                ((float*)(p.ws + WS_MOD))[(size_t)(l * 9 + g) * 6144 + c0 + cc] = s + p.in[8][l * 6144 + c0 + cc]; }
            __syncthreads();
        } else {
            float* rc = (float*)(p.ws + WS_ROPE); float* rs = rc + 4096;
            if (tid < 128) ((unsigned*)(p.ws + WS_CNT))[tid] = 0u;
            for (int idx = tid; idx < 4096; idx += NTHR) { const int pos = idx >> 6, i = idx & 63; const float inv = exp2f(-(float)i * (13.287712379549449f / 64.f)); const float ang = (float)pos * inv;
                rc[idx] = __cosf(ang); rs[idx] = __sinf(ang); }
        }
    }
}

__device__ void norm_mod_phase(const float* xa, const float* xb, bf16_t* dst, const float* ng, const float* modl, int sh_chunk) {
    const int tid = tid_opaque(), lane = tid & 63, gw = blockIdx.x * 8 + (tid >> 6), nw = gridDim.x * 8;
    for (int row0 = gw; row0 < TT; row0 += 2 * nw) {
        f32x4 v[2][4]; float ss[2];
#pragma unroll
        for (int q = 0; q < 2; ++q) { const int row = min(row0 + q * nw, TT - 1); const float* xr = row < TC ? xa + (size_t)row * DM : xb + (size_t)(row - TC) * DM;
#pragma unroll
            for (int i = 0; i < 4; ++i) v[q][i] = __builtin_nontemporal_load((const f32x4*)(xr + i * 256 + lane * 4)); }
#pragma unroll
        for (int q = 0; q < 2; ++q) { float s = 0.f;
#pragma unroll
            for (int i = 0; i < 4; ++i) s += v[q][i][0] * v[q][i][0] + v[q][i][1] * v[q][i][1] + v[q][i][2] * v[q][i][2] + v[q][i][3] * v[q][i][3];
            ss[q] = s; }
#pragma unroll
        for (int q = 0; q < 2; ++q) { const int row = row0 + q * nw; if (row >= TT) break;
            const float rstd = rsqrtf(wave_sum(ss[q]) * (1.f / DM) + EPSV); const float* md = modl + row_group(row) * 6144;
#pragma unroll
            for (int i = 0; i < 4; ++i) { const int c = i * 256 + lane * 4; const f32x4 g = *(const f32x4*)(ng + c), sh = *(const f32x4*)(md + sh_chunk * 1024 + c), sc = *(const f32x4*)(md + (sh_chunk + 1) * 1024 + c);
                const f32x4 o = v[q][i] * rstd * g * (sc + 1.f) + sh; st_bf16x4(dst + (size_t)row * DM + c, o); } }
    }
}
__device__ void final_norm_phase(float* x, const float* ng) {
    const int tid = tid_opaque(), lane = tid & 63, gw = blockIdx.x * 8 + (tid >> 6), nw = gridDim.x * 8;
    for (int row = gw; row < TT; row += nw) {
        float* xr = x + (size_t)row * DM; f32x4 v[4]; float ss = 0.f;
#pragma unroll
        for (int i = 0; i < 4; ++i) { v[i] = __builtin_nontemporal_load((const f32x4*)(xr + i * 256 + lane * 4)); ss += v[i][0] * v[i][0] + v[i][1] * v[i][1] + v[i][2] * v[i][2] + v[i][3] * v[i][3]; }
        ss = wave_sum(ss); const float rstd = rsqrtf(ss * (1.f / DM) + EPSV);
#pragma unroll
        for (int i = 0; i < 4; ++i) { const int c = i * 256 + lane * 4; const f32x4 g = *(const f32x4*)(ng + c); __builtin_nontemporal_store(v[i] * rstd * g, (f32x4*)(xr + c)); }
    }
}

__device__ void conv_phase(const Params& p, int l, unsigned char* smem) {
    const int tid = tid_opaque(), lane = tid & 63, wv = tid >> 6;
    const bf16_t* aglu = (const bf16_t*)(p.ws + WS_R2); bf16_t* aconv = (bf16_t*)(p.ws + WS_R1);
    float* red = (float*)(smem + 46 * 2048);
    float* rst = red + 128;
    const int c0 = 2 * tid;
    float w0[31], w1[31];
#pragma unroll
    for (int j = 0; j < 31; ++j) { const f32x2 wv2 = *(const f32x2*)(p.in[10] + (size_t)(l * 31 + j) * DM + c0); w0[j] = wv2.x; w1[j] = wv2.y; }
    const f32x2 bias = *(const f32x2*)(p.in[11] + l * DM + c0), gn = *(const f32x2*)(p.in[12] + l * DM + c0);
    for (int it = blockIdx.x; it < TT / 16; it += gridDim.x) {
        const int t0 = it * 16, segl = t0 < TC ? 256 : 64, ss = t0 & ~(segl - 1), se = ss + segl;
        for (int idx = tid; idx < 46 * 128; idx += NTHR) { const int rr = idx >> 7, ch = idx & 127, tt = t0 - 15 + rr; u32x4 v = (u32x4){0u, 0u, 0u, 0u};
            if (tt >= ss && tt < se) v = *(const u32x4*)(aglu + (size_t)tt * DM + ch * 8);
            *(u32x4*)(smem + rr * 2048 + ch * 16) = v; }
        __syncthreads();
        float a0[16], a1[16];
#pragma unroll
        for (int t = 0; t < 16; ++t) { a0[t] = bias.x; a1[t] = bias.y; }
#pragma unroll
        for (int rr = 0; rr < 46; ++rr) { const unsigned uv = *(const unsigned*)(smem + rr * 2048 + c0 * 2); const float lo = bf_lo(uv), hi = bf_hi(uv);
#pragma unroll
            for (int t = 0; t < 16; ++t) { const int j = rr - t; if (j >= 0 && j < 31) { a0[t] += w0[j] * lo; a1[t] += w1[j] * hi; } } }
#pragma unroll
        for (int t = 0; t < 16; ++t) { const float s = wave_sum(a0[t] * a0[t] + a1[t] * a1[t]); if (lane == 0) red[wv * 16 + t] = s; }
        __syncthreads();
        if (tid < 16) { float s = 0.f;
#pragma unroll
            for (int q = 0; q < 8; ++q) s += red[q * 16 + tid];
            rst[tid] = rsqrtf(s * (1.f / DM) + EPSV); }
        __syncthreads();
#pragma unroll
        for (int t = 0; t < 16; ++t) { const float r = rst[t]; *(unsigned*)(aconv + (size_t)(t0 + t) * DM + c0) = cvt_pk_bf16(siluf_(a0[t] * r * gn.x), siluf_(a1[t] * r * gn.y)); }
        __syncthreads();
    }
}

__device__ void ret_phase(const Params& p, int l, unsigned char* smem) {
    LAS unsigned char* lds = (LAS unsigned char*)smem;
    const int tid = tid_opaque(), lane = tid & 63, w = __builtin_amdgcn_readfirstlane(tid >> 6), fr = lane & 15, fq = lane >> 4;
    const bf16_t* Qg = (const bf16_t*)(p.ws + WS_Q); const bf16_t* Kg = (const bf16_t*)(p.ws + WS_K); const bf16_t* KTg = (const bf16_t*)(p.ws + WS_KT); const bf16_t* VTg = (const bf16_t*)(p.ws + WS_VT);
    constexpr int QOFF = 0, KTOFF = 65536;
    const unsigned voffQ = (unsigned)(((2 * w + (lane >> 5)) * DM + (((lane & 31) ^ ((2 * w + (lane >> 5)) & 15))) * 8) * 2);
    const unsigned voffKT = (unsigned)(((4 * w + (lane >> 4)) * TT + (((lane & 15) ^ ((((2 * w + (lane >> 5)) & 12)) | ((lane >> 4) & 3)))) * 8) * 2);
    const unsigned voffK = (unsigned)(((16 * w + fr) * DM + fq * 8) * 2);
    const unsigned voffV = (unsigned)(((16 * w + fr) * TT + fq * 8) * 2);
    const unsigned voffY = (unsigned)(((4 * fq) * VW + 16 * w + fr) * 2);
    int xb[4];
#pragma unroll
    for (int k4 = 0; k4 < 4; ++k4) xb[k4] = ((k4 * 4 + fq) ^ fr) * 16;
    for (int it = blockIdx.x; it < 768; it += gridDim.x) {
        int es, dir, h, bb, tok0, nch; const bool lat = it < 256;
        { const int j = lat ? it : it - 256, x = j & 7, y = j >> 3; es = y & 3; const int cmb = (y >> 2) * 8 + x; dir = cmb & 1; h = (cmb >> 1) & 3; bb = cmb >> 3;
          tok0 = lat ? TC + bb * 2048 : bb * 256; nch = lat ? 16 : 2; }
        const float dl = p.in[14][l * 8 + dir * 4 + h]; const float lg2 = -log1pf(expf(-dl)) * 1.4426950408889634f;
        const float sdec = exp2f(128.f * lg2);
        const float zl = dir ? -lg2 : lg2, zb2 = (float)(dir ? 128 - 4 * fq : 4 * fq + 1) * lg2, kb2 = (float)(dir ? 8 * fq : 127 - 8 * fq) * lg2;
        const int pbase = dir ? (16 * w + 4 * fq - fr) : (fr - 16 * w - 4 * fq);
        f32x4 S[16];
        const unsigned voffS = (unsigned)((8 * fq * 512 + 16 * w + fr) * 4);
        if (lat) { const float* sp = p.in[3] + ((((size_t)bb * 2 + l) * 2 + dir) * 4 + h) * 256 * 512 + es * 128;
#pragma unroll
            for (int D = 0; D < 16; ++D)
#pragma unroll
                for (int r = 0; r < 4; ++r) S[D][r] = __builtin_nontemporal_load((const float*)((const char*)(sp + ((D >> 1) * 32 + 4 * (D & 1) + r) * 512) + voffS));
        } else {
#pragma unroll
            for (int D = 0; D < 16; ++D) S[D] = (f32x4){0.f, 0.f, 0.f, 0.f};
        }
        bf16_t* Yg = (bf16_t*)(p.ws + (dir ? WS_YB : WS_YF));
        for (int s = 0; s < nch; ++s) {
            const int c = dir ? nch - 1 - s : s, r0 = tok0 + c * 128;
            { const bf16_t* qu = Qg + (size_t)r0 * DM + h * 256; const bf16_t* ku = KTg + (size_t)(h * 256) * TT + r0;
#pragma unroll
              for (int n = 0; n < 8; ++n) {
                  __builtin_amdgcn_global_load_lds((const unsigned*)((const char*)(qu + (size_t)(n * 16) * DM) + voffQ), (LAS unsigned*)(lds + QOFF + (n * 8 + w) * 1024), 16, 0, 0);
                  __builtin_amdgcn_global_load_lds((const unsigned*)((const char*)(ku + (size_t)(n * 32) * TT) + voffKT), (LAS unsigned*)(lds + KTOFF + (n * 8 + w) * 1024), 16, 0, 0); } }
            bf16x8 Kf[8], Vf[4];
            { const char* kb = (const char*)(Kg + (size_t)r0 * DM + h * 256) + voffK;
#pragma unroll
              for (int ks = 0; ks < 4; ++ks) Kf[ks] = *(const bf16x8*)(kb + ks * 64); }
            asm volatile("s_waitcnt vmcnt(0)" ::: "memory");
            __syncthreads();
            { const char* kb = (const char*)(Kg + (size_t)r0 * DM + h * 256) + voffK;
#pragma unroll
              for (int ks = 4; ks < 8; ++ks) Kf[ks] = *(const bf16x8*)(kb + ks * 64); }
            f32x4 Z[8], PT[8];
#pragma unroll
            for (int i8 = 0; i8 < 8; ++i8) { Z[i8] = (f32x4){0.f, 0.f, 0.f, 0.f}; PT[i8] = (f32x4){0.f, 0.f, 0.f, 0.f}; }
#define QFRAG(ks, i8) (*(const LAS bf16x8*)(lds + QOFF + xb[(ks) & 3] + fr * 512 + (i8) * 8192 + ((ks) >> 2) * 256))
            { bf16x8 qa[4], qb[4];
#pragma unroll
              for (int j = 0; j < 4; ++j) qa[j] = QFRAG(0, j);
#pragma unroll
              for (int ks = 0; ks < 8; ++ks) { u32x4 t; t.x = cvt_pk_bf16(S[2 * ks][0], S[2 * ks][1]); t.y = cvt_pk_bf16(S[2 * ks][2], S[2 * ks][3]); t.z = cvt_pk_bf16(S[2 * ks + 1][0], S[2 * ks + 1][1]); t.w = cvt_pk_bf16(S[2 * ks + 1][2], S[2 * ks + 1][3]);
                  const bf16x8 Sb = __builtin_bit_cast(bf16x8, t);
#pragma unroll
                  for (int j = 0; j < 4; ++j) qb[j] = QFRAG(ks, 4 + j);
                  __builtin_amdgcn_sched_barrier(0);
#pragma unroll
                  for (int j = 0; j < 4; ++j) { Z[j] = __builtin_amdgcn_mfma_f32_16x16x32_bf16(qa[j], Sb, Z[j], 0, 0, 0); PT[j] = __builtin_amdgcn_mfma_f32_16x16x32_bf16(Kf[ks], qa[j], PT[j], 0, 0, 0); }
                  __builtin_amdgcn_sched_barrier(0);
                  if (ks < 7) {
#pragma unroll
                      for (int j = 0; j < 4; ++j) qa[j] = QFRAG(ks + 1, j); }
                  __builtin_amdgcn_sched_barrier(0);
#pragma unroll
                  for (int j = 0; j < 4; ++j) { Z[4 + j] = __builtin_amdgcn_mfma_f32_16x16x32_bf16(qb[j], Sb, Z[4 + j], 0, 0, 0); PT[4 + j] = __builtin_amdgcn_mfma_f32_16x16x32_bf16(Kf[ks], qb[j], PT[4 + j], 0, 0, 0); }
                  __builtin_amdgcn_sched_barrier(0); } }
#undef QFRAG
            { const char* vb = (const char*)(VTg + (size_t)(h * 512 + es * 128) * TT + r0) + voffV;
#pragma unroll
              for (int ks = 0; ks < 4; ++ks) Vf[ks] = *(const bf16x8*)(vb + ks * 64); }
            float zb2_ = zb2, zl_ = zl, kb2_ = kb2; int pbase_ = pbase;
            asm volatile("" : "+v"(zb2_), "+v"(zl_), "+v"(kb2_), "+v"(pbase_));
            { f32x4 zf, pf; const float z16 = __builtin_amdgcn_exp2f(16.f * zl_);
#pragma unroll
              for (int r = 0; r < 4; ++r) { zf[r] = __builtin_amdgcn_exp2f(zb2_ + (float)r * zl_); pf[r] = __builtin_amdgcn_exp2f((float)(pbase_ + (dir ? r : -r)) * lg2); }
#pragma unroll
              for (int i8 = 0; i8 < 8; ++i8) {
#pragma unroll
                  for (int r = 0; r < 4; ++r) { Z[i8][r] *= zf[r];
                      const int df = pbase_ + (dir ? -(i8 * 16 - r) : (i8 * 16 - r)); PT[i8][r] = df >= 0 ? PT[i8][r] * pf[r] : 0.f; }
                  zf *= z16; pf *= z16; } }
            __syncthreads();
#pragma unroll
            for (int i8 = 0; i8 < 8; ++i8) { const int i = i8 * 16 + fr; u32x2 t; t.x = cvt_pk_bf16(PT[i8][0], PT[i8][1]); t.y = cvt_pk_bf16(PT[i8][2], PT[i8][3]);
                *(LAS u32x2*)(lds + QOFF + i * 256 + (((2 * w + (fq >> 1)) ^ fr)) * 16 + (fq & 1) * 8) = t; }
            __syncthreads();
#define PFRAG(i8, ks) (*(const LAS bf16x8*)(lds + QOFF + xb[ks] + fr * 256 + (i8) * 4096))
            { bf16x8 pa[4], pb[4];
#pragma unroll
              for (int ks = 0; ks < 4; ++ks) pa[ks] = PFRAG(0, ks);
#pragma unroll
              for (int i8 = 0; i8 < 8; i8 += 2) {
#pragma unroll
                  for (int ks = 0; ks < 4; ++ks) pb[ks] = PFRAG(i8 + 1, ks);
                  __builtin_amdgcn_sched_barrier(0);
#pragma unroll
                  for (int ks = 0; ks < 4; ++ks) Z[i8] = __builtin_amdgcn_mfma_f32_16x16x32_bf16(pa[ks], Vf[ks], Z[i8], 0, 0, 0);
                  __builtin_amdgcn_sched_barrier(0);
                  if (i8 < 6) {
#pragma unroll
                      for (int ks = 0; ks < 4; ++ks) pa[ks] = PFRAG(i8 + 2, ks); }
                  __builtin_amdgcn_sched_barrier(0);
#pragma unroll
                  for (int ks = 0; ks < 4; ++ks) Z[i8 + 1] = __builtin_amdgcn_mfma_f32_16x16x32_bf16(pb[ks], Vf[ks], Z[i8 + 1], 0, 0, 0);
                  __builtin_amdgcn_sched_barrier(0); } }
#undef PFRAG
#pragma unroll
            for (int i8 = 0; i8 < 8; ++i8)
#pragma unroll
                for (int r = 0; r < 4; ++r) *(bf16_t*)((char*)(Yg + (size_t)(r0 + i8 * 16 + r) * VW + h * 512 + es * 128) + voffY) = bf16_1(Z[i8][r]);
            bf16x8 Vs[4];
            float kf8[8], kstep[4];
#pragma unroll
            for (int e = 0; e < 8; ++e) kf8[e] = __builtin_amdgcn_exp2f(kb2_ - (float)e * zl_);
            { const float k32 = __builtin_amdgcn_exp2f(-32.f * zl_); kstep[0] = 1.f; kstep[1] = k32; kstep[2] = k32 * k32; kstep[3] = kstep[2] * k32; }
#pragma unroll
            for (int ks = 0; ks < 4; ++ks) { const u32x4 t = __builtin_bit_cast(u32x4, Vf[ks]); float f[8]; f[0] = bf_lo(t.x); f[1] = bf_hi(t.x); f[2] = bf_lo(t.y); f[3] = bf_hi(t.y); f[4] = bf_lo(t.z); f[5] = bf_hi(t.z); f[6] = bf_lo(t.w); f[7] = bf_hi(t.w);
#pragma unroll
                for (int e = 0; e < 8; ++e) f[e] *= kf8[e] * kstep[ks];
                u32x4 o; o.x = cvt_pk_bf16(f[0], f[1]); o.y = cvt_pk_bf16(f[2], f[3]); o.z = cvt_pk_bf16(f[4], f[5]); o.w = cvt_pk_bf16(f[6], f[7]); Vs[ks] = __builtin_bit_cast(bf16x8, o); }
#define TFRAG(D, ks) (*(const LAS bf16x8*)(lds + KTOFF + xb[ks] + (8 * (fr >> 2) + (fr & 3)) * 256 + ((D) >> 1) * 8192 + ((D) & 1) * 1024))
            { bf16x8 ta[4], tb[4];
#pragma unroll
              for (int ks = 0; ks < 4; ++ks) ta[ks] = TFRAG(0, ks);
#pragma unroll
              for (int D = 0; D < 16; D += 2) { S[D] *= sdec; S[D + 1] *= sdec;
#pragma unroll
                  for (int ks = 0; ks < 4; ++ks) tb[ks] = TFRAG(D + 1, ks);
                  __builtin_amdgcn_sched_barrier(0);
#pragma unroll
                  for (int ks = 0; ks < 4; ++ks) S[D] = __builtin_amdgcn_mfma_f32_16x16x32_bf16(ta[ks], Vs[ks], S[D], 0, 0, 0);
                  __builtin_amdgcn_sched_barrier(0);
                  if (D < 14) {
#pragma unroll
                      for (int ks = 0; ks < 4; ++ks) ta[ks] = TFRAG(D + 2, ks); }
                  __builtin_amdgcn_sched_barrier(0);
#pragma unroll
                  for (int ks = 0; ks < 4; ++ks) S[D + 1] = __builtin_amdgcn_mfma_f32_16x16x32_bf16(tb[ks], Vs[ks], S[D + 1], 0, 0, 0);
                  __builtin_amdgcn_sched_barrier(0); } }
#undef TFRAG
            __syncthreads();
        }
        if (!lat) { float* so = p.out + (size_t)TT * DM + ((((size_t)bb * 2 + l) * 2 + dir) * 4 + h) * 256 * 512 + es * 128;
#pragma unroll
            for (int D = 0; D < 16; ++D)
#pragma unroll
                for (int r = 0; r < 4; ++r) __builtin_nontemporal_store(S[D][r], (float*)((char*)(so + ((D >> 1) * 32 + 4 * (D & 1) + r) * 512) + voffS)); }
    }
}

__device__ void comb_phase(const Params& p) {
    const int tid = tid_opaque(), lane = tid & 63, gw = blockIdx.x * 8 + (tid >> 6), nw = gridDim.x * 8;
    const bf16_t* yf = (const bf16_t*)(p.ws + WS_YF); const bf16_t* yb = (const bf16_t*)(p.ws + WS_YB); const bf16_t* rg = (const bf16_t*)(p.ws + WS_RG); bf16_t* ar = (bf16_t*)(p.ws + WS_Q);
    for (int tok = gw; tok < TT; tok += nw) {
        u32x4 a[4], b[4], g[4];
#pragma unroll
        for (int h = 0; h < 4; ++h) { const size_t off = (size_t)tok * VW + h * 512 + lane * 8; a[h] = __builtin_nontemporal_load((const u32x4*)(yf + off)); b[h] = __builtin_nontemporal_load((const u32x4*)(yb + off)); g[h] = __builtin_nontemporal_load((const u32x4*)(rg + off)); }
#pragma unroll
        for (int h = 0; h < 4; ++h) {
            float y[8];
#pragma unroll
            for (int e = 0; e < 4; ++e) { y[2 * e] = bf_lo(a[h][e]) + bf_lo(b[h][e]); y[2 * e + 1] = bf_hi(a[h][e]) + bf_hi(b[h][e]); }
            float s = 0.f;
#pragma unroll
            for (int e = 0; e < 8; ++e) s += y[e];
            const float mu = wave_sum(s) * (1.f / 512.f); float v = 0.f;
#pragma unroll
            for (int e = 0; e < 8; ++e) { y[e] -= mu; v += y[e] * y[e]; }
            const float rstd = rsqrtf(wave_sum(v) * (1.f / 512.f) + EPSV);
            u32x4 o;
#pragma unroll
            for (int e = 0; e < 4; ++e) o[e] = cvt_pk_bf16(y[2 * e] * rstd * bf_lo(g[h][e]), y[2 * e + 1] * rstd * bf_hi(g[h][e]));
            *(u32x4*)(ar + (size_t)tok * VW + h * 512 + lane * 8) = o;
        }
    }
}


#define XB_TMO      128
#define XB_XCNT(j)  (256  + 64 * (j))
#define XB_XSUB(j)  (1280 + 64 * (j))
#define XB_XGEN(j)  (2304 + 64 * (j))
#define XB_TOP      3328
#define XB_TOPGEN   3392
#define XCD_BAR_WORDS 3456
#define XB_SPIN_CAP (1u << 18)
__device__ __forceinline__ unsigned xb_ld(unsigned* p)              { return __hip_atomic_load(p, __ATOMIC_RELAXED, __HIP_MEMORY_SCOPE_AGENT); }
__device__ __forceinline__ unsigned xb_add(unsigned* p, unsigned v) { return __hip_atomic_fetch_add(p, v, __ATOMIC_RELAXED, __HIP_MEMORY_SCOPE_AGENT); }
__device__ __forceinline__ unsigned xb_xcc_id() { return (unsigned)__builtin_amdgcn_s_getreg((3 << 11) | 20) & 0xFu; }
#define XB_SPIN(cond, bar) do { unsigned _sp = 0; while (cond) { __builtin_amdgcn_s_sleep(1); \
    if ((++_sp & 255u) == 0u) { if (xb_ld(&(bar)[XB_TMO])) break; if (_sp > XB_SPIN_CAP) { atomicAdd(&(bar)[XB_TMO], 1u); break; } } } } while (0)
struct XcdBarrier { unsigned* bar; unsigned x; volatile LAS unsigned* st; };
__device__ __forceinline__ XcdBarrier xcd_barrier_post(unsigned* bar, volatile LAS unsigned* st) {
    XcdBarrier b; b.bar = bar; b.x = xb_xcc_id(); b.st = st;
    if (threadIdx.x == 0) (void)xb_add(&bar[XB_XCNT(b.x)], 1u);
    return b;
}
__device__ __forceinline__ void xcd_barrier_complete(unsigned* bar, unsigned x, unsigned& nloc, unsigned& nx) {
    const unsigned G = gridDim.x * gridDim.y * gridDim.z;
    unsigned sum, cnt, mine, sp = 0u;
    for (;;) {
        sum = 0u; cnt = 0u; mine = 0u;
#pragma unroll
        for (unsigned j = 0; j < 16; ++j) { const unsigned c = xb_ld(&bar[XB_XCNT(j)]); sum += c; cnt += (c > 0u) ? 1u : 0u; mine = (j == x) ? c : mine; }
        if (sum == G) break;
        __builtin_amdgcn_s_sleep(1);
        if ((++sp & 255u) == 0u) { if (xb_ld(&bar[XB_TMO])) break; if (sp > XB_SPIN_CAP) { atomicAdd(&bar[XB_TMO], 1u); break; } }
    }
    nloc = mine > 0u ? mine : 1u; nx = cnt > 0u ? cnt : 1u;
}
__device__ __forceinline__ void xcd_barrier(const XcdBarrier& b) {
    asm volatile("s_waitcnt vmcnt(0)" ::: "memory");
    __syncthreads();
    if (threadIdx.x == 0) {
        unsigned* bar = b.bar;
        __builtin_amdgcn_s_waitcnt(0);
        unsigned nloc = b.st[0], nx = b.st[1];
        if (nloc == 0u) { xcd_barrier_complete(bar, b.x, nloc, nx); b.st[0] = nloc; b.st[1] = nx; }
        const unsigned old = xb_add(&bar[XB_XSUB(b.x)], 1u);
        const unsigned gen = old / nloc;
        if (old + 1u == (gen + 1u) * nloc) {
            __builtin_amdgcn_fence(__ATOMIC_RELEASE, "agent");
            asm volatile("s_waitcnt vmcnt(0)" ::: "memory");
            const unsigned og = xb_add(&bar[XB_TOP], 1u);
            const unsigned tg = og / nx;
            if (og + 1u == (tg + 1u) * nx) xb_add(&bar[XB_TOPGEN], 1u);
            else XB_SPIN(xb_ld(&bar[XB_TOPGEN]) == tg, bar);
            __builtin_amdgcn_fence(__ATOMIC_ACQUIRE, "agent");
            xb_add(&bar[XB_XGEN(b.x)], 1u);
            asm volatile("s_waitcnt vmcnt(0)" ::: "memory");
        } else {
            XB_SPIN(xb_ld(&bar[XB_XGEN(b.x)]) == gen, bar);
            __builtin_amdgcn_fence(__ATOMIC_ACQUIRE, "agent");
            asm volatile("s_waitcnt vmcnt(0)" ::: "memory");
        }
    }
    __syncthreads();
}

__global__ void __launch_bounds__(NTHR) mega(Params p) {
    __shared__ __attribute__((aligned(16))) unsigned char smem[131072];
    cg::grid_group grid = cg::this_grid();
    LAS unsigned char* lds = (LAS unsigned char*)smem;
    unsigned char* ws = p.ws;
    float* xbuf = p.out;
    const float* modb = (const float*)(ws + WS_MOD);
    pg8::StaticOrder so;
    __shared__ __attribute__((aligned(16))) unsigned xb_st[4];
    if (threadIdx.x < 4) xb_st[threadIdx.x] = 0u;
    __syncthreads();
    if (blockIdx.x == 1) { const int t = tid_opaque(); for (int i = t; i < XCD_BAR_WORDS; i += NTHR) ((unsigned*)(ws + WS_BAR))[i] = 0u; }
    phase0(p, smem);
    grid.sync();
    const XcdBarrier xbar = xcd_barrier_post((unsigned*)(ws + WS_BAR), (volatile LAS unsigned*)xb_st);
    for (int l = 0; l < 2; ++l) {
        const unsigned char* wl = ws + WS_W + (size_t)l * WL_SZ;
        const float* modl = modb + (size_t)l * 9 * 6144;
        const float* xa = l == 0 ? p.in[0] : xbuf; const float* xb = l == 0 ? p.in[1] : xbuf + (size_t)TC * DM;
        norm_mod_phase(xa, xb, (bf16_t*)(ws + WS_R1), p.in[5] + l * DM, modl, 0);
        xcd_barrier(xbar);
        { pg8::Gemm g{(const bf16_t*)(ws + WS_R1), (const bf16_t*)(wl + WL_IN), TT, PW, DM, nullptr, nullptr}; so.init(TT, PW, gridDim.x, blockIdx.x);
          EpiG1 e{(bf16_t*)(ws + WS_R2), (bf16_t*)(ws + WS_Q), (bf16_t*)(ws + WS_K), (bf16_t*)(ws + WS_KT), (bf16_t*)(ws + WS_VT), (bf16_t*)(ws + WS_RG), (bf16_t*)(ws + WS_GATE), (const float*)(ws + WS_ROPE), (const float*)(ws + WS_ROPE) + 4096};
          pg8::gemm_phase(lds, g, so, e); }
        xcd_barrier(xbar);
        ret_phase(p, l, smem);
        conv_phase(p, l, smem);
        xcd_barrier(xbar);
        { pg8::Gemm g{(const bf16_t*)(ws + WS_R1), (const bf16_t*)(wl + WL_CONV), TT, DM, DM, nullptr, nullptr}; so.init(TT, DM, gridDim.x, blockIdx.x);
          EpiE1 e{(bf16_t*)(ws + WS_KT), (const bf16_t*)(ws + WS_GATE)};
          comb_phase(p);
          __syncthreads();
          pg8::gemm_phase(lds, g, so, e); }
        xcd_barrier(xbar);
        { pg8::Gemm g{(const bf16_t*)(ws + WS_Q), (const bf16_t*)(wl + WL_RET), TT, DM, VW, (unsigned long long*)(ws + WS_DUMP), (unsigned*)(ws + WS_CNT)}; so.init(TT, DM, gridDim.x, blockIdx.x, true);
          EpiE2 e{(const bf16_t*)(ws + WS_KT), (const bf16_t*)(ws + WS_GATE), (bf16_t*)(ws + WS_R2)};
          pg8::gemm_phase(lds, g, so, e); }
        xcd_barrier(xbar);
        { pg8::Gemm g{(const bf16_t*)(ws + WS_R2), (const bf16_t*)(wl + WL_OUT), TT, DM, DM, nullptr, nullptr}; so.init(TT, DM, gridDim.x, blockIdx.x);
          EpiResT<false> e{xa, xb, xbuf, modl + 2 * 1024};
          pg8::gemm_phase(lds, g, so, e); }
        xcd_barrier(xbar);
        norm_mod_phase(xbuf, xbuf + (size_t)TC * DM, (bf16_t*)(ws + WS_R1), p.in[6] + l * DM, modl, 3);
        xcd_barrier(xbar);
        { pg8::Gemm g{(const bf16_t*)(ws + WS_R1), (const bf16_t*)(wl + WL_M1), TT, MLPW, DM, nullptr, nullptr}; so.init(TT, MLPW, gridDim.x, blockIdx.x);
          EpiF1 e{(bf16_t*)(ws + WS_RG)};
          pg8::gemm_phase(lds, g, so, e); }
        xcd_barrier(xbar);
        { pg8::Gemm g{(const bf16_t*)(ws + WS_RG), (const bf16_t*)(wl + WL_M2), TT, DM, MLPW, (unsigned long long*)(ws + WS_DUMP), (unsigned*)(ws + WS_CNT)}; so.init(TT, DM, gridDim.x, blockIdx.x, true);
          EpiResT<true> e{xbuf, xbuf + (size_t)TC * DM, xbuf, modl + 5 * 1024};
          pg8::gemm_phase(lds, g, so, e); }
        xcd_barrier(xbar);
    }
    final_norm_phase(xbuf, p.in[19]);
}

extern "C" void kernel_launch(void* const* d_in, const int* in_sizes, int n_in, void* d_out, int out_size, void* d_ws, size_t ws_size, hipStream_t stream) {
    static int grid_blocks = 0;
    if (!grid_blocks) {
        int dev = 0, cus = 0, per_cu = 0;
        (void)hipGetDevice(&dev);
        (void)hipDeviceGetAttribute(&cus, hipDeviceAttributeMultiprocessorCount, dev);
        (void)hipOccupancyMaxActiveBlocksPerMultiprocessor(&per_cu, mega, NTHR, 0);
        if (per_cu < 1) per_cu = 1;
        grid_blocks = cus;
    }
    if (n_in != 20 || ws_size < WS_END) return;
    Params p{};
    for (int i = 0; i < 20; ++i) p.in[i] = (const float*)d_in[i];
    p.out = (float*)d_out; p.ws = (unsigned char*)d_ws;
    void* args[] = {&p};
    (void)hipLaunchCooperativeKernel((void*)mega, dim3(grid_blocks), dim3(NTHR), args, 0, stream);
}
```

```cpp
#include <hip/hip_runtime.h>
#include <hip/hip_cooperative_groups.h>
namespace cg = cooperative_groups;

#define LAS __attribute__((address_space(3)))
typedef unsigned short bf16_t;
typedef short bf16x8 __attribute__((ext_vector_type(8)));
typedef float f32x4 __attribute__((ext_vector_type(4)));
typedef float f32x2 __attribute__((ext_vector_type(2)));
typedef unsigned u32x2 __attribute__((ext_vector_type(2)));
typedef unsigned u32x4 __attribute__((ext_vector_type(4)));

constexpr int DM = 1024, TC = 4096, TL = 16384, TT = 20480, PW = 10240, MLPW = 4096, VW = 2048;
constexpr int NTHR = 512;
constexpr float EPSV = 1e-6f;
constexpr size_t MiB = (size_t)1 << 20;
constexpr size_t WS_W = 0;
constexpr size_t WL_IN = 0, WL_CONV = 20 * MiB, WL_RET = 22 * MiB, WL_OUT = 26 * MiB, WL_M1 = 28 * MiB, WL_M2 = 36 * MiB, WL_SZ = 44 * MiB;
constexpr size_t WS_MOD = 88 * MiB;
constexpr size_t WS_ROPE = 88 * MiB + 512 * 1024;
constexpr size_t WS_R1 = 90 * MiB;
constexpr size_t WS_R2 = 130 * MiB;
constexpr size_t WS_Q = 170 * MiB;
constexpr size_t WS_K = 210 * MiB;
constexpr size_t WS_KT = 250 * MiB;
constexpr size_t WS_VT = 290 * MiB;
constexpr size_t WS_RG = 370 * MiB;
constexpr size_t WS_GATE = 450 * MiB;
constexpr size_t WS_YF = 530 * MiB;
constexpr size_t WS_YB = 610 * MiB;
constexpr size_t WS_BAR = 88 * MiB + 448 * 1024;
constexpr size_t WS_DUMP = 690 * MiB;
constexpr size_t WS_CNT = 88 * MiB + 480 * 1024;
constexpr size_t WS_END = 754 * MiB;

struct Params { const float* in[20]; float* out; unsigned char* ws; };

typedef __bf16 bf16x2_t __attribute__((ext_vector_type(2)));
__device__ __forceinline__ unsigned cvt_pk_bf16(float lo, float hi) { const f32x2 f = {lo, hi}; const bf16x2_t v = __builtin_convertvector(f, bf16x2_t); return __builtin_bit_cast(unsigned, v); }
__device__ __forceinline__ float bf_lo(unsigned u) { return __uint_as_float(u << 16); }
__device__ __forceinline__ float bf_hi(unsigned u) { return __uint_as_float(u & 0xffff0000u); }
__device__ __forceinline__ float sigmoidf_(float x) { return __builtin_amdgcn_rcpf(1.f + __expf(-x)); }
__device__ __forceinline__ float siluf_(float x) { return x * sigmoidf_(x); }
__device__ __forceinline__ float wave_sum(float v) {
#pragma unroll
    for (int o = 32; o > 0; o >>= 1) v += __shfl_xor(v, o, 64);
    return v;
}
__device__ __forceinline__ int tid_opaque() { int t = threadIdx.x; asm volatile("" : "+v"(t)); return t; }
__device__ __forceinline__ int row_group(int row) { return row < TC ? 0 : 1 + ((row - TC) >> 11); }

namespace pg8 {
constexpr int BM = 256, BK = 64, HALF = 128, HTB = HALF * BK * 2, NXCD = 8, WGM = 8;
__device__ __forceinline__ int lds_byte(int r, int c) { const int st = (r >> 4) * 2 + (c >> 5), rr = r & 15, cc = c & 31, ob = rr * 64 + cc * 2; return st * 1024 + (ob ^ (((ob >> 9) & 1) << 5)); }
__device__ __forceinline__ void stage_rc(int b, int& R, int& C) { const int st = b / 1024, sb = b % 1024, swz = sb ^ (((sb >> 9) & 1) << 5); R = (st >> 1) * 16 + swz / 64; C = (st & 1) * 32 + (swz % 64) / 2; }
__device__ __forceinline__ int perm32(int rho) { const int n = rho >> 4, i = rho & 15; return 8 * (i >> 2) + 4 * n + (i & 3); }
struct Unit { int pm, pn, kq, ti; };
struct Gemm { const bf16_t* A; const bf16_t* Bt; int M, N, K; unsigned long long* dump; unsigned* cnt; };
struct StaticOrder {
    int nM, nN, nwg, G, c; bool split;
    __device__ void init(int M, int N, int G_, int c_, bool allow_split = false) { nM = M / BM; nN = N / BM; nwg = nM * nN; G = G_; c = c_; split = allow_split && nwg == 320 && G == 256; }
    __device__ bool next(int i, Unit& u) const {
        if (split) {
            const int x = c & 7, j = c >> 3;
            if (i == 0) { u.pm = x * 8 + (j & 7); u.pn = j >> 3; u.kq = -1; u.ti = 0; return true; }
            if (i == 1) { u.kq = x & 3; u.pm = 64 + (x >> 2) * 8 + (j >> 2); u.pn = j & 3; u.ti = (u.pm - 64) * 4 + u.pn; return true; }
            return false;
        }
        const long L = (long)i * G + c;
        if (L >= nwg) return false;
        int wgid = (int)L; { const int q = nwg / NXCD, r = nwg % NXCD, xcd = wgid % NXCD, off = wgid / NXCD; wgid = (xcd < r ? xcd * (q + 1) : r * (q + 1) + (xcd - r) * q) + off; }
        const int nig = WGM * nN, gid = wgid / nig, fm = gid * WGM, gsz = (nM - fm) < WGM ? (nM - fm) : WGM;
        u.pm = fm + ((wgid % nig) % gsz); u.pn = (wgid % nig) / gsz; u.kq = -1; u.ti = 0; return true;
    }
};

template <class Epi>
__device__ __forceinline__ void gemm_phase(LAS unsigned char* lds, const Gemm g, const StaticOrder& S, const Epi& E) {
    const int tid = tid_opaque(), wid = __builtin_amdgcn_readfirstlane(tid >> 6), lane = tid & 63, wr = wid >> 2, wc = wid & 3, fr = lane & 15, fq = lane >> 4;
    const int K = g.K;
    unsigned voffA[2], voffB[2];
#pragma unroll
    for (int i = 0; i < 2; ++i) { int R, C; stage_rc(tid * 16 + i * 8192, R, C); const int Rb = (R & ~31) + perm32(R & 31); voffA[i] = (unsigned)(R * K + C) * 2u; voffB[i] = (unsigned)(Rb * K + C) * 2u; }
    const size_t kstep = (size_t)(BK * 2);
    const size_t hstep = (size_t)HALF * K * 2;
    const size_t tstep = 2 * hstep;
    const unsigned ldsw = (unsigned)wid * 1024u;
    const int aoff = lds_byte(wr * 64 + fr, fq * 8), boff = lds_byte(wc * 32 + fr, fq * 8);
#define PG8_SA(b, h) (((b) * 2 + (h)) * HTB)
#define PG8_SB(b, h) ((4 + (b) * 2 + (h)) * HTB)
#define PG8_STAGE(bufoff, gbase, voff) do { _Pragma("unroll") for (int _i = 0; _i < 2; ++_i) \
        __builtin_amdgcn_global_load_lds((const unsigned*)((const char*)(gbase) + (voff)[_i]), (LAS unsigned*)(lds + (bufoff) + ldsw + _i * 8192), 16, 0, 0); } while (0)
#define PG8_LDA(dst, b, h) do { _Pragma("unroll") for (int m = 0; m < 4; ++m) _Pragma("unroll") for (int k = 0; k < 2; ++k) dst[m][k] = *(const LAS bf16x8*)(lds + PG8_SA(b, h) + aoff + m * 2048 + k * 1024); } while (0)
#define PG8_LDB(dst, b, h) do { _Pragma("unroll") for (int n = 0; n < 2; ++n) _Pragma("unroll") for (int k = 0; k < 2; ++k) dst[n][k] = *(const LAS bf16x8*)(lds + PG8_SB(b, h) + boff + n * 2048 + k * 1024); } while (0)
#define PG8_MMA(ai, bj, At, Bt) do { __builtin_amdgcn_s_setprio(1); _Pragma("unroll") for (int m = 0; m < 4; ++m) _Pragma("unroll") for (int n = 0; n < 2; ++n) _Pragma("unroll") for (int k = 0; k < 2; ++k) \
        acc[ai][bj][m][n] = __builtin_amdgcn_mfma_f32_16x16x32_bf16(Bt[n][k], At[m][k], acc[ai][bj][m][n], 0, 0, 0); __builtin_amdgcn_s_setprio(0); } while (0)
#define PG8_WAIT_V(n) asm volatile("s_waitcnt vmcnt(" #n ")" ::: "memory")
#define PG8_WAIT_L(n) asm volatile("s_waitcnt lgkmcnt(" #n ")" ::: "memory")
#define PG8_BAR __builtin_amdgcn_s_barrier()
#define PG8_SCHED __builtin_amdgcn_sched_barrier(0)
    Unit cur, nxt; int ui = 0;
    if (!S.next(0, cur)) return;
    f32x4 acc[2][2][4][2];
#pragma unroll
    for (int a = 0; a < 2; ++a)
#pragma unroll
        for (int b = 0; b < 2; ++b)
#pragma unroll
            for (int m = 0; m < 4; ++m)
#pragma unroll
                for (int n = 0; n < 2; ++n) acc[a][b][m][n] = (f32x4){0.f, 0.f, 0.f, 0.f};
    bf16x8 At[4][2], B0[2][2], B1[2][2];
    const char* cA = E.swapped(cur) ? (const char*)g.Bt + (size_t)cur.pn * tstep : (const char*)g.A + (size_t)cur.pm * tstep;
    const char* cB = E.swapped(cur) ? (const char*)g.A + (size_t)cur.pm * tstep : (const char*)g.Bt + (size_t)cur.pn * tstep;
    const size_t qstep = (size_t)(K >> 2) * 2;
    if (cur.kq >= 0) { cA += cur.kq * qstep; cB += cur.kq * qstep; }
    PG8_STAGE(PG8_SB(0, 0), cB, voffB); PG8_STAGE(PG8_SA(0, 0), cA, voffA); PG8_STAGE(PG8_SB(0, 1), cB + hstep, voffB); PG8_STAGE(PG8_SA(0, 1), cA + hstep, voffA);
    if (wr == 1) PG8_BAR;
    PG8_WAIT_V(4); PG8_BAR;
    PG8_STAGE(PG8_SB(1, 0), cB + kstep, voffB); PG8_STAGE(PG8_SA(1, 0), cA + kstep, voffA); PG8_STAGE(PG8_SB(1, 1), cB + hstep + kstep, voffB);
    PG8_WAIT_V(6); PG8_BAR;
    for (;;) {
        const bool has_next = S.next(ui + 1, nxt);
        const bool nsw = has_next && E.swapped(nxt);
        const char* nA = has_next ? (nsw ? (const char*)g.Bt + (size_t)nxt.pn * tstep : (const char*)g.A + (size_t)nxt.pm * tstep) : cA;
        const char* nB = has_next ? (nsw ? (const char*)g.A + (size_t)nxt.pm * tstep : (const char*)g.Bt + (size_t)nxt.pn * tstep) : cB;
        if (has_next && nxt.kq >= 0) { nA += nxt.kq * qstep; nB += nxt.kq * qstep; }
        const int nt = (cur.kq >= 0 ? (K >> 2) : K) / BK;
        for (int t = 0; t < nt; t += 2) {
            const bool last = (t == nt - 2);
            const char* a1 = cA + (size_t)(t + 1) * kstep;
            const char* a2 = last ? nA : cA + (size_t)(t + 2) * kstep; const char* b2 = last ? nB : cB + (size_t)(t + 2) * kstep;
            const char* a3 = a2 + kstep; const char* b3 = b2 + kstep;
            PG8_LDB(B0, 0, 0); PG8_SCHED; PG8_LDA(At, 0, 0); PG8_STAGE(PG8_SA(1, 1), a1 + hstep, voffA);
            PG8_WAIT_L(8); PG8_BAR; PG8_WAIT_L(0); PG8_MMA(0, 0, At, B0); PG8_BAR; PG8_SCHED;
            PG8_LDB(B1, 0, 1); PG8_STAGE(PG8_SB(0, 0), b2, voffB);
            PG8_BAR; PG8_WAIT_L(0); PG8_MMA(0, 1, At, B1); PG8_BAR;
            PG8_LDA(At, 0, 1); PG8_STAGE(PG8_SA(0, 0), a2, voffA);
            PG8_BAR; PG8_WAIT_L(0); PG8_MMA(1, 0, At, B0); PG8_BAR; PG8_SCHED;
            PG8_STAGE(PG8_SB(0, 1), b2 + hstep, voffB);
            PG8_WAIT_V(6); PG8_BAR; PG8_MMA(1, 1, At, B1); PG8_BAR;
            PG8_LDB(B0, 1, 0); PG8_SCHED; PG8_LDA(At, 1, 0); PG8_STAGE(PG8_SA(0, 1), a2 + hstep, voffA);
            PG8_WAIT_L(8); PG8_BAR; PG8_WAIT_L(0); PG8_MMA(0, 0, At, B0); PG8_BAR; PG8_SCHED;
            PG8_LDB(B1, 1, 1); PG8_STAGE(PG8_SB(1, 0), b3, voffB);
            PG8_BAR; PG8_WAIT_L(0); PG8_MMA(0, 1, At, B1); PG8_BAR;
            PG8_LDA(At, 1, 1); PG8_STAGE(PG8_SA(1, 0), a3, voffA);
            PG8_BAR; PG8_WAIT_L(0); PG8_MMA(1, 0, At, B0); PG8_BAR; PG8_SCHED;
            PG8_STAGE(PG8_SB(1, 1), b3 + hstep, voffB);
            PG8_WAIT_V(6); PG8_BAR; PG8_MMA(1, 1, At, B1); PG8_BAR;
        }
        if (cur.kq < 0) E(acc, cur, wr, wc, fr, fq);
        if (!has_next) break;
#pragma unroll
        for (int a = 0; a < 2; ++a)
#pragma unroll
            for (int b = 0; b < 2; ++b)
#pragma unroll
                for (int m = 0; m < 4; ++m)
#pragma unroll
                    for (int n = 0; n < 2; ++n) acc[a][b][m][n] = (f32x4){0.f, 0.f, 0.f, 0.f};
        cur = nxt; cA = nA; cB = nB; ++ui;
    }
    PG8_WAIT_V(0);
    if (wr == 0) PG8_BAR;
    PG8_BAR;
    if constexpr (Epi::SPLIT) {
    if (cur.kq >= 0) {
        const __amdgpu_buffer_rsrc_t drs = __builtin_amdgcn_make_buffer_rsrc((void*)(g.dump + (size_t)cur.ti * 4 * (64 * 512)), 0, 4 * 64 * 512 * 8, 0x00020000);
        unsigned lo = (unsigned)tid * 16u;
        { const unsigned qo = (unsigned)cur.kq * (64 * 512 * 8);
#pragma unroll
          for (int a = 0; a < 2; ++a)
#pragma unroll
              for (int b = 0; b < 2; ++b)
#pragma unroll
                  for (int m = 0; m < 4; ++m)
#pragma unroll
                      for (int n = 0; n < 2; ++n) { asm volatile("" : "+v"(lo));
                          __builtin_amdgcn_raw_buffer_store_b128(__builtin_bit_cast(u32x4, acc[a][b][m][n]), drs, qo + (unsigned)((((a * 2 + b) * 4 + m) * 2 + n) * (512 * 16)) + lo, 0,   16); } }
        asm volatile("s_waitcnt vmcnt(0)" ::: "memory");
        __syncthreads();
        if (tid == 0) { __hip_atomic_fetch_add(g.cnt + 2 * cur.ti, 1u, __ATOMIC_RELAXED, __HIP_MEMORY_SCOPE_AGENT);
            unsigned spins = 0; while (__hip_atomic_load(g.cnt + 2 * cur.ti, __ATOMIC_RELAXED, __HIP_MEMORY_SCOPE_AGENT) < 4u) { __builtin_amdgcn_s_sleep(2); if (++spins > (1u << 22)) break; } }
        __syncthreads();
#pragma unroll
        for (int a = 0; a < 2; ++a)
#pragma unroll
            for (int m = 0; m < 4; ++m) { if (((a * 4 + m) >> 1) != cur.kq) continue;
                f32x4 v[2][2];
#pragma unroll
                for (int b = 0; b < 2; ++b)
#pragma unroll
                    for (int n = 0; n < 2; ++n) { asm volatile("" : "+v"(lo)); const unsigned o = (unsigned)((((a * 2 + b) * 4 + m) * 2 + n) * (512 * 16)) + lo;
                        const f32x4 p0 = __builtin_bit_cast(f32x4, __builtin_amdgcn_raw_buffer_load_b128(drs, o, 0, 16)), p1 = __builtin_bit_cast(f32x4, __builtin_amdgcn_raw_buffer_load_b128(drs, o + 64 * 512 * 8, 0, 16)),
                                    p2 = __builtin_bit_cast(f32x4, __builtin_amdgcn_raw_buffer_load_b128(drs, o + 2 * 64 * 512 * 8, 0, 16)), p3 = __builtin_bit_cast(f32x4, __builtin_amdgcn_raw_buffer_load_b128(drs, o + 3 * 64 * 512 * 8, 0, 16));
                        v[b][n] = (p0 + p1) + (p2 + p3); }
                E.rg(a, m, v, cur, wr, wc, fr, fq); }
        asm volatile("s_waitcnt vmcnt(0)" ::: "memory");
        __syncthreads();
        if (tid == 0) { const unsigned old = __hip_atomic_fetch_add(g.cnt + 2 * cur.ti + 1, 1u, __ATOMIC_RELAXED, __HIP_MEMORY_SCOPE_AGENT);
            if (old == 3u) { __hip_atomic_store(g.cnt + 2 * cur.ti, 0u, __ATOMIC_RELAXED, __HIP_MEMORY_SCOPE_AGENT); __hip_atomic_store(g.cnt + 2 * cur.ti + 1, 0u, __ATOMIC_RELAXED, __HIP_MEMORY_SCOPE_AGENT); } }
        __syncthreads();
    }
    }
#undef PG8_SA
#undef PG8_SB
#undef PG8_STAGE
#undef PG8_LDA
#undef PG8_LDB
#undef PG8_MMA
#undef PG8_WAIT_V
#undef PG8_WAIT_L
#undef PG8_BAR
#undef PG8_SCHED
}
}
using pg8::Unit;
typedef const f32x4 (&AccRef)[2][2][4][2];

__device__ __forceinline__ void st_bf16x4(bf16_t* p, f32x4 v) { u32x2 w; w.x = cvt_pk_bf16(v[0], v[1]); w.y = cvt_pk_bf16(v[2], v[3]); *(u32x2*)p = w; }
__device__ __forceinline__ void st_bf16x8(bf16_t* p, f32x4 a, f32x4 b) { u32x4 w; w.x = cvt_pk_bf16(a[0], a[1]); w.y = cvt_pk_bf16(a[2], a[3]); w.z = cvt_pk_bf16(b[0], b[1]); w.w = cvt_pk_bf16(b[2], b[3]); *(u32x4*)p = w; }
__device__ __forceinline__ bf16_t bf16_1(float v) { return (bf16_t)(cvt_pk_bf16(v, 0.f) & 0xffffu); }

struct EpiG1 {
    static constexpr bool SPLIT = false;
    __device__ __forceinline__ bool swapped(const Unit& u) const { return u.pn >= 16 && u.pn < 24; }
    bf16_t *aglu, *q, *k, *kt, *vt, *rg, *gate; const float *rcos, *rsin;
    __device__ __forceinline__ void operator()(AccRef acc, const Unit& u, int wr, int wc, int fr, int fq) const {
        const int pn = u.pn, row0 = u.pm * 256 + wr * 64 + fr, ct = wc * 32 + 8 * fq;
        if (pn < 8) {
#pragma unroll
            for (int ai = 0; ai < 2; ++ai)
#pragma unroll
                for (int m = 0; m < 4; ++m) { const int row = row0 + ai * 128 + m * 16; f32x4 o[2];
#pragma unroll
                    for (int n = 0; n < 2; ++n) { const f32x4 a = acc[ai][0][m][n], b = acc[ai][1][m][n];
#pragma unroll
                        for (int r = 0; r < 4; ++r) o[n][r] = a[r] * sigmoidf_(b[r]); }
                    st_bf16x8(aglu + (size_t)row * DM + pn * 128 + ct, o[0], o[1]); }
        } else if (pn < 16) {
            const bool isK = pn >= 12; const int h = (pn - 8) & 3; const float sc = isK ? 0.0625f : 1.0f; bf16_t* dst = isK ? k : q;
#pragma unroll
            for (int ai = 0; ai < 2; ++ai)
#pragma unroll
                for (int m = 0; m < 4; ++m) { const int row = row0 + ai * 128 + m * 16; const bool lat = row >= TC; const int pos = (row - TC) & 2047, gr = pos >> 6, gc = pos & 63; f32x4 o1[2], o2[2];
#pragma unroll
                    for (int n = 0; n < 2; ++n) { const int d1 = ct + n * 4; const f32x4 x1 = acc[ai][0][m][n] * sc, x2 = acc[ai][1][m][n] * sc; o1[n] = x1; o2[n] = x2;
                        if (lat) { const int ti = (d1 < 64) ? gr * 64 + d1 : gc * 64 + d1 - 64; const f32x4 cs = *(const f32x4*)(rcos + ti), sn = *(const f32x4*)(rsin + ti);
                            o1[n] = x1 * cs - x2 * sn; o2[n] = x2 * cs + x1 * sn; }
                        if (isK) {
#pragma unroll
                            for (int r = 0; r < 4; ++r) { kt[(size_t)(h * 256 + d1 + r) * TT + row] = bf16_1(o1[n][r]); kt[(size_t)(h * 256 + 128 + d1 + r) * TT + row] = bf16_1(o2[n][r]); } } }
                    st_bf16x8(dst + (size_t)row * DM + h * 256 + ct, o1[0], o1[1]); st_bf16x8(dst + (size_t)row * DM + h * 256 + 128 + ct, o2[0], o2[1]); }
        } else if (pn < 24) {
            const int e0 = (pn - 16) * 256 + wr * 64 + fr, t0 = u.pm * 256 + ct;
#pragma unroll
            for (int ai = 0; ai < 2; ++ai)
#pragma unroll
                for (int m = 0; m < 4; ++m) { bf16_t* vr = vt + (size_t)(e0 + ai * 128 + m * 16) * TT + t0;
#pragma unroll
                    for (int bj = 0; bj < 2; ++bj) st_bf16x8(vr + bj * 128, acc[ai][bj][m][0], acc[ai][bj][m][1]); }
        } else {
            const bool isG = pn >= 32; bf16_t* dst = isG ? gate : rg; const int cb = ((pn - 24) & 7) * 256;
#pragma unroll
            for (int ai = 0; ai < 2; ++ai)
#pragma unroll
                for (int m = 0; m < 4; ++m) { const int row = row0 + ai * 128 + m * 16;
#pragma unroll
                    for (int bj = 0; bj < 2; ++bj) { f32x4 o[2];
#pragma unroll
                        for (int n = 0; n < 2; ++n) { const f32x4 v = acc[ai][bj][m][n];
#pragma unroll
                            for (int r = 0; r < 4; ++r) { const float s = sigmoidf_(v[r]); o[n][r] = isG ? s : v[r] * s; } }
                        st_bf16x8(dst + (size_t)row * VW + cb + bj * 128 + ct, o[0], o[1]); } }
        }
    }
};

struct EpiE1 {
    static constexpr bool SPLIT = true;
    __device__ __forceinline__ bool swapped(const Unit&) const { return false; }
    bf16_t* m1; const bf16_t* gate;
    __device__ __forceinline__ void rg(int ai, int m, const f32x4 (&v)[2][2], const Unit& u, int wr, int wc, int fr, int fq) const {
        const int row = u.pm * 256 + wr * 64 + fr + ai * 128 + m * 16, col0 = u.pn * 256 + wc * 32 + 8 * fq;
#pragma unroll
        for (int bj = 0; bj < 2; ++bj) { const int col = col0 + bj * 128; const u32x4 gv = *(const u32x4*)(gate + (size_t)row * VW + col); const f32x4 v0 = v[bj][0], v1 = v[bj][1];
            f32x4 o0, o1; o0[0] = v0[0] * bf_lo(gv.x); o0[1] = v0[1] * bf_hi(gv.x); o0[2] = v0[2] * bf_lo(gv.y); o0[3] = v0[3] * bf_hi(gv.y);
            o1[0] = v1[0] * bf_lo(gv.z); o1[1] = v1[1] * bf_hi(gv.z); o1[2] = v1[2] * bf_lo(gv.w); o1[3] = v1[3] * bf_hi(gv.w);
            st_bf16x8(m1 + (size_t)row * DM + col, o0, o1); }
    }
    __device__ __forceinline__ void operator()(AccRef acc, const Unit& u, int wr, int wc, int fr, int fq) const {
#pragma unroll
        for (int a = 0; a < 2; ++a)
#pragma unroll
            for (int m = 0; m < 4; ++m) { const f32x4 v[2][2] = {{acc[a][0][m][0], acc[a][0][m][1]}, {acc[a][1][m][0], acc[a][1][m][1]}}; rg(a, m, v, u, wr, wc, fr, fq); }
    }
};
struct EpiE2 {
    static constexpr bool SPLIT = true;
    __device__ __forceinline__ bool swapped(const Unit&) const { return false; }
    const bf16_t* m1; const bf16_t* gate; bf16_t* mm;
    __device__ __forceinline__ void rg(int ai, int m, const f32x4 (&v)[2][2], const Unit& u, int wr, int wc, int fr, int fq) const {
        const int row = u.pm * 256 + wr * 64 + fr + ai * 128 + m * 16, col0 = u.pn * 256 + wc * 32 + 8 * fq;
#pragma unroll
        for (int bj = 0; bj < 2; ++bj) { const int col = col0 + bj * 128; const u32x4 gv = *(const u32x4*)(gate + (size_t)row * VW + DM + col), mv = *(const u32x4*)(m1 + (size_t)row * DM + col); const f32x4 v0 = v[bj][0], v1 = v[bj][1];
            f32x4 o0, o1; o0[0] = bf_lo(mv.x) + v0[0] * bf_lo(gv.x); o0[1] = bf_hi(mv.x) + v0[1] * bf_hi(gv.x); o0[2] = bf_lo(mv.y) + v0[2] * bf_lo(gv.y); o0[3] = bf_hi(mv.y) + v0[3] * bf_hi(gv.y);
            o1[0] = bf_lo(mv.z) + v1[0] * bf_lo(gv.z); o1[1] = bf_hi(mv.z) + v1[1] * bf_hi(gv.z); o1[2] = bf_lo(mv.w) + v1[2] * bf_lo(gv.w); o1[3] = bf_hi(mv.w) + v1[3] * bf_hi(gv.w);
            st_bf16x8(mm + (size_t)row * DM + col, o0, o1); }
    }
    __device__ __forceinline__ void operator()(AccRef acc, const Unit& u, int wr, int wc, int fr, int fq) const {
#pragma unroll
        for (int a = 0; a < 2; ++a)
#pragma unroll
            for (int m = 0; m < 4; ++m) { const f32x4 v[2][2] = {{acc[a][0][m][0], acc[a][0][m][1]}, {acc[a][1][m][0], acc[a][1][m][1]}}; rg(a, m, v, u, wr, wc, fr, fq); }
    }
};
template <bool SPLIT_> struct EpiResT {
    static constexpr bool SPLIT = SPLIT_;
    __device__ __forceinline__ bool swapped(const Unit&) const { return false; }
    const float *xa, *xb; float* xout; const float* gvec;
    __device__ __forceinline__ void rg(int ai, int m, const f32x4 (&v)[2][2], const Unit& u, int wr, int wc, int fr, int fq) const {
        const int row = u.pm * 256 + wr * 64 + fr + ai * 128 + m * 16, col0 = u.pn * 256 + wc * 32 + 8 * fq;
        const float* xr = row < TC ? xa + (size_t)row * DM : xb + (size_t)(row - TC) * DM; const float* gr = gvec + row_group(row) * 6144;
#pragma unroll
        for (int bj = 0; bj < 2; ++bj)
#pragma unroll
            for (int n = 0; n < 2; ++n) { const int col = col0 + bj * 128 + n * 4; const f32x4 xv = *(const f32x4*)(xr + col), gv = *(const f32x4*)(gr + col);
                *(f32x4*)(xout + (size_t)row * DM + col) = xv + gv * v[bj][n]; }
    }
    __device__ __forceinline__ void operator()(AccRef acc, const Unit& u, int wr, int wc, int fr, int fq) const {
#pragma unroll
        for (int a = 0; a < 2; ++a)
#pragma unroll
            for (int m = 0; m < 4; ++m) { const f32x4 v[2][2] = {{acc[a][0][m][0], acc[a][0][m][1]}, {acc[a][1][m][0], acc[a][1][m][1]}}; rg(a, m, v, u, wr, wc, fr, fq); }
    }
};
struct EpiF1 {
    static constexpr bool SPLIT = false;
    __device__ __forceinline__ bool swapped(const Unit&) const { return false; }
    bf16_t* uo;
    __device__ __forceinline__ void operator()(AccRef acc, const Unit& u, int wr, int wc, int fr, int fq) const {
        const int row0 = u.pm * 256 + wr * 64 + fr, col0 = u.pn * 256 + wc * 32 + 8 * fq;
#pragma unroll
        for (int ai = 0; ai < 2; ++ai)
#pragma unroll
            for (int m = 0; m < 4; ++m) { const int row = row0 + ai * 128 + m * 16;
#pragma unroll
                for (int bj = 0; bj < 2; ++bj) { f32x4 o[2];
#pragma unroll
                    for (int n = 0; n < 2; ++n) { const f32x4 v = acc[ai][bj][m][n];
#pragma unroll
                        for (int r = 0; r < 4; ++r) { const float t = fmaxf(v[r], 0.f); o[n][r] = t * t; } }
                    st_bf16x8(uo + (size_t)row * MLPW + col0 + bj * 128, o[0], o[1]); } }
    }
};

__device__ __forceinline__ void tconv_item(const float* __restrict__ src, bf16_t* __restrict__ dst, int K, int N, int item, bool permIn, float* tile  ) {
    const int tilesN = N >> 8, kt = item / tilesN, ntile = item - kt * tilesN, k0 = kt * 64, n0 = ntile * 256, tid = tid_opaque();
    { const int r = tid >> 6, c4 = (tid & 63) * 4; f32x4 v[8];
#pragma unroll
      for (int rr = 0; rr < 8; ++rr) v[rr] = __builtin_nontemporal_load((const f32x4*)(src + (size_t)(k0 + r + rr * 8) * N + n0 + c4));
#pragma unroll
      for (int rr = 0; rr < 8; ++rr) { float* t = tile + (r + rr * 8) * 257 + c4; t[0] = v[rr][0]; t[1] = v[rr][1]; t[2] = v[rr][2]; t[3] = v[rr][3]; } }
    __syncthreads();
#pragma unroll
    for (int q = 0; q < 4; ++q) { const int n = q * 64 + (tid >> 3), k8 = (tid & 7) * 8; float v[8];
#pragma unroll
      for (int e = 0; e < 8; ++e) v[e] = tile[(k8 + e) * 257 + n];
      int nn = n0 + n;
      if (permIn && nn < 2048) { const int c = nn & 1023, half = nn >> 10; nn = (c >> 7) * 256 + half * 128 + (c & 127); }
      u32x4 w; w.x = cvt_pk_bf16(v[0], v[1]); w.y = cvt_pk_bf16(v[2], v[3]); w.z = cvt_pk_bf16(v[4], v[5]); w.w = cvt_pk_bf16(v[6], v[7]);
      *(u32x4*)(dst + (size_t)nn * K + k0 + k8) = w; }
    __syncthreads();
}

__device__ void phase0(const Params& p, unsigned char* smem) {
    float* tile = (float*)smem;
    float* scond = (float*)(smem + 66048);
    float* red = (float*)(smem + 66048 + 36864);
    const int tid = tid_opaque();
    constexpr int NT_L = 1408, NT = 2 * NT_L, NMOD = 192;
    for (int it = blockIdx.x; it < NT + NMOD + 1; it += gridDim.x) {
        if (it < NT) {
            const int l = it / NT_L; int j = it - l * NT_L; unsigned char* wb = p.ws + WS_W + (size_t)l * WL_SZ;
            if (j < 640) tconv_item(p.in[9] + (size_t)l * DM * PW, (bf16_t*)(wb + WL_IN), DM, PW, j, true, tile);
            else if ((j -= 640) < 64) tconv_item(p.in[13] + (size_t)l * DM * DM, (bf16_t*)(wb + WL_CONV), DM, DM, j, false, tile);
            else if ((j -= 64) < 128) tconv_item(p.in[15] + (size_t)l * VW * DM, (bf16_t*)(wb + WL_RET), VW, DM, j, false, tile);
            else if ((j -= 128) < 64) tconv_item(p.in[16] + (size_t)l * DM * DM, (bf16_t*)(wb + WL_OUT), DM, DM, j, false, tile);
            else if ((j -= 64) < 256) tconv_item(p.in[17] + (size_t)l * DM * MLPW, (bf16_t*)(wb + WL_M1), DM, MLPW, j, false, tile);
            else { j -= 256; tconv_item(p.in[18] + (size_t)l * MLPW * DM, (bf16_t*)(wb + WL_M2), MLPW, DM, j, false, tile); }
        } else if (it < NT + NMOD) {
            const int j = it - NT, l = j / 96, c0 = (j % 96) * 64;
            for (int idx = tid; idx < 9 * 1024; idx += NTHR) { const int g = idx >> 10, k = idx & 1023; const float v = g == 0 ? p.in[4][k] : p.in[2][(g - 1) * 1024 + k]; scond[idx] = siluf_(v); }
            __syncthreads();
            const int col = tid & 63, kg = tid >> 6; float a[9];
#pragma unroll
            for (int g = 0; g < 9; ++g) a[g] = 0.f;
            const float* wm = p.in[7] + (size_t)l * DM * 6144 + c0 + col;
#pragma unroll 16
            for (int k = kg * 128; k < kg * 128 + 128; ++k) { const float w = __builtin_nontemporal_load(wm + (size_t)k * 6144);
#pragma unroll
                for (int g = 0; g < 9; ++g) a[g] += scond[g * 1024 + k] * w; }
#pragma unroll
            for (int g = 0; g < 9; ++g) red[(kg * 9 + g) * 64 + col] = a[g];
            __syncthreads();
            for (int o = tid; o < 9 * 64; o += NTHR) { const int g = o >> 6, cc = o & 63; float s = 0.f;
#pragma unroll
                for (int q = 0; q < 8; ++q) s += red[(q * 9 + g) * 64 + cc];
                ((float*)(p.ws + WS_MOD))[(size_t)(l * 9 + g) * 6144 + c0 + cc] = s + p.in[8][l * 6144 + c0 + cc]; }
            __syncthreads();
        } else {
            float* rc = (float*)(p.ws + WS_ROPE); float* rs = rc + 4096;
            if (tid < 128) ((unsigned*)(p.ws + WS_CNT))[tid] = 0u;
            for (int idx = tid; idx < 4096; idx += NTHR) { const int pos = idx >> 6, i = idx & 63; const float inv = exp2f(-(float)i * (13.287712379549449f / 64.f)); const float ang = (float)pos * inv;
                rc[idx] = __cosf(ang); rs[idx] = __sinf(ang); }
        }
    }
}

__device__ void norm_mod_phase(const float* xa, const float* xb, bf16_t* dst, const float* ng, const float* modl, int sh_chunk) {
    const int tid = tid_opaque(), lane = tid & 63, gw = blockIdx.x * 8 + (tid >> 6), nw = gridDim.x * 8;
    for (int row0 = gw; row0 < TT; row0 += 2 * nw) {
        f32x4 v[2][4]; float ss[2];
#pragma unroll
        for (int q = 0; q < 2; ++q) { const int row = min(row0 + q * nw, TT - 1); const float* xr = row < TC ? xa + (size_t)row * DM : xb + (size_t)(row - TC) * DM;
#pragma unroll
            for (int i = 0; i < 4; ++i) v[q][i] = __builtin_nontemporal_load((const f32x4*)(xr + i * 256 + lane * 4)); }
#pragma unroll
        for (int q = 0; q < 2; ++q) { float s = 0.f;
#pragma unroll
            for (int i = 0; i < 4; ++i) s += v[q][i][0] * v[q][i][0] + v[q][i][1] * v[q][i][1] + v[q][i][2] * v[q][i][2] + v[q][i][3] * v[q][i][3];
            ss[q] = s; }
#pragma unroll
        for (int q = 0; q < 2; ++q) { const int row = row0 + q * nw; if (row >= TT) break;
            const float rstd = rsqrtf(wave_sum(ss[q]) * (1.f / DM) + EPSV); const float* md = modl + row_group(row) * 6144;
#pragma unroll
            for (int i = 0; i < 4; ++i) { const int c = i * 256 + lane * 4; const f32x4 g = *(const f32x4*)(ng + c), sh = *(const f32x4*)(md + sh_chunk * 1024 + c), sc = *(const f32x4*)(md + (sh_chunk + 1) * 1024 + c);
                const f32x4 o = v[q][i] * rstd * g * (sc + 1.f) + sh; st_bf16x4(dst + (size_t)row * DM + c, o); } }
    }
}
__device__ void final_norm_phase(float* x, const float* ng) {
    const int tid = tid_opaque(), lane = tid & 63, gw = blockIdx.x * 8 + (tid >> 6), nw = gridDim.x * 8;
    for (int row = gw; row < TT; row += nw) {
        float* xr = x + (size_t)row * DM; f32x4 v[4]; float ss = 0.f;
#pragma unroll
        for (int i = 0; i < 4; ++i) { v[i] = __builtin_nontemporal_load((const f32x4*)(xr + i * 256 + lane * 4)); ss += v[i][0] * v[i][0] + v[i][1] * v[i][1] + v[i][2] * v[i][2] + v[i][3] * v[i][3]; }
        ss = wave_sum(ss); const float rstd = rsqrtf(ss * (1.f / DM) + EPSV);
#pragma unroll
        for (int i = 0; i < 4; ++i) { const int c = i * 256 + lane * 4; const f32x4 g = *(const f32x4*)(ng + c); __builtin_nontemporal_store(v[i] * rstd * g, (f32x4*)(xr + c)); }
    }
}

__device__ void conv_phase(const Params& p, int l, unsigned char* smem) {
    const int tid = tid_opaque(), lane = tid & 63, wv = tid >> 6;
    const bf16_t* aglu = (const bf16_t*)(p.ws + WS_R2); bf16_t* aconv = (bf16_t*)(p.ws + WS_R1);
    float* red = (float*)(smem + 46 * 2048);
    float* rst = red + 128;
    const int c0 = 2 * tid;
    float w0[31], w1[31];
#pragma unroll
    for (int j = 0; j < 31; ++j) { const f32x2 wv2 = *(const f32x2*)(p.in[10] + (size_t)(l * 31 + j) * DM + c0); w0[j] = wv2.x; w1[j] = wv2.y; }
    const f32x2 bias = *(const f32x2*)(p.in[11] + l * DM + c0), gn = *(const f32x2*)(p.in[12] + l * DM + c0);
    for (int it = blockIdx.x; it < TT / 16; it += gridDim.x) {
        const int t0 = it * 16, segl = t0 < TC ? 256 : 64, ss = t0 & ~(segl - 1), se = ss + segl;
        for (int idx = tid; idx < 46 * 128; idx += NTHR) { const int rr = idx >> 7, ch = idx & 127, tt = t0 - 15 + rr; u32x4 v = (u32x4){0u, 0u, 0u, 0u};
            if (tt >= ss && tt < se) v = *(const u32x4*)(aglu + (size_t)tt * DM + ch * 8);
            *(u32x4*)(smem + rr * 2048 + ch * 16) = v; }
        __syncthreads();
        float a0[16], a1[16];
#pragma unroll
        for (int t = 0; t < 16; ++t) { a0[t] = bias.x; a1[t] = bias.y; }
#pragma unroll
        for (int rr = 0; rr < 46; ++rr) { const unsigned uv = *(const unsigned*)(smem + rr * 2048 + c0 * 2); const float lo = bf_lo(uv), hi = bf_hi(uv);
#pragma unroll
            for (int t = 0; t < 16; ++t) { const int j = rr - t; if (j >= 0 && j < 31) { a0[t] += w0[j] * lo; a1[t] += w1[j] * hi; } } }
#pragma unroll
        for (int t = 0; t < 16; ++t) { const float s = wave_sum(a0[t] * a0[t] + a1[t] * a1[t]); if (lane == 0) red[wv * 16 + t] = s; }
        __syncthreads();
        if (tid < 16) { float s = 0.f;
#pragma unroll
            for (int q = 0; q < 8; ++q) s += red[q * 16 + tid];
            rst[tid] = rsqrtf(s * (1.f / DM) + EPSV); }
        __syncthreads();
#pragma unroll
        for (int t = 0; t < 16; ++t) { const float r = rst[t]; *(unsigned*)(aconv + (size_t)(t0 + t) * DM + c0) = cvt_pk_bf16(siluf_(a0[t] * r * gn.x), siluf_(a1[t] * r * gn.y)); }
        __syncthreads();
    }
}

__device__ void ret_phase(const Params& p, int l, unsigned char* smem) {
    LAS unsigned char* lds = (LAS unsigned char*)smem;
    const int tid = tid_opaque(), lane = tid & 63, w = __builtin_amdgcn_readfirstlane(tid >> 6), fr = lane & 15, fq = lane >> 4;
    const bf16_t* Qg = (const bf16_t*)(p.ws + WS_Q); const bf16_t* Kg = (const bf16_t*)(p.ws + WS_K); const bf16_t* KTg = (const bf16_t*)(p.ws + WS_KT); const bf16_t* VTg = (const bf16_t*)(p.ws + WS_VT);
    constexpr int QOFF = 0, KTOFF = 65536;
    const unsigned voffQ = (unsigned)(((2 * w + (lane >> 5)) * DM + (((lane & 31) ^ ((2 * w + (lane >> 5)) & 15))) * 8) * 2);
    const unsigned voffKT = (unsigned)(((4 * w + (lane >> 4)) * TT + (((lane & 15) ^ ((((2 * w + (lane >> 5)) & 12)) | ((lane >> 4) & 3)))) * 8) * 2);
    const unsigned voffK = (unsigned)(((16 * w + fr) * DM + fq * 8) * 2);
    const unsigned voffV = (unsigned)(((16 * w + fr) * TT + fq * 8) * 2);
    const unsigned voffY = (unsigned)(((4 * fq) * VW + 16 * w + fr) * 2);
    int xb[4];
#pragma unroll
    for (int k4 = 0; k4 < 4; ++k4) xb[k4] = ((k4 * 4 + fq) ^ fr) * 16;
    for (int it = blockIdx.x; it < 768; it += gridDim.x) {
        int es, dir, h, bb, tok0, nch; const bool lat = it < 256;
        { const int j = lat ? it : it - 256, x = j & 7, y = j >> 3; es = y & 3; const int cmb = (y >> 2) * 8 + x; dir = cmb & 1; h = (cmb >> 1) & 3; bb = cmb >> 3;
          tok0 = lat ? TC + bb * 2048 : bb * 256; nch = lat ? 16 : 2; }
        const float dl = p.in[14][l * 8 + dir * 4 + h]; const float lg2 = -log1pf(expf(-dl)) * 1.4426950408889634f;
        const float sdec = exp2f(128.f * lg2);
        const float zl = dir ? -lg2 : lg2, zb2 = (float)(dir ? 128 - 4 * fq : 4 * fq + 1) * lg2, kb2 = (float)(dir ? 8 * fq : 127 - 8 * fq) * lg2;
        const int pbase = dir ? (16 * w + 4 * fq - fr) : (fr - 16 * w - 4 * fq);
        f32x4 S[16];
        const unsigned voffS = (unsigned)((8 * fq * 512 + 16 * w + fr) * 4);
        if (lat) { const float* sp = p.in[3] + ((((size_t)bb * 2 + l) * 2 + dir) * 4 + h) * 256 * 512 + es * 128;
#pragma unroll
            for (int D = 0; D < 16; ++D)
#pragma unroll
                for (int r = 0; r < 4; ++r) S[D][r] = __builtin_nontemporal_load((const float*)((const char*)(sp + ((D >> 1) * 32 + 4 * (D & 1) + r) * 512) + voffS));
        } else {
#pragma unroll
            for (int D = 0; D < 16; ++D) S[D] = (f32x4){0.f, 0.f, 0.f, 0.f};
        }
        bf16_t* Yg = (bf16_t*)(p.ws + (dir ? WS_YB : WS_YF));
        for (int s = 0; s < nch; ++s) {
            const int c = dir ? nch - 1 - s : s, r0 = tok0 + c * 128;
            { const bf16_t* qu = Qg + (size_t)r0 * DM + h * 256; const bf16_t* ku = KTg + (size_t)(h * 256) * TT + r0;
#pragma unroll
              for (int n = 0; n < 8; ++n) {
                  __builtin_amdgcn_global_load_lds((const unsigned*)((const char*)(qu + (size_t)(n * 16) * DM) + voffQ), (LAS unsigned*)(lds + QOFF + (n * 8 + w) * 1024), 16, 0, 0);
                  __builtin_amdgcn_global_load_lds((const unsigned*)((const char*)(ku + (size_t)(n * 32) * TT) + voffKT), (LAS unsigned*)(lds + KTOFF + (n * 8 + w) * 1024), 16, 0, 0); } }
            bf16x8 Kf[8], Vf[4];
            { const char* kb = (const char*)(Kg + (size_t)r0 * DM + h * 256) + voffK;
#pragma unroll
              for (int ks = 0; ks < 4; ++ks) Kf[ks] = *(const bf16x8*)(kb + ks * 64); }
            asm volatile("s_waitcnt vmcnt(0)" ::: "memory");
            __syncthreads();
            { const char* kb = (const char*)(Kg + (size_t)r0 * DM + h * 256) + voffK;
#pragma unroll
              for (int ks = 4; ks < 8; ++ks) Kf[ks] = *(const bf16x8*)(kb + ks * 64); }
            f32x4 Z[8], PT[8];
#pragma unroll
            for (int i8 = 0; i8 < 8; ++i8) { Z[i8] = (f32x4){0.f, 0.f, 0.f, 0.f}; PT[i8] = (f32x4){0.f, 0.f, 0.f, 0.f}; }
#define QFRAG(ks, i8) (*(const LAS bf16x8*)(lds + QOFF + xb[(ks) & 3] + fr * 512 + (i8) * 8192 + ((ks) >> 2) * 256))
            { bf16x8 qa[4], qb[4];
#pragma unroll
              for (int j = 0; j < 4; ++j) qa[j] = QFRAG(0, j);
#pragma unroll
              for (int ks = 0; ks < 8; ++ks) { u32x4 t; t.x = cvt_pk_bf16(S[2 * ks][0], S[2 * ks][1]); t.y = cvt_pk_bf16(S[2 * ks][2], S[2 * ks][3]); t.z = cvt_pk_bf16(S[2 * ks + 1][0], S[2 * ks + 1][1]); t.w = cvt_pk_bf16(S[2 * ks + 1][2], S[2 * ks + 1][3]);
                  const bf16x8 Sb = __builtin_bit_cast(bf16x8, t);
#pragma unroll
                  for (int j = 0; j < 4; ++j) qb[j] = QFRAG(ks, 4 + j);
                  __builtin_amdgcn_sched_barrier(0);
#pragma unroll
                  for (int j = 0; j < 4; ++j) { Z[j] = __builtin_amdgcn_mfma_f32_16x16x32_bf16(qa[j], Sb, Z[j], 0, 0, 0); PT[j] = __builtin_amdgcn_mfma_f32_16x16x32_bf16(Kf[ks], qa[j], PT[j], 0, 0, 0); }
                  __builtin_amdgcn_sched_barrier(0);
                  if (ks < 7) {
#pragma unroll
                      for (int j = 0; j < 4; ++j) qa[j] = QFRAG(ks + 1, j); }
                  __builtin_amdgcn_sched_barrier(0);
#pragma unroll
                  for (int j = 0; j < 4; ++j) { Z[4 + j] = __builtin_amdgcn_mfma_f32_16x16x32_bf16(qb[j], Sb, Z[4 + j], 0, 0, 0); PT[4 + j] = __builtin_amdgcn_mfma_f32_16x16x32_bf16(Kf[ks], qb[j], PT[4 + j], 0, 0, 0); }
                  __builtin_amdgcn_sched_barrier(0); } }
#undef QFRAG
            { const char* vb = (const char*)(VTg + (size_t)(h * 512 + es * 128) * TT + r0) + voffV;
#pragma unroll
              for (int ks = 0; ks < 4; ++ks) Vf[ks] = *(const bf16x8*)(vb + ks * 64); }
            float zb2_ = zb2, zl_ = zl, kb2_ = kb2; int pbase_ = pbase;
            asm volatile("" : "+v"(zb2_), "+v"(zl_), "+v"(kb2_), "+v"(pbase_));
            { f32x4 zf, pf; const float z16 = __builtin_amdgcn_exp2f(16.f * zl_);
#pragma unroll
              for (int r = 0; r < 4; ++r) { zf[r] = __builtin_amdgcn_exp2f(zb2_ + (float)r * zl_); pf[r] = __builtin_amdgcn_exp2f((float)(pbase_ + (dir ? r : -r)) * lg2); }
#pragma unroll
              for (int i8 = 0; i8 < 8; ++i8) {
#pragma unroll
                  for (int r = 0; r < 4; ++r) { Z[i8][r] *= zf[r];
                      const int df = pbase_ + (dir ? -(i8 * 16 - r) : (i8 * 16 - r)); PT[i8][r] = df >= 0 ? PT[i8][r] * pf[r] : 0.f; }
                  zf *= z16; pf *= z16; } }
            __syncthreads();
#pragma unroll
            for (int i8 = 0; i8 < 8; ++i8) { const int i = i8 * 16 + fr; u32x2 t; t.x = cvt_pk_bf16(PT[i8][0], PT[i8][1]); t.y = cvt_pk_bf16(PT[i8][2], PT[i8][3]);
                *(LAS u32x2*)(lds + QOFF + i * 256 + (((2 * w + (fq >> 1)) ^ fr)) * 16 + (fq & 1) * 8) = t; }
            __syncthreads();
#define PFRAG(i8, ks) (*(const LAS bf16x8*)(lds + QOFF + xb[ks] + fr * 256 + (i8) * 4096))
            { bf16x8 pa[4], pb[4];
#pragma unroll
              for (int ks = 0; ks < 4; ++ks) pa[ks] = PFRAG(0, ks);
#pragma unroll
              for (int i8 = 0; i8 < 8; i8 += 2) {
#pragma unroll
                  for (int ks = 0; ks < 4; ++ks) pb[ks] = PFRAG(i8 + 1, ks);
                  __builtin_amdgcn_sched_barrier(0);
#pragma unroll
                  for (int ks = 0; ks < 4; ++ks) Z[i8] = __builtin_amdgcn_mfma_f32_16x16x32_bf16(pa[ks], Vf[ks], Z[i8], 0, 0, 0);
                  __builtin_amdgcn_sched_barrier(0);
                  if (i8 < 6) {
#pragma unroll
                      for (int ks = 0; ks < 4; ++ks) pa[ks] = PFRAG(i8 + 2, ks); }
                  __builtin_amdgcn_sched_barrier(0);
#pragma unroll
                  for (int ks = 0; ks < 4; ++ks) Z[i8 + 1] = __builtin_amdgcn_mfma_f32_16x16x32_bf16(pb[ks], Vf[ks], Z[i8 + 1], 0, 0, 0);
                  __builtin_amdgcn_sched_barrier(0); } }
#undef PFRAG
#pragma unroll
            for (int i8 = 0; i8 < 8; ++i8)
#pragma unroll
                for (int r = 0; r < 4; ++r) *(bf16_t*)((char*)(Yg + (size_t)(r0 + i8 * 16 + r) * VW + h * 512 + es * 128) + voffY) = bf16_1(Z[i8][r]);
            bf16x8 Vs[4];
            float kf8[8], kstep[4];
#pragma unroll
            for (int e = 0; e < 8; ++e) kf8[e] = __builtin_amdgcn_exp2f(kb2_ - (float)e * zl_);
            { const float k32 = __builtin_amdgcn_exp2f(-32.f * zl_); kstep[0] = 1.f; kstep[1] = k32; kstep[2] = k32 * k32; kstep[3] = kstep[2] * k32; }
#pragma unroll
            for (int ks = 0; ks < 4; ++ks) { const u32x4 t = __builtin_bit_cast(u32x4, Vf[ks]); float f[8]; f[0] = bf_lo(t.x); f[1] = bf_hi(t.x); f[2] = bf_lo(t.y); f[3] = bf_hi(t.y); f[4] = bf_lo(t.z); f[5] = bf_hi(t.z); f[6] = bf_lo(t.w); f[7] = bf_hi(t.w);
#pragma unroll
                for (int e = 0; e < 8; ++e) f[e] *= kf8[e] * kstep[ks];
                u32x4 o; o.x = cvt_pk_bf16(f[0], f[1]); o.y = cvt_pk_bf16(f[2], f[3]); o.z = cvt_pk_bf16(f[4], f[5]); o.w = cvt_pk_bf16(f[6], f[7]); Vs[ks] = __builtin_bit_cast(bf16x8, o); }
#define TFRAG(D, ks) (*(const LAS bf16x8*)(lds + KTOFF + xb[ks] + (8 * (fr >> 2) + (fr & 3)) * 256 + ((D) >> 1) * 8192 + ((D) & 1) * 1024))
            { bf16x8 ta[4], tb[4];
#pragma unroll
              for (int ks = 0; ks < 4; ++ks) ta[ks] = TFRAG(0, ks);
#pragma unroll
              for (int D = 0; D < 16; D += 2) { S[D] *= sdec; S[D + 1] *= sdec;
#pragma unroll
                  for (int ks = 0; ks < 4; ++ks) tb[ks] = TFRAG(D + 1, ks);
                  __builtin_amdgcn_sched_barrier(0);
#pragma unroll
                  for (int ks = 0; ks < 4; ++ks) S[D] = __builtin_amdgcn_mfma_f32_16x16x32_bf16(ta[ks], Vs[ks], S[D], 0, 0, 0);
                  __builtin_amdgcn_sched_barrier(0);
                  if (D < 14) {
#pragma unroll
                      for (int ks = 0; ks < 4; ++ks) ta[ks] = TFRAG(D + 2, ks); }
                  __builtin_amdgcn_sched_barrier(0);
#pragma unroll
                  for (int ks = 0; ks < 4; ++ks) S[D + 1] = __builtin_amdgcn_mfma_f32_16x16x32_bf16(tb[ks], Vs[ks], S[D + 1], 0, 0, 0);
                  __builtin_amdgcn_sched_barrier(0); } }
#undef TFRAG
            __syncthreads();
        }
        if (!lat) { float* so = p.out + (size_t)TT * DM + ((((size_t)bb * 2 + l) * 2 + dir) * 4 + h) * 256 * 512 + es * 128;
#pragma unroll
            for (int D = 0; D < 16; ++D)
#pragma unroll
                for (int r = 0; r < 4; ++r) __builtin_nontemporal_store(S[D][r], (float*)((char*)(so + ((D >> 1) * 32 + 4 * (D & 1) + r) * 512) + voffS)); }
    }
}

__device__ void comb_phase(const Params& p) {
    const int tid = tid_opaque(), lane = tid & 63, gw = blockIdx.x * 8 + (tid >> 6), nw = gridDim.x * 8;
    const bf16_t* yf = (const bf16_t*)(p.ws + WS_YF); const bf16_t* yb = (const bf16_t*)(p.ws + WS_YB); const bf16_t* rg = (const bf16_t*)(p.ws + WS_RG); bf16_t* ar = (bf16_t*)(p.ws + WS_Q);
    for (int tok = gw; tok < TT; tok += nw) {
        u32x4 a[4], b[4], g[4];
#pragma unroll
        for (int h = 0; h < 4; ++h) { const size_t off = (size_t)tok * VW + h * 512 + lane * 8; a[h] = __builtin_nontemporal_load((const u32x4*)(yf + off)); b[h] = __builtin_nontemporal_load((const u32x4*)(yb + off)); g[h] = __builtin_nontemporal_load((const u32x4*)(rg + off)); }
#pragma unroll
        for (int h = 0; h < 4; ++h) {
            float y[8];
#pragma unroll
            for (int e = 0; e < 4; ++e) { y[2 * e] = bf_lo(a[h][e]) + bf_lo(b[h][e]); y[2 * e + 1] = bf_hi(a[h][e]) + bf_hi(b[h][e]); }
            float s = 0.f;
#pragma unroll
            for (int e = 0; e < 8; ++e) s += y[e];
            const float mu = wave_sum(s) * (1.f / 512.f); float v = 0.f;
#pragma unroll
            for (int e = 0; e < 8; ++e) { y[e] -= mu; v += y[e] * y[e]; }
            const float rstd = rsqrtf(wave_sum(v) * (1.f / 512.f) + EPSV);
            u32x4 o;
#pragma unroll
            for (int e = 0; e < 4; ++e) o[e] = cvt_pk_bf16(y[2 * e] * rstd * bf_lo(g[h][e]), y[2 * e + 1] * rstd * bf_hi(g[h][e]));
            *(u32x4*)(ar + (size_t)tok * VW + h * 512 + lane * 8) = o;
        }
    }
}


#define XB_TMO      128
#define XB_XCNT(j)  (256  + 64 * (j))
#define XB_XSUB(j)  (1280 + 64 * (j))
#define XB_XGEN(j)  (2304 + 64 * (j))
#define XB_TOP      3328
#define XB_TOPGEN   3392
#define XCD_BAR_WORDS 3456
#define XB_SPIN_CAP (1u << 18)
__device__ __forceinline__ unsigned xb_ld(unsigned* p)              { return __hip_atomic_load(p, __ATOMIC_RELAXED, __HIP_MEMORY_SCOPE_AGENT); }
__device__ __forceinline__ unsigned xb_add(unsigned* p, unsigned v) { return __hip_atomic_fetch_add(p, v, __ATOMIC_RELAXED, __HIP_MEMORY_SCOPE_AGENT); }
__device__ __forceinline__ unsigned xb_xcc_id() { return (unsigned)__builtin_amdgcn_s_getreg((3 << 11) | 20) & 0xFu; }
#define XB_SPIN(cond, bar) do { unsigned _sp = 0; while (cond) { __builtin_amdgcn_s_sleep(1); \
    if ((++_sp & 255u) == 0u) { if (xb_ld(&(bar)[XB_TMO])) break; if (_sp > XB_SPIN_CAP) { atomicAdd(&(bar)[XB_TMO], 1u); break; } } } } while (0)
struct XcdBarrier { unsigned* bar; unsigned x; volatile LAS unsigned* st; };
__device__ __forceinline__ XcdBarrier xcd_barrier_post(unsigned* bar, volatile LAS unsigned* st) {
    XcdBarrier b; b.bar = bar; b.x = xb_xcc_id(); b.st = st;
    if (threadIdx.x == 0) (void)xb_add(&bar[XB_XCNT(b.x)], 1u);
    return b;
}
__device__ __forceinline__ void xcd_barrier_complete(unsigned* bar, unsigned x, unsigned& nloc, unsigned& nx) {
    const unsigned G = gridDim.x * gridDim.y * gridDim.z;
    unsigned sum, cnt, mine, sp = 0u;
    for (;;) {
        sum = 0u; cnt = 0u; mine = 0u;
#pragma unroll
        for (unsigned j = 0; j < 16; ++j) { const unsigned c = xb_ld(&bar[XB_XCNT(j)]); sum += c; cnt += (c > 0u) ? 1u : 0u; mine = (j == x) ? c : mine; }
        if (sum == G) break;
        __builtin_amdgcn_s_sleep(1);
        if ((++sp & 255u) == 0u) { if (xb_ld(&bar[XB_TMO])) break; if (sp > XB_SPIN_CAP) { atomicAdd(&bar[XB_TMO], 1u); break; } }
    }
    nloc = mine > 0u ? mine : 1u; nx = cnt > 0u ? cnt : 1u;
}
__device__ __forceinline__ void xcd_barrier(const XcdBarrier& b) {
    asm volatile("s_waitcnt vmcnt(0)" ::: "memory");
    __syncthreads();
    if (threadIdx.x == 0) {
        unsigned* bar = b.bar;
        __builtin_amdgcn_s_waitcnt(0);
        unsigned nloc = b.st[0], nx = b.st[1];
        if (nloc == 0u) { xcd_barrier_complete(bar, b.x, nloc, nx); b.st[0] = nloc; b.st[1] = nx; }
        const unsigned old = xb_add(&bar[XB_XSUB(b.x)], 1u);
        const unsigned gen = old / nloc;
        if (old + 1u == (gen + 1u) * nloc) {
            __builtin_amdgcn_fence(__ATOMIC_RELEASE, "agent");
            asm volatile("s_waitcnt vmcnt(0)" ::: "memory");
            const unsigned og = xb_add(&bar[XB_TOP], 1u);
            const unsigned tg = og / nx;
            if (og + 1u == (tg + 1u) * nx) xb_add(&bar[XB_TOPGEN], 1u);
            else XB_SPIN(xb_ld(&bar[XB_TOPGEN]) == tg, bar);
            __builtin_amdgcn_fence(__ATOMIC_ACQUIRE, "agent");
            xb_add(&bar[XB_XGEN(b.x)], 1u);
            asm volatile("s_waitcnt vmcnt(0)" ::: "memory");
        } else {
            XB_SPIN(xb_ld(&bar[XB_XGEN(b.x)]) == gen, bar);
            __builtin_amdgcn_fence(__ATOMIC_ACQUIRE, "agent");
            asm volatile("s_waitcnt vmcnt(0)" ::: "memory");
        }
    }
    __syncthreads();
}

__global__ void __launch_bounds__(NTHR) mega(Params p) {
    __shared__ __attribute__((aligned(16))) unsigned char smem[131072];
    cg::grid_group grid = cg::this_grid();
    LAS unsigned char* lds = (LAS unsigned char*)smem;
    unsigned char* ws = p.ws;
    float* xbuf = p.out;
    const float* modb = (const float*)(ws + WS_MOD);
    pg8::StaticOrder so;
    __shared__ __attribute__((aligned(16))) unsigned xb_st[4];
    if (threadIdx.x < 4) xb_st[threadIdx.x] = 0u;
    __syncthreads();
    if (blockIdx.x == 1) { const int t = tid_opaque(); for (int i = t; i < XCD_BAR_WORDS; i += NTHR) ((unsigned*)(ws + WS_BAR))[i] = 0u; }
    phase0(p, smem);
    grid.sync();
    const XcdBarrier xbar = xcd_barrier_post((unsigned*)(ws + WS_BAR), (volatile LAS unsigned*)xb_st);
    for (int l = 0; l < 2; ++l) {
        const unsigned char* wl = ws + WS_W + (size_t)l * WL_SZ;
        const float* modl = modb + (size_t)l * 9 * 6144;
        const float* xa = l == 0 ? p.in[0] : xbuf; const float* xb = l == 0 ? p.in[1] : xbuf + (size_t)TC * DM;
        norm_mod_phase(xa, xb, (bf16_t*)(ws + WS_R1), p.in[5] + l * DM, modl, 0);
        xcd_barrier(xbar);
        { pg8::Gemm g{(const bf16_t*)(ws + WS_R1), (const bf16_t*)(wl + WL_IN), TT, PW, DM, nullptr, nullptr}; so.init(TT, PW, gridDim.x, blockIdx.x);
          EpiG1 e{(bf16_t*)(ws + WS_R2), (bf16_t*)(ws + WS_Q), (bf16_t*)(ws + WS_K), (bf16_t*)(ws + WS_KT), (bf16_t*)(ws + WS_VT), (bf16_t*)(ws + WS_RG), (bf16_t*)(ws + WS_GATE), (const float*)(ws + WS_ROPE), (const float*)(ws + WS_ROPE) + 4096};
          pg8::gemm_phase(lds, g, so, e); }
        xcd_barrier(xbar);
        ret_phase(p, l, smem);
        conv_phase(p, l, smem);
        xcd_barrier(xbar);
        { pg8::Gemm g{(const bf16_t*)(ws + WS_R1), (const bf16_t*)(wl + WL_CONV), TT, DM, DM, (unsigned long long*)(ws + WS_DUMP), (unsigned*)(ws + WS_CNT)}; so.init(TT, DM, gridDim.x, blockIdx.x, true);
          EpiE1 e{(bf16_t*)(ws + WS_KT), (const bf16_t*)(ws + WS_GATE)};
          comb_phase(p);
          __syncthreads();
          pg8::gemm_phase(lds, g, so, e); }
        xcd_barrier(xbar);
        { pg8::Gemm g{(const bf16_t*)(ws + WS_Q), (const bf16_t*)(wl + WL_RET), TT, DM, VW, (unsigned long long*)(ws + WS_DUMP), (unsigned*)(ws + WS_CNT)}; so.init(TT, DM, gridDim.x, blockIdx.x, true);
          EpiE2 e{(const bf16_t*)(ws + WS_KT), (const bf16_t*)(ws + WS_GATE), (bf16_t*)(ws + WS_R2)};
          pg8::gemm_phase(lds, g, so, e); }
        xcd_barrier(xbar);
        { pg8::Gemm g{(const bf16_t*)(ws + WS_R2), (const bf16_t*)(wl + WL_OUT), TT, DM, DM, (unsigned long long*)(ws + WS_DUMP), (unsigned*)(ws + WS_CNT)}; so.init(TT, DM, gridDim.x, blockIdx.x, true);
          EpiResT<true> e{xa, xb, xbuf, modl + 2 * 1024};
          pg8::gemm_phase(lds, g, so, e); }
        xcd_barrier(xbar);
        norm_mod_phase(xbuf, xbuf + (size_t)TC * DM, (bf16_t*)(ws + WS_R1), p.in[6] + l * DM, modl, 3);
        xcd_barrier(xbar);
        { pg8::Gemm g{(const bf16_t*)(ws + WS_R1), (const bf16_t*)(wl + WL_M1), TT, MLPW, DM, nullptr, nullptr}; so.init(TT, MLPW, gridDim.x, blockIdx.x);
          EpiF1 e{(bf16_t*)(ws + WS_RG)};
          pg8::gemm_phase(lds, g, so, e); }
        xcd_barrier(xbar);
        { pg8::Gemm g{(const bf16_t*)(ws + WS_RG), (const bf16_t*)(wl + WL_M2), TT, DM, MLPW, (unsigned long long*)(ws + WS_DUMP), (unsigned*)(ws + WS_CNT)}; so.init(TT, DM, gridDim.x, blockIdx.x, true);
          EpiResT<true> e{xbuf, xbuf + (size_t)TC * DM, xbuf, modl + 5 * 1024};
          pg8::gemm_phase(lds, g, so, e); }
        xcd_barrier(xbar);
    }
    final_norm_phase(xbuf, p.in[19]);
}

extern "C" void kernel_launch(void* const* d_in, const int* in_sizes, int n_in, void* d_out, int out_size, void* d_ws, size_t ws_size, hipStream_t stream) {
    static int grid_blocks = 0;
    if (!grid_blocks) {
        int dev = 0, cus = 0, per_cu = 0;
        (void)hipGetDevice(&dev);
        (void)hipDeviceGetAttribute(&cus, hipDeviceAttributeMultiprocessorCount, dev);
        (void)hipOccupancyMaxActiveBlocksPerMultiprocessor(&per_cu, mega, NTHR, 0);
        if (per_cu < 1) per_cu = 1;
        grid_blocks = cus;
    }
    if (n_in != 20 || ws_size < WS_END) return;
    Params p{};
    for (int i = 0; i < 20; ++i) p.in[i] = (const float*)d_in[i];
    p.out = (float*)d_out; p.ws = (unsigned char*)d_ws;
    void* args[] = {&p};
    (void)hipLaunchCooperativeKernel((void*)mega, dim3(grid_blocks), dim3(NTHR), args, 0, stream);
}
```

```cpp
#include <hip/hip_runtime.h>
#include <hip/hip_cooperative_groups.h>
namespace cg = cooperative_groups;

#define LAS __attribute__((address_space(3)))
typedef unsigned short bf16_t;
typedef short bf16x8 __attribute__((ext_vector_type(8)));
typedef float f32x4 __attribute__((ext_vector_type(4)));
typedef float f32x2 __attribute__((ext_vector_type(2)));
typedef unsigned u32x2 __attribute__((ext_vector_type(2)));
typedef unsigned u32x4 __attribute__((ext_vector_type(4)));

constexpr int DM = 1024, TC = 4096, TL = 16384, TT = 20480, PW = 10240, MLPW = 4096, VW = 2048;
constexpr int NTHR = 512;
constexpr float EPSV = 1e-6f;
constexpr size_t MiB = (size_t)1 << 20;
constexpr size_t WS_W = 0;
constexpr size_t WL_IN = 0, WL_CONV = 20 * MiB, WL_RET = 22 * MiB, WL_OUT = 26 * MiB, WL_M1 = 28 * MiB, WL_M2 = 36 * MiB, WL_SZ = 44 * MiB;
constexpr size_t WS_MOD = 88 * MiB;
constexpr size_t WS_ROPE = 88 * MiB + 512 * 1024;
constexpr size_t WS_R1 = 90 * MiB;
constexpr size_t WS_R2 = 130 * MiB;
constexpr size_t WS_Q = 170 * MiB;
constexpr size_t WS_K = 210 * MiB;
constexpr size_t WS_KT = 250 * MiB;
constexpr size_t WS_VT = 290 * MiB;
constexpr size_t WS_RG = 370 * MiB;
constexpr size_t WS_GATE = 450 * MiB;
constexpr size_t WS_YF = 530 * MiB;
constexpr size_t WS_YB = 610 * MiB;
constexpr size_t WS_BAR = 88 * MiB + 448 * 1024;
constexpr size_t WS_DUMP = 690 * MiB;
constexpr size_t WS_CNT = 88 * MiB + 480 * 1024;
constexpr size_t WS_END = 754 * MiB;

struct Params { const float* in[20]; float* out; unsigned char* ws; };

typedef __bf16 bf16x2_t __attribute__((ext_vector_type(2)));
__device__ __forceinline__ unsigned cvt_pk_bf16(float lo, float hi) { const f32x2 f = {lo, hi}; const bf16x2_t v = __builtin_convertvector(f, bf16x2_t); return __builtin_bit_cast(unsigned, v); }
__device__ __forceinline__ float bf_lo(unsigned u) { return __uint_as_float(u << 16); }
__device__ __forceinline__ float bf_hi(unsigned u) { return __uint_as_float(u & 0xffff0000u); }
__device__ __forceinline__ float sigmoidf_(float x) { return __builtin_amdgcn_rcpf(1.f + __expf(-x)); }
__device__ __forceinline__ float siluf_(float x) { return x * sigmoidf_(x); }
__device__ __forceinline__ float wave_sum(float v) {
#pragma unroll
    for (int o = 32; o > 0; o >>= 1) v += __shfl_xor(v, o, 64);
    return v;
}
__device__ __forceinline__ int tid_opaque() { int t = threadIdx.x; asm volatile("" : "+v"(t)); return t; }
__device__ __forceinline__ int row_group(int row) { return row < TC ? 0 : 1 + ((row - TC) >> 11); }

namespace pg8 {
constexpr int BM = 256, BK = 64, HALF = 128, HTB = HALF * BK * 2, NXCD = 8, WGM = 8;
__device__ __forceinline__ int lds_byte(int r, int c) { const int st = (r >> 4) * 2 + (c >> 5), rr = r & 15, cc = c & 31, ob = rr * 64 + cc * 2; return st * 1024 + (ob ^ (((ob >> 9) & 1) << 5)); }
__device__ __forceinline__ void stage_rc(int b, int& R, int& C) { const int st = b / 1024, sb = b % 1024, swz = sb ^ (((sb >> 9) & 1) << 5); R = (st >> 1) * 16 + swz / 64; C = (st & 1) * 32 + (swz % 64) / 2; }
__device__ __forceinline__ int perm32(int rho) { const int n = rho >> 4, i = rho & 15; return 8 * (i >> 2) + 4 * n + (i & 3); }
struct Unit { int pm, pn, kq, ti; };
struct Gemm { const bf16_t* A; const bf16_t* Bt; int M, N, K; unsigned long long* dump; unsigned* cnt; };
struct StaticOrder {
    int nM, nN, nwg, G, c; bool split;
    __device__ void init(int M, int N, int G_, int c_, bool allow_split = false) { nM = M / BM; nN = N / BM; nwg = nM * nN; G = G_; c = c_; split = allow_split && nwg == 320 && G == 256; }
    __device__ bool next(int i, Unit& u) const {
        if (split) {
            const int x = c & 7, j = c >> 3;
            if (i == 0) { u.pm = x * 8 + (j & 7); u.pn = j >> 3; u.kq = -1; u.ti = 0; return true; }
            if (i == 1) { u.kq = x & 3; u.pm = 64 + (x >> 2) * 8 + (j >> 2); u.pn = j & 3; u.ti = (u.pm - 64) * 4 + u.pn; return true; }
            return false;
        }
        const long L = (long)i * G + c;
        if (L >= nwg) return false;
        int wgid = (int)L; { const int q = nwg / NXCD, r = nwg % NXCD, xcd = wgid % NXCD, off = wgid / NXCD; wgid = (xcd < r ? xcd * (q + 1) : r * (q + 1) + (xcd - r) * q) + off; }
        const int nig = WGM * nN, gid = wgid / nig, fm = gid * WGM, gsz = (nM - fm) < WGM ? (nM - fm) : WGM;
        u.pm = fm + ((wgid % nig) % gsz); u.pn = (wgid % nig) / gsz; u.kq = -1; u.ti = 0; return true;
    }
};

template <class Epi>
__device__ __forceinline__ void gemm_phase(LAS unsigned char* lds, const Gemm g, const StaticOrder& S, const Epi& E) {
    const int tid = tid_opaque(), wid = __builtin_amdgcn_readfirstlane(tid >> 6), lane = tid & 63, wr = wid >> 2, wc = wid & 3, fr = lane & 15, fq = lane >> 4;
    const int K = g.K;
    unsigned voffA[2], voffB[2];
#pragma unroll
    for (int i = 0; i < 2; ++i) { int R, C; stage_rc(tid * 16 + i * 8192, R, C); const int Rb = (R & ~31) + perm32(R & 31); voffA[i] = (unsigned)(R * K + C) * 2u; voffB[i] = (unsigned)(Rb * K + C) * 2u; }
    const size_t kstep = (size_t)(BK * 2);
    const size_t hstep = (size_t)HALF * K * 2;
    const size_t tstep = 2 * hstep;
    const unsigned ldsw = (unsigned)wid * 1024u;
    const int aoff = lds_byte(wr * 64 + fr, fq * 8), boff = lds_byte(wc * 32 + fr, fq * 8);
#define PG8_SA(b, h) (((b) * 2 + (h)) * HTB)
#define PG8_SB(b, h) ((4 + (b) * 2 + (h)) * HTB)
#define PG8_STAGE(bufoff, gbase, voff) do { _Pragma("unroll") for (int _i = 0; _i < 2; ++_i) \
        __builtin_amdgcn_global_load_lds((const unsigned*)((const char*)(gbase) + (voff)[_i]), (LAS unsigned*)(lds + (bufoff) + ldsw + _i * 8192), 16, 0, 0); } while (0)
#define PG8_LDA(dst, b, h) do { _Pragma("unroll") for (int m = 0; m < 4; ++m) _Pragma("unroll") for (int k = 0; k < 2; ++k) dst[m][k] = *(const LAS bf16x8*)(lds + PG8_SA(b, h) + aoff + m * 2048 + k * 1024); } while (0)
#define PG8_LDB(dst, b, h) do { _Pragma("unroll") for (int n = 0; n < 2; ++n) _Pragma("unroll") for (int k = 0; k < 2; ++k) dst[n][k] = *(const LAS bf16x8*)(lds + PG8_SB(b, h) + boff + n * 2048 + k * 1024); } while (0)
#define PG8_MMA(ai, bj, At, Bt) do { __builtin_amdgcn_s_setprio(1); _Pragma("unroll") for (int m = 0; m < 4; ++m) _Pragma("unroll") for (int n = 0; n < 2; ++n) _Pragma("unroll") for (int k = 0; k < 2; ++k) \
        acc[ai][bj][m][n] = __builtin_amdgcn_mfma_f32_16x16x32_bf16(Bt[n][k], At[m][k], acc[ai][bj][m][n], 0, 0, 0); __builtin_amdgcn_s_setprio(0); } while (0)
#define PG8_WAIT_V(n) asm volatile("s_waitcnt vmcnt(" #n ")" ::: "memory")
#define PG8_WAIT_L(n) asm volatile("s_waitcnt lgkmcnt(" #n ")" ::: "memory")
#define PG8_BAR __builtin_amdgcn_s_barrier()
#define PG8_SCHED __builtin_amdgcn_sched_barrier(0)
    Unit cur, nxt; int ui = 0;
    if (!S.next(0, cur)) return;
    f32x4 acc[2][2][4][2];
#pragma unroll
    for (int a = 0; a < 2; ++a)
#pragma unroll
        for (int b = 0; b < 2; ++b)
#pragma unroll
            for (int m = 0; m < 4; ++m)
#pragma unroll
                for (int n = 0; n < 2; ++n) acc[a][b][m][n] = (f32x4){0.f, 0.f, 0.f, 0.f};
    bf16x8 At[4][2], B0[2][2], B1[2][2];
    const char* cA = E.swapped(cur) ? (const char*)g.Bt + (size_t)cur.pn * tstep : (const char*)g.A + (size_t)cur.pm * tstep;
    const char* cB = E.swapped(cur) ? (const char*)g.A + (size_t)cur.pm * tstep : (const char*)g.Bt + (size_t)cur.pn * tstep;
    const size_t qstep = (size_t)(K >> 2) * 2;
    if (cur.kq >= 0) { cA += cur.kq * qstep; cB += cur.kq * qstep; }
    PG8_STAGE(PG8_SB(0, 0), cB, voffB); PG8_STAGE(PG8_SA(0, 0), cA, voffA); PG8_STAGE(PG8_SB(0, 1), cB + hstep, voffB); PG8_STAGE(PG8_SA(0, 1), cA + hstep, voffA);
    if (wr == 1) PG8_BAR;
    PG8_WAIT_V(4); PG8_BAR;
    PG8_STAGE(PG8_SB(1, 0), cB + kstep, voffB); PG8_STAGE(PG8_SA(1, 0), cA + kstep, voffA); PG8_STAGE(PG8_SB(1, 1), cB + hstep + kstep, voffB);
    PG8_WAIT_V(6); PG8_BAR;
    for (;;) {
        const bool has_next = S.next(ui + 1, nxt);
        const bool nsw = has_next && E.swapped(nxt);
        const char* nA = has_next ? (nsw ? (const char*)g.Bt + (size_t)nxt.pn * tstep : (const char*)g.A + (size_t)nxt.pm * tstep) : cA;
        const char* nB = has_next ? (nsw ? (const char*)g.A + (size_t)nxt.pm * tstep : (const char*)g.Bt + (size_t)nxt.pn * tstep) : cB;
        if (has_next && nxt.kq >= 0) { nA += nxt.kq * qstep; nB += nxt.kq * qstep; }
        const int nt = (cur.kq >= 0 ? (K >> 2) : K) / BK;
        for (int t = 0; t < nt; t += 2) {
            const bool last = (t == nt - 2);
            const char* a1 = cA + (size_t)(t + 1) * kstep;
            const char* a2 = last ? nA : cA + (size_t)(t + 2) * kstep; const char* b2 = last ? nB : cB + (size_t)(t + 2) * kstep;
            const char* a3 = a2 + kstep; const char* b3 = b2 + kstep;
            PG8_LDB(B0, 0, 0); PG8_SCHED; PG8_LDA(At, 0, 0); PG8_STAGE(PG8_SA(1, 1), a1 + hstep, voffA);
            PG8_WAIT_L(8); PG8_BAR; PG8_WAIT_L(0); PG8_MMA(0, 0, At, B0); PG8_BAR; PG8_SCHED;
            PG8_LDB(B1, 0, 1); PG8_STAGE(PG8_SB(0, 0), b2, voffB);
            PG8_BAR; PG8_WAIT_L(0); PG8_MMA(0, 1, At, B1); PG8_BAR;
            PG8_LDA(At, 0, 1); PG8_STAGE(PG8_SA(0, 0), a2, voffA);
            PG8_BAR; PG8_WAIT_L(0); PG8_MMA(1, 0, At, B0); PG8_BAR; PG8_SCHED;
            PG8_STAGE(PG8_SB(0, 1), b2 + hstep, voffB);
            PG8_WAIT_V(6); PG8_BAR; PG8_MMA(1, 1, At, B1); PG8_BAR;
            PG8_LDB(B0, 1, 0); PG8_SCHED; PG8_LDA(At, 1, 0); PG8_STAGE(PG8_SA(0, 1), a2 + hstep, voffA);
            PG8_WAIT_L(8); PG8_BAR; PG8_WAIT_L(0); PG8_MMA(0, 0, At, B0); PG8_BAR; PG8_SCHED;
            PG8_LDB(B1, 1, 1); PG8_STAGE(PG8_SB(1, 0), b3, voffB);
            PG8_BAR; PG8_WAIT_L(0); PG8_MMA(0, 1, At, B1); PG8_BAR;
            PG8_LDA(At, 1, 1); PG8_STAGE(PG8_SA(1, 0), a3, voffA);
            PG8_BAR; PG8_WAIT_L(0); PG8_MMA(1, 0, At, B0); PG8_BAR; PG8_SCHED;
            PG8_STAGE(PG8_SB(1, 1), b3 + hstep, voffB);
            PG8_WAIT_V(6); PG8_BAR; PG8_MMA(1, 1, At, B1); PG8_BAR;
        }
        if (cur.kq < 0) E(acc, cur, wr, wc, fr, fq);
        if (!has_next) break;
#pragma unroll
        for (int a = 0; a < 2; ++a)
#pragma unroll
            for (int b = 0; b < 2; ++b)
#pragma unroll
                for (int m = 0; m < 4; ++m)
#pragma unroll
                    for (int n = 0; n < 2; ++n) acc[a][b][m][n] = (f32x4){0.f, 0.f, 0.f, 0.f};
        cur = nxt; cA = nA; cB = nB; ++ui;
    }
    PG8_WAIT_V(0);
    if (wr == 0) PG8_BAR;
    PG8_BAR;
    if constexpr (Epi::SPLIT) {
    if (cur.kq >= 0) {
        const __amdgpu_buffer_rsrc_t drs = __builtin_amdgcn_make_buffer_rsrc((void*)(g.dump + (size_t)cur.ti * 4 * (64 * 512)), 0, 4 * 64 * 512 * 8, 0x00020000);
        unsigned lo = (unsigned)tid * 16u;
        { const unsigned qo = (unsigned)cur.kq * (64 * 512 * 8);
#pragma unroll
          for (int a = 0; a < 2; ++a)
#pragma unroll
              for (int b = 0; b < 2; ++b)
#pragma unroll
                  for (int m = 0; m < 4; ++m)
#pragma unroll
                      for (int n = 0; n < 2; ++n) { if (((a * 4 + m) >> 1) == cur.kq) continue;
                          asm volatile("" : "+v"(lo));
                          __builtin_amdgcn_raw_buffer_store_b128(__builtin_bit_cast(u32x4, acc[a][b][m][n]), drs, qo + (unsigned)((((a * 2 + b) * 4 + m) * 2 + n) * (512 * 16)) + lo, 0,   16); } }
        asm volatile("s_waitcnt vmcnt(0)" ::: "memory");
        __syncthreads();
        if (tid == 0) { __hip_atomic_fetch_add(g.cnt + 2 * cur.ti, 1u, __ATOMIC_RELAXED, __HIP_MEMORY_SCOPE_AGENT);
            unsigned spins = 0; while (__hip_atomic_load(g.cnt + 2 * cur.ti, __ATOMIC_RELAXED, __HIP_MEMORY_SCOPE_AGENT) < 4u) { __builtin_amdgcn_s_sleep(2); if (++spins > (1u << 22)) break; } }
        __syncthreads();
#pragma unroll
        for (int a = 0; a < 2; ++a)
#pragma unroll
            for (int m = 0; m < 4; ++m) { if (((a * 4 + m) >> 1) != cur.kq) continue;
                f32x4 v[2][2];
#pragma unroll
                for (int b = 0; b < 2; ++b)
#pragma unroll
                    for (int n = 0; n < 2; ++n) { asm volatile("" : "+v"(lo)); const unsigned o = (unsigned)((((a * 2 + b) * 4 + m) * 2 + n) * (512 * 16)) + lo;
                        f32x4 pq[4];
#pragma unroll
                        for (int q = 0; q < 4; ++q) pq[q] = (q == cur.kq) ? acc[a][b][m][n] : __builtin_bit_cast(f32x4, __builtin_amdgcn_raw_buffer_load_b128(drs, o + q * (64 * 512 * 8), 0, 16));
                        v[b][n] = (pq[0] + pq[1]) + (pq[2] + pq[3]); }
                E.rg(a, m, v, cur, wr, wc, fr, fq); }
        asm volatile("s_waitcnt vmcnt(0)" ::: "memory");
        __syncthreads();
        if (tid == 0) { const unsigned old = __hip_atomic_fetch_add(g.cnt + 2 * cur.ti + 1, 1u, __ATOMIC_RELAXED, __HIP_MEMORY_SCOPE_AGENT);
            if (old == 3u) { __hip_atomic_store(g.cnt + 2 * cur.ti, 0u, __ATOMIC_RELAXED, __HIP_MEMORY_SCOPE_AGENT); __hip_atomic_store(g.cnt + 2 * cur.ti + 1, 0u, __ATOMIC_RELAXED, __HIP_MEMORY_SCOPE_AGENT); } }
        __syncthreads();
    }
    }
#undef PG8_SA
#undef PG8_SB
#undef PG8_STAGE
#undef PG8_LDA
#undef PG8_LDB
#undef PG8_MMA
#undef PG8_WAIT_V
#undef PG8_WAIT_L
#undef PG8_BAR
#undef PG8_SCHED
}
}
using pg8::Unit;
typedef const f32x4 (&AccRef)[2][2][4][2];

__device__ __forceinline__ void st_bf16x4(bf16_t* p, f32x4 v) { u32x2 w; w.x = cvt_pk_bf16(v[0], v[1]); w.y = cvt_pk_bf16(v[2], v[3]); *(u32x2*)p = w; }
__device__ __forceinline__ void st_bf16x8(bf16_t* p, f32x4 a, f32x4 b) { u32x4 w; w.x = cvt_pk_bf16(a[0], a[1]); w.y = cvt_pk_bf16(a[2], a[3]); w.z = cvt_pk_bf16(b[0], b[1]); w.w = cvt_pk_bf16(b[2], b[3]); *(u32x4*)p = w; }
__device__ __forceinline__ bf16_t bf16_1(float v) { return (bf16_t)(cvt_pk_bf16(v, 0.f) & 0xffffu); }

struct EpiG1 {
    static constexpr bool SPLIT = false;
    __device__ __forceinline__ bool swapped(const Unit& u) const { return u.pn >= 16 && u.pn < 24; }
    bf16_t *aglu, *q, *k, *kt, *vt, *rg, *gate; const float *rcos, *rsin;
    __device__ __forceinline__ void operator()(AccRef acc, const Unit& u, int wr, int wc, int fr, int fq) const {
        const int pn = u.pn, row0 = u.pm * 256 + wr * 64 + fr, ct = wc * 32 + 8 * fq;
        if (pn < 8) {
#pragma unroll
            for (int ai = 0; ai < 2; ++ai)
#pragma unroll
                for (int m = 0; m < 4; ++m) { const int row = row0 + ai * 128 + m * 16; f32x4 o[2];
#pragma unroll
                    for (int n = 0; n < 2; ++n) { const f32x4 a = acc[ai][0][m][n], b = acc[ai][1][m][n];
#pragma unroll
                        for (int r = 0; r < 4; ++r) o[n][r] = a[r] * sigmoidf_(b[r]); }
                    st_bf16x8(aglu + (size_t)row * DM + pn * 128 + ct, o[0], o[1]); }
        } else if (pn < 16) {
            const bool isK = pn >= 12; const int h = (pn - 8) & 3; const float sc = isK ? 0.0625f : 1.0f; bf16_t* dst = isK ? k : q;
#pragma unroll
            for (int ai = 0; ai < 2; ++ai)
#pragma unroll
                for (int m = 0; m < 4; ++m) { const int row = row0 + ai * 128 + m * 16; const bool lat = row >= TC; const int pos = (row - TC) & 2047, gr = pos >> 6, gc = pos & 63; f32x4 o1[2], o2[2];
#pragma unroll
                    for (int n = 0; n < 2; ++n) { const int d1 = ct + n * 4; const f32x4 x1 = acc[ai][0][m][n] * sc, x2 = acc[ai][1][m][n] * sc; o1[n] = x1; o2[n] = x2;
                        if (lat) { const int ti = (d1 < 64) ? gr * 64 + d1 : gc * 64 + d1 - 64; const f32x4 cs = *(const f32x4*)(rcos + ti), sn = *(const f32x4*)(rsin + ti);
                            o1[n] = x1 * cs - x2 * sn; o2[n] = x2 * cs + x1 * sn; }
                        if (isK) {
#pragma unroll
                            for (int r = 0; r < 4; ++r) { kt[(size_t)(h * 256 + d1 + r) * TT + row] = bf16_1(o1[n][r]); kt[(size_t)(h * 256 + 128 + d1 + r) * TT + row] = bf16_1(o2[n][r]); } } }
                    st_bf16x8(dst + (size_t)row * DM + h * 256 + ct, o1[0], o1[1]); st_bf16x8(dst + (size_t)row * DM + h * 256 + 128 + ct, o2[0], o2[1]); }
        } else if (pn < 24) {
            const int e0 = (pn - 16) * 256 + wr * 64 + fr, t0 = u.pm * 256 + ct;
#pragma unroll
            for (int ai = 0; ai < 2; ++ai)
#pragma unroll
                for (int m = 0; m < 4; ++m) { bf16_t* vr = vt + (size_t)(e0 + ai * 128 + m * 16) * TT + t0;
#pragma unroll
                    for (int bj = 0; bj < 2; ++bj) st_bf16x8(vr + bj * 128, acc[ai][bj][m][0], acc[ai][bj][m][1]); }
        } else {
            const bool isG = pn >= 32; bf16_t* dst = isG ? gate : rg; const int cb = ((pn - 24) & 7) * 256;
#pragma unroll
            for (int ai = 0; ai < 2; ++ai)
#pragma unroll
                for (int m = 0; m < 4; ++m) { const int row = row0 + ai * 128 + m * 16;
#pragma unroll
                    for (int bj = 0; bj < 2; ++bj) { f32x4 o[2];
#pragma unroll
                        for (int n = 0; n < 2; ++n) { const f32x4 v = acc[ai][bj][m][n];
#pragma unroll
                            for (int r = 0; r < 4; ++r) { const float s = sigmoidf_(v[r]); o[n][r] = isG ? s : v[r] * s; } }
                        st_bf16x8(dst + (size_t)row * VW + cb + bj * 128 + ct, o[0], o[1]); } }
        }
    }
};

struct EpiE1 {
    static constexpr bool SPLIT = true;
    __device__ __forceinline__ bool swapped(const Unit&) const { return false; }
    bf16_t* m1; const bf16_t* gate;
    __device__ __forceinline__ void rg(int ai, int m, const f32x4 (&v)[2][2], const Unit& u, int wr, int wc, int fr, int fq) const {
        const int row = u.pm * 256 + wr * 64 + fr + ai * 128 + m * 16, col0 = u.pn * 256 + wc * 32 + 8 * fq;
#pragma unroll
        for (int bj = 0; bj < 2; ++bj) { const int col = col0 + bj * 128; const u32x4 gv = *(const u32x4*)(gate + (size_t)row * VW + col); const f32x4 v0 = v[bj][0], v1 = v[bj][1];
            f32x4 o0, o1; o0[0] = v0[0] * bf_lo(gv.x); o0[1] = v0[1] * bf_hi(gv.x); o0[2] = v0[2] * bf_lo(gv.y); o0[3] = v0[3] * bf_hi(gv.y);
            o1[0] = v1[0] * bf_lo(gv.z); o1[1] = v1[1] * bf_hi(gv.z); o1[2] = v1[2] * bf_lo(gv.w); o1[3] = v1[3] * bf_hi(gv.w);
            st_bf16x8(m1 + (size_t)row * DM + col, o0, o1); }
    }
    __device__ __forceinline__ void operator()(AccRef acc, const Unit& u, int wr, int wc, int fr, int fq) const {
#pragma unroll
        for (int a = 0; a < 2; ++a)
#pragma unroll
            for (int m = 0; m < 4; ++m) { const f32x4 v[2][2] = {{acc[a][0][m][0], acc[a][0][m][1]}, {acc[a][1][m][0], acc[a][1][m][1]}}; rg(a, m, v, u, wr, wc, fr, fq); }
    }
};
struct EpiE2 {
    static constexpr bool SPLIT = true;
    __device__ __forceinline__ bool swapped(const Unit&) const { return false; }
    const bf16_t* m1; const bf16_t* gate; bf16_t* mm;
    __device__ __forceinline__ void rg(int ai, int m, const f32x4 (&v)[2][2], const Unit& u, int wr, int wc, int fr, int fq) const {
        const int row = u.pm * 256 + wr * 64 + fr + ai * 128 + m * 16, col0 = u.pn * 256 + wc * 32 + 8 * fq;
#pragma unroll
        for (int bj = 0; bj < 2; ++bj) { const int col = col0 + bj * 128; const u32x4 gv = *(const u32x4*)(gate + (size_t)row * VW + DM + col), mv = *(const u32x4*)(m1 + (size_t)row * DM + col); const f32x4 v0 = v[bj][0], v1 = v[bj][1];
            f32x4 o0, o1; o0[0] = bf_lo(mv.x) + v0[0] * bf_lo(gv.x); o0[1] = bf_hi(mv.x) + v0[1] * bf_hi(gv.x); o0[2] = bf_lo(mv.y) + v0[2] * bf_lo(gv.y); o0[3] = bf_hi(mv.y) + v0[3] * bf_hi(gv.y);
            o1[0] = bf_lo(mv.z) + v1[0] * bf_lo(gv.z); o1[1] = bf_hi(mv.z) + v1[1] * bf_hi(gv.z); o1[2] = bf_lo(mv.w) + v1[2] * bf_lo(gv.w); o1[3] = bf_hi(mv.w) + v1[3] * bf_hi(gv.w);
            st_bf16x8(mm + (size_t)row * DM + col, o0, o1); }
    }
    __device__ __forceinline__ void operator()(AccRef acc, const Unit& u, int wr, int wc, int fr, int fq) const {
#pragma unroll
        for (int a = 0; a < 2; ++a)
#pragma unroll
            for (int m = 0; m < 4; ++m) { const f32x4 v[2][2] = {{acc[a][0][m][0], acc[a][0][m][1]}, {acc[a][1][m][0], acc[a][1][m][1]}}; rg(a, m, v, u, wr, wc, fr, fq); }
    }
};
template <bool SPLIT_> struct EpiResT {
    static constexpr bool SPLIT = SPLIT_;
    __device__ __forceinline__ bool swapped(const Unit&) const { return false; }
    const float *xa, *xb; float* xout; const float* gvec;
    __device__ __forceinline__ void rg(int ai, int m, const f32x4 (&v)[2][2], const Unit& u, int wr, int wc, int fr, int fq) const {
        const int row = u.pm * 256 + wr * 64 + fr + ai * 128 + m * 16, col0 = u.pn * 256 + wc * 32 + 8 * fq;
        const float* xr = row < TC ? xa + (size_t)row * DM : xb + (size_t)(row - TC) * DM; const float* gr = gvec + row_group(row) * 6144;
#pragma unroll
        for (int bj = 0; bj < 2; ++bj)
#pragma unroll
            for (int n = 0; n < 2; ++n) { const int col = col0 + bj * 128 + n * 4; const f32x4 xv = *(const f32x4*)(xr + col), gv = *(const f32x4*)(gr + col);
                *(f32x4*)(xout + (size_t)row * DM + col) = xv + gv * v[bj][n]; }
    }
    __device__ __forceinline__ void operator()(AccRef acc, const Unit& u, int wr, int wc, int fr, int fq) const {
#pragma unroll
        for (int a = 0; a < 2; ++a)
#pragma unroll
            for (int m = 0; m < 4; ++m) { const f32x4 v[2][2] = {{acc[a][0][m][0], acc[a][0][m][1]}, {acc[a][1][m][0], acc[a][1][m][1]}}; rg(a, m, v, u, wr, wc, fr, fq); }
    }
};
struct EpiF1 {
    static constexpr bool SPLIT = false;
    __device__ __forceinline__ bool swapped(const Unit&) const { return false; }
    bf16_t* uo;
    __device__ __forceinline__ void operator()(AccRef acc, const Unit& u, int wr, int wc, int fr, int fq) const {
        const int row0 = u.pm * 256 + wr * 64 + fr, col0 = u.pn * 256 + wc * 32 + 8 * fq;
#pragma unroll
        for (int ai = 0; ai < 2; ++ai)
#pragma unroll
            for (int m = 0; m < 4; ++m) { const int row = row0 + ai * 128 + m * 16;
#pragma unroll
                for (int bj = 0; bj < 2; ++bj) { f32x4 o[2];
#pragma unroll
                    for (int n = 0; n < 2; ++n) { const f32x4 v = acc[ai][bj][m][n];
#pragma unroll
                        for (int r = 0; r < 4; ++r) { const float t = fmaxf(v[r], 0.f); o[n][r] = t * t; } }
                    st_bf16x8(uo + (size_t)row * MLPW + col0 + bj * 128, o[0], o[1]); } }
    }
};

__device__ __forceinline__ void tconv_item(const float* __restrict__ src, bf16_t* __restrict__ dst, int K, int N, int item, bool permIn, float* tile  ) {
    const int tilesN = N >> 8, kt = item / tilesN, ntile = item - kt * tilesN, k0 = kt * 64, n0 = ntile * 256, tid = tid_opaque();
    { const int r = tid >> 6, c4 = (tid & 63) * 4; f32x4 v[8];
#pragma unroll
      for (int rr = 0; rr < 8; ++rr) v[rr] = __builtin_nontemporal_load((const f32x4*)(src + (size_t)(k0 + r + rr * 8) * N + n0 + c4));
#pragma unroll
      for (int rr = 0; rr < 8; ++rr) { float* t = tile + (r + rr * 8) * 257 + c4; t[0] = v[rr][0]; t[1] = v[rr][1]; t[2] = v[rr][2]; t[3] = v[rr][3]; } }
    __syncthreads();
#pragma unroll
    for (int q = 0; q < 4; ++q) { const int n = q * 64 + (tid >> 3), k8 = (tid & 7) * 8; float v[8];
#pragma unroll
      for (int e = 0; e < 8; ++e) v[e] = tile[(k8 + e) * 257 + n];
      int nn = n0 + n;
      if (permIn && nn < 2048) { const int c = nn & 1023, half = nn >> 10; nn = (c >> 7) * 256 + half * 128 + (c & 127); }
      u32x4 w; w.x = cvt_pk_bf16(v[0], v[1]); w.y = cvt_pk_bf16(v[2], v[3]); w.z = cvt_pk_bf16(v[4], v[5]); w.w = cvt_pk_bf16(v[6], v[7]);
      *(u32x4*)(dst + (size_t)nn * K + k0 + k8) = w; }
    __syncthreads();
}

__device__ void phase0(const Params& p, unsigned char* smem) {
    float* tile = (float*)smem;
    float* scond = (float*)(smem + 66048);
    float* red = (float*)(smem + 66048 + 36864);
    const int tid = tid_opaque();
    constexpr int NT_L = 1408, NT = 2 * NT_L, NMOD = 192;
    for (int it = blockIdx.x; it < NT + NMOD + 1; it += gridDim.x) {
        if (it < NT) {
            const int l = it / NT_L; int j = it - l * NT_L; unsigned char* wb = p.ws + WS_W + (size_t)l * WL_SZ;
            if (j < 640) tconv_item(p.in[9] + (size_t)l * DM * PW, (bf16_t*)(wb + WL_IN), DM, PW, j, true, tile);
            else if ((j -= 640) < 64) tconv_item(p.in[13] + (size_t)l * DM * DM, (bf16_t*)(wb + WL_CONV), DM, DM, j, false, tile);
            else if ((j -= 64) < 128) tconv_item(p.in[15] + (size_t)l * VW * DM, (bf16_t*)(wb + WL_RET), VW, DM, j, false, tile);
            else if ((j -= 128) < 64) tconv_item(p.in[16] + (size_t)l * DM * DM, (bf16_t*)(wb + WL_OUT), DM, DM, j, false, tile);
            else if ((j -= 64) < 256) tconv_item(p.in[17] + (size_t)l * DM * MLPW, (bf16_t*)(wb + WL_M1), DM, MLPW, j, false, tile);
            else { j -= 256; tconv_item(p.in[18] + (size_t)l * MLPW * DM, (bf16_t*)(wb + WL_M2), MLPW, DM, j, false, tile); }
        } else if (it < NT + NMOD) {
            const int j = it - NT, l = j / 96, c0 = (j % 96) * 64;
            for (int idx = tid; idx < 9 * 1024; idx += NTHR) { const int g = idx >> 10, k = idx & 1023; const float v = g == 0 ? p.in[4][k] : p.in[2][(g - 1) * 1024 + k]; scond[idx] = siluf_(v); }
            __syncthreads();
            const int col = tid & 63, kg = tid >> 6; float a[9];
#pragma unroll
            for (int g = 0; g < 9; ++g) a[g] = 0.f;
            const float* wm = p.in[7] + (size_t)l * DM * 6144 + c0 + col;
#pragma unroll 16
            for (int k = kg * 128; k < kg * 128 + 128; ++k) { const float w = __builtin_nontemporal_load(wm + (size_t)k * 6144);
#pragma unroll
                for (int g = 0; g < 9; ++g) a[g] += scond[g * 1024 + k] * w; }
#pragma unroll
            for (int g = 0; g < 9; ++g) red[(kg * 9 + g) * 64 + col] = a[g];
            __syncthreads();
            for (int o = tid; o < 9 * 64; o += NTHR) { const int g = o >> 6, cc = o & 63; float s = 0.f;
#pragma unroll
                for (int q = 0; q < 8; ++q) s += red[(q * 9 + g) * 64 + cc];
                ((float*)(p.ws + WS_MOD))[(size_t)(l * 9 + g) * 6144 + c0 + cc] = s + p.in[8][l * 6144 + c0 + cc]; }
            __syncthreads();
        } else {
            float* rc = (float*)(p.ws + WS_ROPE); float* rs = rc + 4096;
            if (tid < 128) ((unsigned*)(p.ws + WS_CNT))[tid] = 0u;
            for (int idx = tid; idx < 4096; idx += NTHR) { const int pos = idx >> 6, i = idx & 63; const float inv = exp2f(-(float)i * (13.287712379549449f / 64.f)); const float ang = (float)pos * inv;
                rc[idx] = __cosf(ang); rs[idx] = __sinf(ang); }
        }
    }
}

__device__ void norm_mod_phase(const float* xa, const float* xb, bf16_t* dst, const float* ng, const float* modl, int sh_chunk) {
    const int tid = tid_opaque(), lane = tid & 63, gw = blockIdx.x * 8 + (tid >> 6), nw = gridDim.x * 8;
    for (int row0 = gw; row0 < TT; row0 += 2 * nw) {
        f32x4 v[2][4]; float ss[2];
#pragma unroll
        for (int q = 0; q < 2; ++q) { const int row = min(row0 + q * nw, TT - 1); const float* xr = row < TC ? xa + (size_t)row * DM : xb + (size_t)(row - TC) * DM;
#pragma unroll
            for (int i = 0; i < 4; ++i) v[q][i] = __builtin_nontemporal_load((const f32x4*)(xr + i * 256 + lane * 4)); }
#pragma unroll
        for (int q = 0; q < 2; ++q) { float s = 0.f;
#pragma unroll
            for (int i = 0; i < 4; ++i) s += v[q][i][0] * v[q][i][0] + v[q][i][1] * v[q][i][1] + v[q][i][2] * v[q][i][2] + v[q][i][3] * v[q][i][3];
            ss[q] = s; }
#pragma unroll
        for (int q = 0; q < 2; ++q) { const int row = row0 + q * nw; if (row >= TT) break;
            const float rstd = rsqrtf(wave_sum(ss[q]) * (1.f / DM) + EPSV); const float* md = modl + row_group(row) * 6144;
#pragma unroll
            for (int i = 0; i < 4; ++i) { const int c = i * 256 + lane * 4; const f32x4 g = *(const f32x4*)(ng + c), sh = *(const f32x4*)(md + sh_chunk * 1024 + c), sc = *(const f32x4*)(md + (sh_chunk + 1) * 1024 + c);
                const f32x4 o = v[q][i] * rstd * g * (sc + 1.f) + sh; st_bf16x4(dst + (size_t)row * DM + c, o); } }
    }
}
__device__ void final_norm_phase(float* x, const float* ng) {
    const int tid = tid_opaque(), lane = tid & 63, gw = blockIdx.x * 8 + (tid >> 6), nw = gridDim.x * 8;
    for (int row = gw; row < TT; row += nw) {
        float* xr = x + (size_t)row * DM; f32x4 v[4]; float ss = 0.f;
#pragma unroll
        for (int i = 0; i < 4; ++i) { v[i] = __builtin_nontemporal_load((const f32x4*)(xr + i * 256 + lane * 4)); ss += v[i][0] * v[i][0] + v[i][1] * v[i][1] + v[i][2] * v[i][2] + v[i][3] * v[i][3]; }
        ss = wave_sum(ss); const float rstd = rsqrtf(ss * (1.f / DM) + EPSV);
#pragma unroll
        for (int i = 0; i < 4; ++i) { const int c = i * 256 + lane * 4; const f32x4 g = *(const f32x4*)(ng + c); __builtin_nontemporal_store(v[i] * rstd * g, (f32x4*)(xr + c)); }
    }
}

__device__ void conv_phase(const Params& p, int l, unsigned char* smem) {
    const int tid = tid_opaque(), lane = tid & 63, wv = tid >> 6;
    const bf16_t* aglu = (const bf16_t*)(p.ws + WS_R2); bf16_t* aconv = (bf16_t*)(p.ws + WS_R1);
    float* red = (float*)(smem + 46 * 2048);
    float* rst = red + 128;
    const int c0 = 2 * tid;
    float w0[31], w1[31];
#pragma unroll
    for (int j = 0; j < 31; ++j) { const f32x2 wv2 = *(const f32x2*)(p.in[10] + (size_t)(l * 31 + j) * DM + c0); w0[j] = wv2.x; w1[j] = wv2.y; }
    const f32x2 bias = *(const f32x2*)(p.in[11] + l * DM + c0), gn = *(const f32x2*)(p.in[12] + l * DM + c0);
    for (int it = blockIdx.x; it < TT / 16; it += gridDim.x) {
        const int t0 = it * 16, segl = t0 < TC ? 256 : 64, ss = t0 & ~(segl - 1), se = ss + segl;
        for (int idx = tid; idx < 46 * 128; idx += NTHR) { const int rr = idx >> 7, ch = idx & 127, tt = t0 - 15 + rr; u32x4 v = (u32x4){0u, 0u, 0u, 0u};
            if (tt >= ss && tt < se) v = *(const u32x4*)(aglu + (size_t)tt * DM + ch * 8);
            *(u32x4*)(smem + rr * 2048 + ch * 16) = v; }
        __syncthreads();
        float a0[16], a1[16];
#pragma unroll
        for (int t = 0; t < 16; ++t) { a0[t] = bias.x; a1[t] = bias.y; }
#pragma unroll
        for (int rr = 0; rr < 46; ++rr) { const unsigned uv = *(const unsigned*)(smem + rr * 2048 + c0 * 2); const float lo = bf_lo(uv), hi = bf_hi(uv);
#pragma unroll
            for (int t = 0; t < 16; ++t) { const int j = rr - t; if (j >= 0 && j < 31) { a0[t] += w0[j] * lo; a1[t] += w1[j] * hi; } } }
#pragma unroll
        for (int t = 0; t < 16; ++t) { const float s = wave_sum(a0[t] * a0[t] + a1[t] * a1[t]); if (lane == 0) red[wv * 16 + t] = s; }
        __syncthreads();
        if (tid < 16) { float s = 0.f;
#pragma unroll
            for (int q = 0; q < 8; ++q) s += red[q * 16 + tid];
            rst[tid] = rsqrtf(s * (1.f / DM) + EPSV); }
        __syncthreads();
#pragma unroll
        for (int t = 0; t < 16; ++t) { const float r = rst[t]; *(unsigned*)(aconv + (size_t)(t0 + t) * DM + c0) = cvt_pk_bf16(siluf_(a0[t] * r * gn.x), siluf_(a1[t] * r * gn.y)); }
        __syncthreads();
    }
}

__device__ void ret_phase(const Params& p, int l, unsigned char* smem) {
    LAS unsigned char* lds = (LAS unsigned char*)smem;
    const int tid = tid_opaque(), lane = tid & 63, w = __builtin_amdgcn_readfirstlane(tid >> 6), fr = lane & 15, fq = lane >> 4;
    const bf16_t* Qg = (const bf16_t*)(p.ws + WS_Q); const bf16_t* Kg = (const bf16_t*)(p.ws + WS_K); const bf16_t* KTg = (const bf16_t*)(p.ws + WS_KT); const bf16_t* VTg = (const bf16_t*)(p.ws + WS_VT);
    constexpr int QOFF = 0, KTOFF = 65536;
    const unsigned voffQ = (unsigned)(((2 * w + (lane >> 5)) * DM + (((lane & 31) ^ ((2 * w + (lane >> 5)) & 15))) * 8) * 2);
    const unsigned voffKT = (unsigned)(((4 * w + (lane >> 4)) * TT + (((lane & 15) ^ ((((2 * w + (lane >> 5)) & 12)) | ((lane >> 4) & 3)))) * 8) * 2);
    const unsigned voffK = (unsigned)(((16 * w + fr) * DM + fq * 8) * 2);
    const unsigned voffV = (unsigned)(((16 * w + fr) * TT + fq * 8) * 2);
    const unsigned voffY = (unsigned)(((4 * fq) * VW + 16 * w + fr) * 2);
    int xb[4];
#pragma unroll
    for (int k4 = 0; k4 < 4; ++k4) xb[k4] = ((k4 * 4 + fq) ^ fr) * 16;
    for (int it = blockIdx.x; it < 768; it += gridDim.x) {
        int es, dir, h, bb, tok0, nch; const bool lat = it < 256;
        { const int j = lat ? it : it - 256, x = j & 7, y = j >> 3; es = y & 3; const int cmb = (y >> 2) * 8 + x; dir = cmb & 1; h = (cmb >> 1) & 3; bb = cmb >> 3;
          tok0 = lat ? TC + bb * 2048 : bb * 256; nch = lat ? 16 : 2; }
        const float dl = p.in[14][l * 8 + dir * 4 + h]; const float lg2 = -log1pf(expf(-dl)) * 1.4426950408889634f;
        const float sdec = exp2f(128.f * lg2);
        const float zl = dir ? -lg2 : lg2, zb2 = (float)(dir ? 128 - 4 * fq : 4 * fq + 1) * lg2, kb2 = (float)(dir ? 8 * fq : 127 - 8 * fq) * lg2;
        const int pbase = dir ? (16 * w + 4 * fq - fr) : (fr - 16 * w - 4 * fq);
        f32x4 S[16];
        const unsigned voffS = (unsigned)((8 * fq * 512 + 16 * w + fr) * 4);
        if (lat) { const float* sp = p.in[3] + ((((size_t)bb * 2 + l) * 2 + dir) * 4 + h) * 256 * 512 + es * 128;
#pragma unroll
            for (int D = 0; D < 16; ++D)
#pragma unroll
                for (int r = 0; r < 4; ++r) S[D][r] = __builtin_nontemporal_load((const float*)((const char*)(sp + ((D >> 1) * 32 + 4 * (D & 1) + r) * 512) + voffS));
        } else {
#pragma unroll
            for (int D = 0; D < 16; ++D) S[D] = (f32x4){0.f, 0.f, 0.f, 0.f};
        }
        bf16_t* Yg = (bf16_t*)(p.ws + (dir ? WS_YB : WS_YF));
        for (int s = 0; s < nch; ++s) {
            const int c = dir ? nch - 1 - s : s, r0 = tok0 + c * 128;
            { const bf16_t* qu = Qg + (size_t)r0 * DM + h * 256; const bf16_t* ku = KTg + (size_t)(h * 256) * TT + r0;
#pragma unroll
              for (int n = 0; n < 8; ++n) {
                  __builtin_amdgcn_global_load_lds((const unsigned*)((const char*)(qu + (size_t)(n * 16) * DM) + voffQ), (LAS unsigned*)(lds + QOFF + (n * 8 + w) * 1024), 16, 0, 0);
                  __builtin_amdgcn_global_load_lds((const unsigned*)((const char*)(ku + (size_t)(n * 32) * TT) + voffKT), (LAS unsigned*)(lds + KTOFF + (n * 8 + w) * 1024), 16, 0, 0); } }
            bf16x8 Kf[8], Vf[4];
            { const char* kb = (const char*)(Kg + (size_t)r0 * DM + h * 256) + voffK;
#pragma unroll
              for (int ks = 0; ks < 4; ++ks) Kf[ks] = *(const bf16x8*)(kb + ks * 64); }
            asm volatile("s_waitcnt vmcnt(0)" ::: "memory");
            __syncthreads();
            { const char* kb = (const char*)(Kg + (size_t)r0 * DM + h * 256) + voffK;
#pragma unroll
              for (int ks = 4; ks < 8; ++ks) Kf[ks] = *(const bf16x8*)(kb + ks * 64); }
            f32x4 Z[8], PT[8];
#pragma unroll
            for (int i8 = 0; i8 < 8; ++i8) { Z[i8] = (f32x4){0.f, 0.f, 0.f, 0.f}; PT[i8] = (f32x4){0.f, 0.f, 0.f, 0.f}; }
#define QFRAG(ks, i8) (*(const LAS bf16x8*)(lds + QOFF + xb[(ks) & 3] + fr * 512 + (i8) * 8192 + ((ks) >> 2) * 256))
            { bf16x8 qa[4], qb[4];
#pragma unroll
              for (int j = 0; j < 4; ++j) qa[j] = QFRAG(0, j);
#pragma unroll
              for (int ks = 0; ks < 8; ++ks) { u32x4 t; t.x = cvt_pk_bf16(S[2 * ks][0], S[2 * ks][1]); t.y = cvt_pk_bf16(S[2 * ks][2], S[2 * ks][3]); t.z = cvt_pk_bf16(S[2 * ks + 1][0], S[2 * ks + 1][1]); t.w = cvt_pk_bf16(S[2 * ks + 1][2], S[2 * ks + 1][3]);
                  const bf16x8 Sb = __builtin_bit_cast(bf16x8, t);
#pragma unroll
                  for (int j = 0; j < 4; ++j) qb[j] = QFRAG(ks, 4 + j);
                  __builtin_amdgcn_sched_barrier(0);
#pragma unroll
                  for (int j = 0; j < 4; ++j) { Z[j] = __builtin_amdgcn_mfma_f32_16x16x32_bf16(qa[j], Sb, Z[j], 0, 0, 0); PT[j] = __builtin_amdgcn_mfma_f32_16x16x32_bf16(Kf[ks], qa[j], PT[j], 0, 0, 0); }
                  __builtin_amdgcn_sched_barrier(0);
                  if (ks < 7) {
#pragma unroll
                      for (int j = 0; j < 4; ++j) qa[j] = QFRAG(ks + 1, j); }
                  __builtin_amdgcn_sched_barrier(0);
#pragma unroll
                  for (int j = 0; j < 4; ++j) { Z[4 + j] = __builtin_amdgcn_mfma_f32_16x16x32_bf16(qb[j], Sb, Z[4 + j], 0, 0, 0); PT[4 + j] = __builtin_amdgcn_mfma_f32_16x16x32_bf16(Kf[ks], qb[j], PT[4 + j], 0, 0, 0); }
                  __builtin_amdgcn_sched_barrier(0); } }
#undef QFRAG
            { const char* vb = (const char*)(VTg + (size_t)(h * 512 + es * 128) * TT + r0) + voffV;
#pragma unroll
              for (int ks = 0; ks < 4; ++ks) Vf[ks] = *(const bf16x8*)(vb + ks * 64); }
            float zb2_ = zb2, zl_ = zl, kb2_ = kb2; int pbase_ = pbase;
            asm volatile("" : "+v"(zb2_), "+v"(zl_), "+v"(kb2_), "+v"(pbase_));
            { f32x4 zf, pf; const float z16 = __builtin_amdgcn_exp2f(16.f * zl_);
#pragma unroll
              for (int r = 0; r < 4; ++r) { zf[r] = __builtin_amdgcn_exp2f(zb2_ + (float)r * zl_); pf[r] = __builtin_amdgcn_exp2f((float)(pbase_ + (dir ? r : -r)) * lg2); }
#pragma unroll
              for (int i8 = 0; i8 < 8; ++i8) {
#pragma unroll
                  for (int r = 0; r < 4; ++r) { Z[i8][r] *= zf[r];
                      const int df = pbase_ + (dir ? -(i8 * 16 - r) : (i8 * 16 - r)); PT[i8][r] = df >= 0 ? PT[i8][r] * pf[r] : 0.f; }
                  zf *= z16; pf *= z16; } }
            __syncthreads();
#pragma unroll
            for (int i8 = 0; i8 < 8; ++i8) { const int i = i8 * 16 + fr; u32x2 t; t.x = cvt_pk_bf16(PT[i8][0], PT[i8][1]); t.y = cvt_pk_bf16(PT[i8][2], PT[i8][3]);
                *(LAS u32x2*)(lds + QOFF + i * 256 + (((2 * w + (fq >> 1)) ^ fr)) * 16 + (fq & 1) * 8) = t; }
            __syncthreads();
#define PFRAG(i8, ks) (*(const LAS bf16x8*)(lds + QOFF + xb[ks] + fr * 256 + (i8) * 4096))
            { bf16x8 pa[4], pb[4];
#pragma unroll
              for (int ks = 0; ks < 4; ++ks) pa[ks] = PFRAG(0, ks);
#pragma unroll
              for (int i8 = 0; i8 < 8; i8 += 2) {
#pragma unroll
                  for (int ks = 0; ks < 4; ++ks) pb[ks] = PFRAG(i8 + 1, ks);
                  __builtin_amdgcn_sched_barrier(0);
#pragma unroll
                  for (int ks = 0; ks < 4; ++ks) Z[i8] = __builtin_amdgcn_mfma_f32_16x16x32_bf16(pa[ks], Vf[ks], Z[i8], 0, 0, 0);
                  __builtin_amdgcn_sched_barrier(0);
                  if (i8 < 6) {
#pragma unroll
                      for (int ks = 0; ks < 4; ++ks) pa[ks] = PFRAG(i8 + 2, ks); }
                  __builtin_amdgcn_sched_barrier(0);
#pragma unroll
                  for (int ks = 0; ks < 4; ++ks) Z[i8 + 1] = __builtin_amdgcn_mfma_f32_16x16x32_bf16(pb[ks], Vf[ks], Z[i8 + 1], 0, 0, 0);
                  __builtin_amdgcn_sched_barrier(0); } }
#undef PFRAG
#pragma unroll
            for (int i8 = 0; i8 < 8; ++i8)
#pragma unroll
                for (int r = 0; r < 4; ++r) *(bf16_t*)((char*)(Yg + (size_t)(r0 + i8 * 16 + r) * VW + h * 512 + es * 128) + voffY) = bf16_1(Z[i8][r]);
            bf16x8 Vs[4];
            float kf8[8], kstep[4];
#pragma unroll
            for (int e = 0; e < 8; ++e) kf8[e] = __builtin_amdgcn_exp2f(kb2_ - (float)e * zl_);
            { const float k32 = __builtin_amdgcn_exp2f(-32.f * zl_); kstep[0] = 1.f; kstep[1] = k32; kstep[2] = k32 * k32; kstep[3] = kstep[2] * k32; }
#pragma unroll
            for (int ks = 0; ks < 4; ++ks) { const u32x4 t = __builtin_bit_cast(u32x4, Vf[ks]); float f[8]; f[0] = bf_lo(t.x); f[1] = bf_hi(t.x); f[2] = bf_lo(t.y); f[3] = bf_hi(t.y); f[4] = bf_lo(t.z); f[5] = bf_hi(t.z); f[6] = bf_lo(t.w); f[7] = bf_hi(t.w);
#pragma unroll
                for (int e = 0; e < 8; ++e) f[e] *= kf8[e] * kstep[ks];
                u32x4 o; o.x = cvt_pk_bf16(f[0], f[1]); o.y = cvt_pk_bf16(f[2], f[3]); o.z = cvt_pk_bf16(f[4], f[5]); o.w = cvt_pk_bf16(f[6], f[7]); Vs[ks] = __builtin_bit_cast(bf16x8, o); }
#define TFRAG(D, ks) (*(const LAS bf16x8*)(lds + KTOFF + xb[ks] + (8 * (fr >> 2) + (fr & 3)) * 256 + ((D) >> 1) * 8192 + ((D) & 1) * 1024))
            { bf16x8 ta[4], tb[4];
#pragma unroll
              for (int ks = 0; ks < 4; ++ks) ta[ks] = TFRAG(0, ks);
#pragma unroll
              for (int D = 0; D < 16; D += 2) { S[D] *= sdec; S[D + 1] *= sdec;
#pragma unroll
                  for (int ks = 0; ks < 4; ++ks) tb[ks] = TFRAG(D + 1, ks);
                  __builtin_amdgcn_sched_barrier(0);
#pragma unroll
                  for (int ks = 0; ks < 4; ++ks) S[D] = __builtin_amdgcn_mfma_f32_16x16x32_bf16(ta[ks], Vs[ks], S[D], 0, 0, 0);
                  __builtin_amdgcn_sched_barrier(0);
                  if (D < 14) {
#pragma unroll
                      for (int ks = 0; ks < 4; ++ks) ta[ks] = TFRAG(D + 2, ks); }
                  __builtin_amdgcn_sched_barrier(0);
#pragma unroll
                  for (int ks = 0; ks < 4; ++ks) S[D + 1] = __builtin_amdgcn_mfma_f32_16x16x32_bf16(tb[ks], Vs[ks], S[D + 1], 0, 0, 0);
                  __builtin_amdgcn_sched_barrier(0); } }
#undef TFRAG
            __syncthreads();
        }
        if (!lat) { float* so = p.out + (size_t)TT * DM + ((((size_t)bb * 2 + l) * 2 + dir) * 4 + h) * 256 * 512 + es * 128;
#pragma unroll
            for (int D = 0; D < 16; ++D)
#pragma unroll
                for (int r = 0; r < 4; ++r) __builtin_nontemporal_store(S[D][r], (float*)((char*)(so + ((D >> 1) * 32 + 4 * (D & 1) + r) * 512) + voffS)); }
    }
}

__device__ void comb_phase(const Params& p) {
    const int tid = tid_opaque(), lane = tid & 63, gw = blockIdx.x * 8 + (tid >> 6), nw = gridDim.x * 8;
    const bf16_t* yf = (const bf16_t*)(p.ws + WS_YF); const bf16_t* yb = (const bf16_t*)(p.ws + WS_YB); const bf16_t* rg = (const bf16_t*)(p.ws + WS_RG); bf16_t* ar = (bf16_t*)(p.ws + WS_Q);
    for (int tok = gw; tok < TT; tok += nw) {
        u32x4 a[4], b[4], g[4];
#pragma unroll
        for (int h = 0; h < 4; ++h) { const size_t off = (size_t)tok * VW + h * 512 + lane * 8; a[h] = __builtin_nontemporal_load((const u32x4*)(yf + off)); b[h] = __builtin_nontemporal_load((const u32x4*)(yb + off)); g[h] = __builtin_nontemporal_load((const u32x4*)(rg + off)); }
#pragma unroll
        for (int h = 0; h < 4; ++h) {
            float y[8];
#pragma unroll
            for (int e = 0; e < 4; ++e) { y[2 * e] = bf_lo(a[h][e]) + bf_lo(b[h][e]); y[2 * e + 1] = bf_hi(a[h][e]) + bf_hi(b[h][e]); }
            float s = 0.f;
#pragma unroll
            for (int e = 0; e < 8; ++e) s += y[e];
            const float mu = wave_sum(s) * (1.f / 512.f); float v = 0.f;
#pragma unroll
            for (int e = 0; e < 8; ++e) { y[e] -= mu; v += y[e] * y[e]; }
            const float rstd = rsqrtf(wave_sum(v) * (1.f / 512.f) + EPSV);
            u32x4 o;
#pragma unroll
            for (int e = 0; e < 4; ++e) o[e] = cvt_pk_bf16(y[2 * e] * rstd * bf_lo(g[h][e]), y[2 * e + 1] * rstd * bf_hi(g[h][e]));
            *(u32x4*)(ar + (size_t)tok * VW + h * 512 + lane * 8) = o;
        }
    }
}


#define XB_TMO      128
#define XB_XCNT(j)  (256  + 64 * (j))
#define XB_XSUB(j)  (1280 + 64 * (j))
#define XB_XGEN(j)  (2304 + 64 * (j))
#define XB_TOP      3328
#define XB_TOPGEN   3392
#define XCD_BAR_WORDS 3456
#define XB_SPIN_CAP (1u << 18)
__device__ __forceinline__ unsigned xb_ld(unsigned* p)              { return __hip_atomic_load(p, __ATOMIC_RELAXED, __HIP_MEMORY_SCOPE_AGENT); }
__device__ __forceinline__ unsigned xb_add(unsigned* p, unsigned v) { return __hip_atomic_fetch_add(p, v, __ATOMIC_RELAXED, __HIP_MEMORY_SCOPE_AGENT); }
__device__ __forceinline__ unsigned xb_xcc_id() { return (unsigned)__builtin_amdgcn_s_getreg((3 << 11) | 20) & 0xFu; }
#define XB_SPIN(cond, bar) do { unsigned _sp = 0; while (cond) { __builtin_amdgcn_s_sleep(1); \
    if ((++_sp & 255u) == 0u) { if (xb_ld(&(bar)[XB_TMO])) break; if (_sp > XB_SPIN_CAP) { atomicAdd(&(bar)[XB_TMO], 1u); break; } } } } while (0)
struct XcdBarrier { unsigned* bar; unsigned x; volatile LAS unsigned* st; };
__device__ __forceinline__ XcdBarrier xcd_barrier_post(unsigned* bar, volatile LAS unsigned* st) {
    XcdBarrier b; b.bar = bar; b.x = xb_xcc_id(); b.st = st;
    if (threadIdx.x == 0) (void)xb_add(&bar[XB_XCNT(b.x)], 1u);
    return b;
}
__device__ __forceinline__ void xcd_barrier_complete(unsigned* bar, unsigned x, unsigned& nloc, unsigned& nx) {
    const unsigned G = gridDim.x * gridDim.y * gridDim.z;
    unsigned sum, cnt, mine, sp = 0u;
    for (;;) {
        sum = 0u; cnt = 0u; mine = 0u;
#pragma unroll
        for (unsigned j = 0; j < 16; ++j) { const unsigned c = xb_ld(&bar[XB_XCNT(j)]); sum += c; cnt += (c > 0u) ? 1u : 0u; mine = (j == x) ? c : mine; }
        if (sum == G) break;
        __builtin_amdgcn_s_sleep(1);
        if ((++sp & 255u) == 0u) { if (xb_ld(&bar[XB_TMO])) break; if (sp > XB_SPIN_CAP) { atomicAdd(&bar[XB_TMO], 1u); break; } }
    }
    nloc = mine > 0u ? mine : 1u; nx = cnt > 0u ? cnt : 1u;
}
__device__ __forceinline__ void xcd_barrier(const XcdBarrier& b) {
    asm volatile("s_waitcnt vmcnt(0)" ::: "memory");
    __syncthreads();
    if (threadIdx.x == 0) {
        unsigned* bar = b.bar;
        __builtin_amdgcn_s_waitcnt(0);
        unsigned nloc = b.st[0], nx = b.st[1];
        if (nloc == 0u) { xcd_barrier_complete(bar, b.x, nloc, nx); b.st[0] = nloc; b.st[1] = nx; }
        const unsigned old = xb_add(&bar[XB_XSUB(b.x)], 1u);
        const unsigned gen = old / nloc;
        if (old + 1u == (gen + 1u) * nloc) {
            __builtin_amdgcn_fence(__ATOMIC_RELEASE, "agent");
            asm volatile("s_waitcnt vmcnt(0)" ::: "memory");
            const unsigned og = xb_add(&bar[XB_TOP], 1u);
            const unsigned tg = og / nx;
            if (og + 1u == (tg + 1u) * nx) xb_add(&bar[XB_TOPGEN], 1u);
            else XB_SPIN(xb_ld(&bar[XB_TOPGEN]) == tg, bar);
            __builtin_amdgcn_fence(__ATOMIC_ACQUIRE, "agent");
            xb_add(&bar[XB_XGEN(b.x)], 1u);
            asm volatile("s_waitcnt vmcnt(0)" ::: "memory");
        } else {
            XB_SPIN(xb_ld(&bar[XB_XGEN(b.x)]) == gen, bar);
            __builtin_amdgcn_fence(__ATOMIC_ACQUIRE, "agent");
            asm volatile("s_waitcnt vmcnt(0)" ::: "memory");
        }
    }
    __syncthreads();
}

__global__ void __launch_bounds__(NTHR) mega(Params p) {
    __shared__ __attribute__((aligned(16))) unsigned char smem[131072];
    cg::grid_group grid = cg::this_grid();
    LAS unsigned char* lds = (LAS unsigned char*)smem;
    unsigned char* ws = p.ws;
    float* xbuf = p.out;
    const float* modb = (const float*)(ws + WS_MOD);
    pg8::StaticOrder so;
    __shared__ __attribute__((aligned(16))) unsigned xb_st[4];
    if (threadIdx.x < 4) xb_st[threadIdx.x] = 0u;
    __syncthreads();
    if (blockIdx.x == 1) { const int t = tid_opaque(); for (int i = t; i < XCD_BAR_WORDS; i += NTHR) ((unsigned*)(ws + WS_BAR))[i] = 0u; }
    phase0(p, smem);
    grid.sync();
    const XcdBarrier xbar = xcd_barrier_post((unsigned*)(ws + WS_BAR), (volatile LAS unsigned*)xb_st);
    for (int l = 0; l < 2; ++l) {
        const unsigned char* wl = ws + WS_W + (size_t)l * WL_SZ;
        const float* modl = modb + (size_t)l * 9 * 6144;
        const float* xa = l == 0 ? p.in[0] : xbuf; const float* xb = l == 0 ? p.in[1] : xbuf + (size_t)TC * DM;
        norm_mod_phase(xa, xb, (bf16_t*)(ws + WS_R1), p.in[5] + l * DM, modl, 0);
        xcd_barrier(xbar);
        { pg8::Gemm g{(const bf16_t*)(ws + WS_R1), (const bf16_t*)(wl + WL_IN), TT, PW, DM, nullptr, nullptr}; so.init(TT, PW, gridDim.x, blockIdx.x);
          EpiG1 e{(bf16_t*)(ws + WS_R2), (bf16_t*)(ws + WS_Q), (bf16_t*)(ws + WS_K), (bf16_t*)(ws + WS_KT), (bf16_t*)(ws + WS_VT), (bf16_t*)(ws + WS_RG), (bf16_t*)(ws + WS_GATE), (const float*)(ws + WS_ROPE), (const float*)(ws + WS_ROPE) + 4096};
          pg8::gemm_phase(lds, g, so, e); }
        xcd_barrier(xbar);
        ret_phase(p, l, smem);
        conv_phase(p, l, smem);
        xcd_barrier(xbar);
        { pg8::Gemm g{(const bf16_t*)(ws + WS_R1), (const bf16_t*)(wl + WL_CONV), TT, DM, DM, (unsigned long long*)(ws + WS_DUMP), (unsigned*)(ws + WS_CNT)}; so.init(TT, DM, gridDim.x, blockIdx.x, true);
          EpiE1 e{(bf16_t*)(ws + WS_KT), (const bf16_t*)(ws + WS_GATE)};
          comb_phase(p);
          __syncthreads();
          pg8::gemm_phase(lds, g, so, e); }
        xcd_barrier(xbar);
        { pg8::Gemm g{(const bf16_t*)(ws + WS_Q), (const bf16_t*)(wl + WL_RET), TT, DM, VW, (unsigned long long*)(ws + WS_DUMP), (unsigned*)(ws + WS_CNT)}; so.init(TT, DM, gridDim.x, blockIdx.x, true);
          EpiE2 e{(const bf16_t*)(ws + WS_KT), (const bf16_t*)(ws + WS_GATE), (bf16_t*)(ws + WS_R2)};
          pg8::gemm_phase(lds, g, so, e); }
        xcd_barrier(xbar);
        { pg8::Gemm g{(const bf16_t*)(ws + WS_R2), (const bf16_t*)(wl + WL_OUT), TT, DM, DM, (unsigned long long*)(ws + WS_DUMP), (unsigned*)(ws + WS_CNT)}; so.init(TT, DM, gridDim.x, blockIdx.x, true);
          EpiResT<true> e{xa, xb, xbuf, modl + 2 * 1024};
          pg8::gemm_phase(lds, g, so, e); }
        xcd_barrier(xbar);
        norm_mod_phase(xbuf, xbuf + (size_t)TC * DM, (bf16_t*)(ws + WS_R1), p.in[6] + l * DM, modl, 3);
        xcd_barrier(xbar);
        { pg8::Gemm g{(const bf16_t*)(ws + WS_R1), (const bf16_t*)(wl + WL_M1), TT, MLPW, DM, nullptr, nullptr}; so.init(TT, MLPW, gridDim.x, blockIdx.x);
          EpiF1 e{(bf16_t*)(ws + WS_RG)};
          pg8::gemm_phase(lds, g, so, e); }
        xcd_barrier(xbar);
        { pg8::Gemm g{(const bf16_t*)(ws + WS_RG), (const bf16_t*)(wl + WL_M2), TT, DM, MLPW, (unsigned long long*)(ws + WS_DUMP), (unsigned*)(ws + WS_CNT)}; so.init(TT, DM, gridDim.x, blockIdx.x, true);
          EpiResT<true> e{xbuf, xbuf + (size_t)TC * DM, xbuf, modl + 5 * 1024};
          pg8::gemm_phase(lds, g, so, e); }
        xcd_barrier(xbar);
    }
    final_norm_phase(xbuf, p.in[19]);
}

extern "C" void kernel_launch(void* const* d_in, const int* in_sizes, int n_in, void* d_out, int out_size, void* d_ws, size_t ws_size, hipStream_t stream) {
    static int grid_blocks = 0;
    if (!grid_blocks) {
        int dev = 0, cus = 0, per_cu = 0;
        (void)hipGetDevice(&dev);
        (void)hipDeviceGetAttribute(&cus, hipDeviceAttributeMultiprocessorCount, dev);
        (void)hipOccupancyMaxActiveBlocksPerMultiprocessor(&per_cu, mega, NTHR, 0);
        if (per_cu < 1) per_cu = 1;
        grid_blocks = cus;
    }
    if (n_in != 20 || ws_size < WS_END) return;
    Params p{};
    for (int i = 0; i < 20; ++i) p.in[i] = (const float*)d_in[i];
    p.out = (float*)d_out; p.ws = (unsigned char*)d_ws;
    void* args[] = {&p};
    (void)hipLaunchCooperativeKernel((void*)mega, dim3(grid_blocks), dim3(NTHR), args, 0, stream);
}
```

```cpp
#include <hip/hip_runtime.h>
#include <hip/hip_cooperative_groups.h>
namespace cg = cooperative_groups;

#define LAS __attribute__((address_space(3)))
typedef unsigned short bf16_t;
typedef short bf16x8 __attribute__((ext_vector_type(8)));
typedef float f32x4 __attribute__((ext_vector_type(4)));
typedef float f32x2 __attribute__((ext_vector_type(2)));
typedef unsigned u32x2 __attribute__((ext_vector_type(2)));
typedef unsigned u32x4 __attribute__((ext_vector_type(4)));

constexpr int DM = 1024, TC = 4096, TL = 16384, TT = 20480, PW = 10240, MLPW = 4096, VW = 2048;
constexpr int NTHR = 512;
constexpr float EPSV = 1e-6f;
constexpr size_t MiB = (size_t)1 << 20;
constexpr size_t WS_W = 0;
constexpr size_t WL_IN = 0, WL_CONV = 20 * MiB, WL_RET = 22 * MiB, WL_OUT = 26 * MiB, WL_M1 = 28 * MiB, WL_M2 = 36 * MiB, WL_SZ = 44 * MiB;
constexpr size_t WS_MOD = 88 * MiB;
constexpr size_t WS_ROPE = 88 * MiB + 512 * 1024;
constexpr size_t WS_R1 = 90 * MiB;
constexpr size_t WS_R2 = 130 * MiB;
constexpr size_t WS_Q = 170 * MiB;
constexpr size_t WS_K = 210 * MiB;
constexpr size_t WS_KT = 250 * MiB;
constexpr size_t WS_VT = 290 * MiB;
constexpr size_t WS_RG = 370 * MiB;
constexpr size_t WS_GATE = 450 * MiB;
constexpr size_t WS_YF = 530 * MiB;
constexpr size_t WS_YB = 610 * MiB;
constexpr size_t WS_BAR = 88 * MiB + 448 * 1024;
constexpr size_t WS_DUMP = 690 * MiB;
constexpr size_t WS_CNT = 88 * MiB + 480 * 1024;
constexpr size_t WS_END = 754 * MiB;

struct Params { const float* in[20]; float* out; unsigned char* ws; };

typedef __bf16 bf16x2_t __attribute__((ext_vector_type(2)));
__device__ __forceinline__ unsigned cvt_pk_bf16(float lo, float hi) { const f32x2 f = {lo, hi}; const bf16x2_t v = __builtin_convertvector(f, bf16x2_t); return __builtin_bit_cast(unsigned, v); }
__device__ __forceinline__ float bf_lo(unsigned u) { return __uint_as_float(u << 16); }
__device__ __forceinline__ float bf_hi(unsigned u) { return __uint_as_float(u & 0xffff0000u); }
__device__ __forceinline__ float sigmoidf_(float x) { return __builtin_amdgcn_rcpf(1.f + __expf(-x)); }
__device__ __forceinline__ float siluf_(float x) { return x * sigmoidf_(x); }
__device__ __forceinline__ float wave_sum(float v) {
#pragma unroll
    for (int o = 32; o > 0; o >>= 1) v += __shfl_xor(v, o, 64);
    return v;
}
__device__ __forceinline__ int tid_opaque() { int t = threadIdx.x; asm volatile("" : "+v"(t)); return t; }
__device__ __forceinline__ int row_group(int row) { return row < TC ? 0 : 1 + ((row - TC) >> 11); }

namespace pg8 {
constexpr int BM = 256, BK = 64, HALF = 128, HTB = HALF * BK * 2, NXCD = 8, WGM = 8;
__device__ __forceinline__ int lds_byte(int r, int c) { const int st = (r >> 4) * 2 + (c >> 5), rr = r & 15, cc = c & 31, ob = rr * 64 + cc * 2; return st * 1024 + (ob ^ (((ob >> 9) & 1) << 5)); }
__device__ __forceinline__ void stage_rc(int b, int& R, int& C) { const int st = b / 1024, sb = b % 1024, swz = sb ^ (((sb >> 9) & 1) << 5); R = (st >> 1) * 16 + swz / 64; C = (st & 1) * 32 + (swz % 64) / 2; }
__device__ __forceinline__ int perm32(int rho) { const int n = rho >> 4, i = rho & 15; return 8 * (i >> 2) + 4 * n + (i & 3); }
struct Unit { int pm, pn, kq, ti; };
struct Gemm { const bf16_t* A; const bf16_t* Bt; int M, N, K; unsigned long long* dump; unsigned* cnt; };
struct StaticOrder {
    int nM, nN, nwg, G, c; bool split;
    __device__ void init(int M, int N, int G_, int c_, bool allow_split = false) { nM = M / BM; nN = N / BM; nwg = nM * nN; G = G_; c = c_; split = allow_split && nwg == 320 && G == 256; }
    __device__ bool next(int i, Unit& u) const {
        if (split) {
            const int x = c & 7, j = c >> 3;
            if (i == 0) { u.pm = x * 8 + (j & 7); u.pn = j >> 3; u.kq = -1; u.ti = 0; return true; }
            if (i == 1) { u.kq = x & 3; u.pm = 64 + (x >> 2) * 8 + (j >> 2); u.pn = j & 3; u.ti = (u.pm - 64) * 4 + u.pn; return true; }
            return false;
        }
        const long L = (long)i * G + c;
        if (L >= nwg) return false;
        int wgid = (int)L; { const int q = nwg / NXCD, r = nwg % NXCD, xcd = wgid % NXCD, off = wgid / NXCD; wgid = (xcd < r ? xcd * (q + 1) : r * (q + 1) + (xcd - r) * q) + off; }
        const int nig = WGM * nN, gid = wgid / nig, fm = gid * WGM, gsz = (nM - fm) < WGM ? (nM - fm) : WGM;
        u.pm = fm + ((wgid % nig) % gsz); u.pn = (wgid % nig) / gsz; u.kq = -1; u.ti = 0; return true;
    }
};

template <class Epi>
__device__ __forceinline__ void gemm_phase(LAS unsigned char* lds, const Gemm g, const StaticOrder& S, const Epi& E) {
    const int tid = tid_opaque(), wid = __builtin_amdgcn_readfirstlane(tid >> 6), lane = tid & 63, wr = wid >> 2, wc = wid & 3, fr = lane & 15, fq = lane >> 4;
    const int K = g.K;
    unsigned voffA[2], voffB[2];
#pragma unroll
    for (int i = 0; i < 2; ++i) { int R, C; stage_rc(tid * 16 + i * 8192, R, C); const int Rb = (R & ~31) + perm32(R & 31); voffA[i] = (unsigned)(R * K + C) * 2u; voffB[i] = (unsigned)(Rb * K + C) * 2u; }
    const size_t kstep = (size_t)(BK * 2);
    const size_t hstep = (size_t)HALF * K * 2;
    const size_t tstep = 2 * hstep;
    const unsigned ldsw = (unsigned)wid * 1024u;
    const int aoff = lds_byte(wr * 64 + fr, fq * 8), boff = lds_byte(wc * 32 + fr, fq * 8);
#define PG8_SA(b, h) (((b) * 2 + (h)) * HTB)
#define PG8_SB(b, h) ((4 + (b) * 2 + (h)) * HTB)
#define PG8_STAGE(bufoff, gbase, voff) do { _Pragma("unroll") for (int _i = 0; _i < 2; ++_i) \
        __builtin_amdgcn_global_load_lds((const unsigned*)((const char*)(gbase) + (voff)[_i]), (LAS unsigned*)(lds + (bufoff) + ldsw + _i * 8192), 16, 0, 0); } while (0)
#define PG8_LDA(dst, b, h) do { _Pragma("unroll") for (int m = 0; m < 4; ++m) _Pragma("unroll") for (int k = 0; k < 2; ++k) dst[m][k] = *(const LAS bf16x8*)(lds + PG8_SA(b, h) + aoff + m * 2048 + k * 1024); } while (0)
#define PG8_LDB(dst, b, h) do { _Pragma("unroll") for (int n = 0; n < 2; ++n) _Pragma("unroll") for (int k = 0; k < 2; ++k) dst[n][k] = *(const LAS bf16x8*)(lds + PG8_SB(b, h) + boff + n * 2048 + k * 1024); } while (0)
#define PG8_MMA(ai, bj, At, Bt) do { __builtin_amdgcn_s_setprio(1); _Pragma("unroll") for (int m = 0; m < 4; ++m) _Pragma("unroll") for (int n = 0; n < 2; ++n) _Pragma("unroll") for (int k = 0; k < 2; ++k) \
        acc[ai][bj][m][n] = __builtin_amdgcn_mfma_f32_16x16x32_bf16(Bt[n][k], At[m][k], acc[ai][bj][m][n], 0, 0, 0); __builtin_amdgcn_s_setprio(0); } while (0)
#define PG8_WAIT_V(n) asm volatile("s_waitcnt vmcnt(" #n ")" ::: "memory")
#define PG8_WAIT_L(n) asm volatile("s_waitcnt lgkmcnt(" #n ")" ::: "memory")
#define PG8_BAR __builtin_amdgcn_s_barrier()
#define PG8_SCHED __builtin_amdgcn_sched_barrier(0)
    Unit cur, nxt; int ui = 0;
    if (!S.next(0, cur)) return;
    f32x4 acc[2][2][4][2];
#pragma unroll
    for (int a = 0; a < 2; ++a)
#pragma unroll
        for (int b = 0; b < 2; ++b)
#pragma unroll
            for (int m = 0; m < 4; ++m)
#pragma unroll
                for (int n = 0; n < 2; ++n) acc[a][b][m][n] = (f32x4){0.f, 0.f, 0.f, 0.f};
    bf16x8 At[4][2], B0[2][2], B1[2][2];
    const char* cA = E.swapped(cur) ? (const char*)g.Bt + (size_t)cur.pn * tstep : (const char*)g.A + (size_t)cur.pm * tstep;
    const char* cB = E.swapped(cur) ? (const char*)g.A + (size_t)cur.pm * tstep : (const char*)g.Bt + (size_t)cur.pn * tstep;
    const size_t qstep = (size_t)(K >> 2) * 2;
    if (cur.kq >= 0) { cA += cur.kq * qstep; cB += cur.kq * qstep; }
    PG8_STAGE(PG8_SB(0, 0), cB, voffB); PG8_STAGE(PG8_SA(0, 0), cA, voffA); PG8_STAGE(PG8_SB(0, 1), cB + hstep, voffB); PG8_STAGE(PG8_SA(0, 1), cA + hstep, voffA);
    if (wr == 1) PG8_BAR;
    PG8_WAIT_V(4); PG8_BAR;
    PG8_STAGE(PG8_SB(1, 0), cB + kstep, voffB); PG8_STAGE(PG8_SA(1, 0), cA + kstep, voffA); PG8_STAGE(PG8_SB(1, 1), cB + hstep + kstep, voffB);
    PG8_WAIT_V(6); PG8_BAR;
    for (;;) {
        const bool has_next = S.next(ui + 1, nxt);
        const bool nsw = has_next && E.swapped(nxt);
        const char* nA = has_next ? (nsw ? (const char*)g.Bt + (size_t)nxt.pn * tstep : (const char*)g.A + (size_t)nxt.pm * tstep) : cA;
        const char* nB = has_next ? (nsw ? (const char*)g.A + (size_t)nxt.pm * tstep : (const char*)g.Bt + (size_t)nxt.pn * tstep) : cB;
        if (has_next && nxt.kq >= 0) { nA += nxt.kq * qstep; nB += nxt.kq * qstep; }
        const int nt = (cur.kq >= 0 ? (K >> 2) : K) / BK;
        for (int t = 0; t < nt; t += 2) {
            const bool last = (t == nt - 2);
            const char* a1 = cA + (size_t)(t + 1) * kstep;
            const char* a2 = last ? nA : cA + (size_t)(t + 2) * kstep; const char* b2 = last ? nB : cB + (size_t)(t + 2) * kstep;
            const char* a3 = a2 + kstep; const char* b3 = b2 + kstep;
            PG8_LDB(B0, 0, 0); PG8_SCHED; PG8_LDA(At, 0, 0); PG8_STAGE(PG8_SA(1, 1), a1 + hstep, voffA);
            PG8_WAIT_L(8); PG8_BAR; PG8_WAIT_L(0); PG8_MMA(0, 0, At, B0); PG8_BAR; PG8_SCHED;
            PG8_LDB(B1, 0, 1); PG8_STAGE(PG8_SB(0, 0), b2, voffB);
            PG8_BAR; PG8_WAIT_L(0); PG8_MMA(0, 1, At, B1); PG8_BAR;
            PG8_LDA(At, 0, 1); PG8_STAGE(PG8_SA(0, 0), a2, voffA);
            PG8_BAR; PG8_WAIT_L(0); PG8_MMA(1, 0, At, B0); PG8_BAR; PG8_SCHED;
            PG8_STAGE(PG8_SB(0, 1), b2 + hstep, voffB);
            PG8_WAIT_V(6); PG8_BAR; PG8_MMA(1, 1, At, B1); PG8_BAR;
            PG8_LDB(B0, 1, 0); PG8_SCHED; PG8_LDA(At, 1, 0); PG8_STAGE(PG8_SA(0, 1), a2 + hstep, voffA);
            PG8_WAIT_L(8); PG8_BAR; PG8_WAIT_L(0); PG8_MMA(0, 0, At, B0); PG8_BAR; PG8_SCHED;
            PG8_LDB(B1, 1, 1); PG8_STAGE(PG8_SB(1, 0), b3, voffB);
            PG8_BAR; PG8_WAIT_L(0); PG8_MMA(0, 1, At, B1); PG8_BAR;
            PG8_LDA(At, 1, 1); PG8_STAGE(PG8_SA(1, 0), a3, voffA);
            PG8_BAR; PG8_WAIT_L(0); PG8_MMA(1, 0, At, B0); PG8_BAR; PG8_SCHED;
            PG8_STAGE(PG8_SB(1, 1), b3 + hstep, voffB);
            PG8_WAIT_V(6); PG8_BAR; PG8_MMA(1, 1, At, B1); PG8_BAR;
        }
        if (cur.kq < 0) E(acc, cur, wr, wc, fr, fq);
        if (!has_next) break;
#pragma unroll
        for (int a = 0; a < 2; ++a)
#pragma unroll
            for (int b = 0; b < 2; ++b)
#pragma unroll
                for (int m = 0; m < 4; ++m)
#pragma unroll
                    for (int n = 0; n < 2; ++n) acc[a][b][m][n] = (f32x4){0.f, 0.f, 0.f, 0.f};
        cur = nxt; cA = nA; cB = nB; ++ui;
    }
    PG8_WAIT_V(0);
    if (wr == 0) PG8_BAR;
    PG8_BAR;
    if constexpr (Epi::SPLIT) {
    if (cur.kq >= 0) {
        const __amdgpu_buffer_rsrc_t drs = __builtin_amdgcn_make_buffer_rsrc((void*)((char*)g.dump + (size_t)cur.ti * (4 * 16 * 512 * 16)), 0, 4 * 16 * 512 * 16, 0x00020000);
        unsigned lo = (unsigned)tid * 16u;
        { const unsigned qo = (unsigned)cur.kq * (16 * 512 * 16);
#pragma unroll
          for (int a = 0; a < 2; ++a)
#pragma unroll
              for (int b = 0; b < 2; ++b)
#pragma unroll
                  for (int m = 0; m < 4; ++m) { if (((a * 4 + m) >> 1) == cur.kq) continue;
                      asm volatile("" : "+v"(lo)); const f32x4 v0 = acc[a][b][m][0], v1 = acc[a][b][m][1];
                      u32x4 w; w.x = cvt_pk_bf16(v0[0], v0[1]); w.y = cvt_pk_bf16(v0[2], v0[3]); w.z = cvt_pk_bf16(v1[0], v1[1]); w.w = cvt_pk_bf16(v1[2], v1[3]);
                      __builtin_amdgcn_raw_buffer_store_b128(w, drs, qo + (unsigned)(((a * 2 + b) * 4 + m) * (512 * 16)) + lo, 0,   16); } }
        asm volatile("s_waitcnt vmcnt(0)" ::: "memory");
        __syncthreads();
        if (tid == 0) { __hip_atomic_fetch_add(g.cnt + 2 * cur.ti, 1u, __ATOMIC_RELAXED, __HIP_MEMORY_SCOPE_AGENT);
            unsigned spins = 0; while (__hip_atomic_load(g.cnt + 2 * cur.ti, __ATOMIC_RELAXED, __HIP_MEMORY_SCOPE_AGENT) < 4u) { __builtin_amdgcn_s_sleep(2); if (++spins > (1u << 22)) break; } }
        __syncthreads();
#pragma unroll
        for (int a = 0; a < 2; ++a)
#pragma unroll
            for (int m = 0; m < 4; ++m) { if (((a * 4 + m) >> 1) != cur.kq) continue;
                f32x4 v[2][2];
#pragma unroll
                for (int b = 0; b < 2; ++b) { asm volatile("" : "+v"(lo)); const unsigned o = (unsigned)(((a * 2 + b) * 4 + m) * (512 * 16)) + lo;
                    f32x4 p0[4], p1[4];
#pragma unroll
                    for (int q = 0; q < 4; ++q) {
                        if (q == cur.kq) { p0[q] = acc[a][b][m][0]; p1[q] = acc[a][b][m][1]; }
                        else { const u32x4 w = __builtin_amdgcn_raw_buffer_load_b128(drs, o + q * (16 * 512 * 16), 0, 16);
                            p0[q] = (f32x4){bf_lo(w.x), bf_hi(w.x), bf_lo(w.y), bf_hi(w.y)}; p1[q] = (f32x4){bf_lo(w.z), bf_hi(w.z), bf_lo(w.w), bf_hi(w.w)}; } }
                    v[b][0] = (p0[0] + p0[1]) + (p0[2] + p0[3]); v[b][1] = (p1[0] + p1[1]) + (p1[2] + p1[3]); }
                E.rg(a, m, v, cur, wr, wc, fr, fq); }
        asm volatile("s_waitcnt vmcnt(0)" ::: "memory");
        __syncthreads();
        if (tid == 0) { const unsigned old = __hip_atomic_fetch_add(g.cnt + 2 * cur.ti + 1, 1u, __ATOMIC_RELAXED, __HIP_MEMORY_SCOPE_AGENT);
            if (old == 3u) { __hip_atomic_store(g.cnt + 2 * cur.ti, 0u, __ATOMIC_RELAXED, __HIP_MEMORY_SCOPE_AGENT); __hip_atomic_store(g.cnt + 2 * cur.ti + 1, 0u, __ATOMIC_RELAXED, __HIP_MEMORY_SCOPE_AGENT); } }
        __syncthreads();
    }
    }
#undef PG8_SA
#undef PG8_SB
#undef PG8_STAGE
#undef PG8_LDA
#undef PG8_LDB
#undef PG8_MMA
#undef PG8_WAIT_V
#undef PG8_WAIT_L
#undef PG8_BAR
#undef PG8_SCHED
}
}
using pg8::Unit;
typedef const f32x4 (&AccRef)[2][2][4][2];

__device__ __forceinline__ void st_bf16x4(bf16_t* p, f32x4 v) { u32x2 w; w.x = cvt_pk_bf16(v[0], v[1]); w.y = cvt_pk_bf16(v[2], v[3]); *(u32x2*)p = w; }
__device__ __forceinline__ void st_bf16x8(bf16_t* p, f32x4 a, f32x4 b) { u32x4 w; w.x = cvt_pk_bf16(a[0], a[1]); w.y = cvt_pk_bf16(a[2], a[3]); w.z = cvt_pk_bf16(b[0], b[1]); w.w = cvt_pk_bf16(b[2], b[3]); *(u32x4*)p = w; }
__device__ __forceinline__ bf16_t bf16_1(float v) { return (bf16_t)(cvt_pk_bf16(v, 0.f) & 0xffffu); }

struct EpiG1 {
    static constexpr bool SPLIT = false;
    __device__ __forceinline__ bool swapped(const Unit& u) const { return u.pn >= 16 && u.pn < 24; }
    bf16_t *aglu, *q, *k, *kt, *vt, *rg, *gate; const float *rcos, *rsin;
    __device__ __forceinline__ void operator()(AccRef acc, const Unit& u, int wr, int wc, int fr, int fq) const {
        const int pn = u.pn, row0 = u.pm * 256 + wr * 64 + fr, ct = wc * 32 + 8 * fq;
        if (pn < 8) {
#pragma unroll
            for (int ai = 0; ai < 2; ++ai)
#pragma unroll
                for (int m = 0; m < 4; ++m) { const int row = row0 + ai * 128 + m * 16; f32x4 o[2];
#pragma unroll
                    for (int n = 0; n < 2; ++n) { const f32x4 a = acc[ai][0][m][n], b = acc[ai][1][m][n];
#pragma unroll
                        for (int r = 0; r < 4; ++r) o[n][r] = a[r] * sigmoidf_(b[r]); }
                    st_bf16x8(aglu + (size_t)row * DM + pn * 128 + ct, o[0], o[1]); }
        } else if (pn < 16) {
            const bool isK = pn >= 12; const int h = (pn - 8) & 3; const float sc = isK ? 0.0625f : 1.0f; bf16_t* dst = isK ? k : q;
#pragma unroll
            for (int ai = 0; ai < 2; ++ai)
#pragma unroll
                for (int m = 0; m < 4; ++m) { const int row = row0 + ai * 128 + m * 16; const bool lat = row >= TC; const int pos = (row - TC) & 2047, gr = pos >> 6, gc = pos & 63; f32x4 o1[2], o2[2];
#pragma unroll
                    for (int n = 0; n < 2; ++n) { const int d1 = ct + n * 4; const f32x4 x1 = acc[ai][0][m][n] * sc, x2 = acc[ai][1][m][n] * sc; o1[n] = x1; o2[n] = x2;
                        if (lat) { const int ti = (d1 < 64) ? gr * 64 + d1 : gc * 64 + d1 - 64; const f32x4 cs = *(const f32x4*)(rcos + ti), sn = *(const f32x4*)(rsin + ti);
                            o1[n] = x1 * cs - x2 * sn; o2[n] = x2 * cs + x1 * sn; }
                        if (isK) {
#pragma unroll
                            for (int r = 0; r < 4; ++r) { kt[(size_t)(h * 256 + d1 + r) * TT + row] = bf16_1(o1[n][r]); kt[(size_t)(h * 256 + 128 + d1 + r) * TT + row] = bf16_1(o2[n][r]); } } }
                    st_bf16x8(dst + (size_t)row * DM + h * 256 + ct, o1[0], o1[1]); st_bf16x8(dst + (size_t)row * DM + h * 256 + 128 + ct, o2[0], o2[1]); }
        } else if (pn < 24) {
            const int e0 = (pn - 16) * 256 + wr * 64 + fr, t0 = u.pm * 256 + ct;
#pragma unroll
            for (int ai = 0; ai < 2; ++ai)
#pragma unroll
                for (int m = 0; m < 4; ++m) { bf16_t* vr = vt + (size_t)(e0 + ai * 128 + m * 16) * TT + t0;
#pragma unroll
                    for (int bj = 0; bj < 2; ++bj) st_bf16x8(vr + bj * 128, acc[ai][bj][m][0], acc[ai][bj][m][1]); }
        } else {
            const bool isG = pn >= 32; bf16_t* dst = isG ? gate : rg; const int cb = ((pn - 24) & 7) * 256;
#pragma unroll
            for (int ai = 0; ai < 2; ++ai)
#pragma unroll
                for (int m = 0; m < 4; ++m) { const int row = row0 + ai * 128 + m * 16;
#pragma unroll
                    for (int bj = 0; bj < 2; ++bj) { f32x4 o[2];
#pragma unroll
                        for (int n = 0; n < 2; ++n) { const f32x4 v = acc[ai][bj][m][n];
#pragma unroll
                            for (int r = 0; r < 4; ++r) { const float s = sigmoidf_(v[r]); o[n][r] = isG ? s : v[r] * s; } }
                        st_bf16x8(dst + (size_t)row * VW + cb + bj * 128 + ct, o[0], o[1]); } }
        }
    }
};

struct EpiE1 {
    static constexpr bool SPLIT = true;
    __device__ __forceinline__ bool swapped(const Unit&) const { return false; }
    bf16_t* m1; const bf16_t* gate;
    __device__ __forceinline__ void rg(int ai, int m, const f32x4 (&v)[2][2], const Unit& u, int wr, int wc, int fr, int fq) const {
        const int row = u.pm * 256 + wr * 64 + fr + ai * 128 + m * 16, col0 = u.pn * 256 + wc * 32 + 8 * fq;
#pragma unroll
        for (int bj = 0; bj < 2; ++bj) { const int col = col0 + bj * 128; const u32x4 gv = *(const u32x4*)(gate + (size_t)row * VW + col); const f32x4 v0 = v[bj][0], v1 = v[bj][1];
            f32x4 o0, o1; o0[0] = v0[0] * bf_lo(gv.x); o0[1] = v0[1] * bf_hi(gv.x); o0[2] = v0[2] * bf_lo(gv.y); o0[3] = v0[3] * bf_hi(gv.y);
            o1[0] = v1[0] * bf_lo(gv.z); o1[1] = v1[1] * bf_hi(gv.z); o1[2] = v1[2] * bf_lo(gv.w); o1[3] = v1[3] * bf_hi(gv.w);
            st_bf16x8(m1 + (size_t)row * DM + col, o0, o1); }
    }
    __device__ __forceinline__ void operator()(AccRef acc, const Unit& u, int wr, int wc, int fr, int fq) const {
#pragma unroll
        for (int a = 0; a < 2; ++a)
#pragma unroll
            for (int m = 0; m < 4; ++m) { const f32x4 v[2][2] = {{acc[a][0][m][0], acc[a][0][m][1]}, {acc[a][1][m][0], acc[a][1][m][1]}}; rg(a, m, v, u, wr, wc, fr, fq); }
    }
};
struct EpiE2 {
    static constexpr bool SPLIT = true;
    __device__ __forceinline__ bool swapped(const Unit&) const { return false; }
    const bf16_t* m1; const bf16_t* gate; bf16_t* mm;
    __device__ __forceinline__ void rg(int ai, int m, const f32x4 (&v)[2][2], const Unit& u, int wr, int wc, int fr, int fq) const {
        const int row = u.pm * 256 + wr * 64 + fr + ai * 128 + m * 16, col0 = u.pn * 256 + wc * 32 + 8 * fq;
#pragma unroll
        for (int bj = 0; bj < 2; ++bj) { const int col = col0 + bj * 128; const u32x4 gv = *(const u32x4*)(gate + (size_t)row * VW + DM + col), mv = *(const u32x4*)(m1 + (size_t)row * DM + col); const f32x4 v0 = v[bj][0], v1 = v[bj][1];
            f32x4 o0, o1; o0[0] = bf_lo(mv.x) + v0[0] * bf_lo(gv.x); o0[1] = bf_hi(mv.x) + v0[1] * bf_hi(gv.x); o0[2] = bf_lo(mv.y) + v0[2] * bf_lo(gv.y); o0[3] = bf_hi(mv.y) + v0[3] * bf_hi(gv.y);
            o1[0] = bf_lo(mv.z) + v1[0] * bf_lo(gv.z); o1[1] = bf_hi(mv.z) + v1[1] * bf_hi(gv.z); o1[2] = bf_lo(mv.w) + v1[2] * bf_lo(gv.w); o1[3] = bf_hi(mv.w) + v1[3] * bf_hi(gv.w);
            st_bf16x8(mm + (size_t)row * DM + col, o0, o1); }
    }
    __device__ __forceinline__ void operator()(AccRef acc, const Unit& u, int wr, int wc, int fr, int fq) const {
#pragma unroll
        for (int a = 0; a < 2; ++a)
#pragma unroll
            for (int m = 0; m < 4; ++m) { const f32x4 v[2][2] = {{acc[a][0][m][0], acc[a][0][m][1]}, {acc[a][1][m][0], acc[a][1][m][1]}}; rg(a, m, v, u, wr, wc, fr, fq); }
    }
};
template <bool SPLIT_> struct EpiResT {
    static constexpr bool SPLIT = SPLIT_;
    __device__ __forceinline__ bool swapped(const Unit&) const { return false; }
    const float *xa, *xb; float* xout; const float* gvec;
    __device__ __forceinline__ void rg(int ai, int m, const f32x4 (&v)[2][2], const Unit& u, int wr, int wc, int fr, int fq) const {
        const int row = u.pm * 256 + wr * 64 + fr + ai * 128 + m * 16, col0 = u.pn * 256 + wc * 32 + 8 * fq;
        const float* xr = row < TC ? xa + (size_t)row * DM : xb + (size_t)(row - TC) * DM; const float* gr = gvec + row_group(row) * 6144;
#pragma unroll
        for (int bj = 0; bj < 2; ++bj)
#pragma unroll
            for (int n = 0; n < 2; ++n) { const int col = col0 + bj * 128 + n * 4; const f32x4 xv = *(const f32x4*)(xr + col), gv = *(const f32x4*)(gr + col);
                *(f32x4*)(xout + (size_t)row * DM + col) = xv + gv * v[bj][n]; }
    }
    __device__ __forceinline__ void operator()(AccRef acc, const Unit& u, int wr, int wc, int fr, int fq) const {
#pragma unroll
        for (int a = 0; a < 2; ++a)
#pragma unroll
            for (int m = 0; m < 4; ++m) { const f32x4 v[2][2] = {{acc[a][0][m][0], acc[a][0][m][1]}, {acc[a][1][m][0], acc[a][1][m][1]}}; rg(a, m, v, u, wr, wc, fr, fq); }
    }
};
struct EpiF1 {
    static constexpr bool SPLIT = false;
    __device__ __forceinline__ bool swapped(const Unit&) const { return false; }
    bf16_t* uo;
    __device__ __forceinline__ void operator()(AccRef acc, const Unit& u, int wr, int wc, int fr, int fq) const {
        const int row0 = u.pm * 256 + wr * 64 + fr, col0 = u.pn * 256 + wc * 32 + 8 * fq;
#pragma unroll
        for (int ai = 0; ai < 2; ++ai)
#pragma unroll
            for (int m = 0; m < 4; ++m) { const int row = row0 + ai * 128 + m * 16;
#pragma unroll
                for (int bj = 0; bj < 2; ++bj) { f32x4 o[2];
#pragma unroll
                    for (int n = 0; n < 2; ++n) { const f32x4 v = acc[ai][bj][m][n];
#pragma unroll
                        for (int r = 0; r < 4; ++r) { const float t = fmaxf(v[r], 0.f); o[n][r] = t * t; } }
                    st_bf16x8(uo + (size_t)row * MLPW + col0 + bj * 128, o[0], o[1]); } }
    }
};

__device__ __forceinline__ void tconv_item(const float* __restrict__ src, bf16_t* __restrict__ dst, int K, int N, int item, bool permIn, float* tile  ) {
    const int tilesN = N >> 8, kt = item / tilesN, ntile = item - kt * tilesN, k0 = kt * 64, n0 = ntile * 256, tid = tid_opaque();
    { const int r = tid >> 6, c4 = (tid & 63) * 4; f32x4 v[8];
#pragma unroll
      for (int rr = 0; rr < 8; ++rr) v[rr] = __builtin_nontemporal_load((const f32x4*)(src + (size_t)(k0 + r + rr * 8) * N + n0 + c4));
#pragma unroll
      for (int rr = 0; rr < 8; ++rr) { float* t = tile + (r + rr * 8) * 257 + c4; t[0] = v[rr][0]; t[1] = v[rr][1]; t[2] = v[rr][2]; t[3] = v[rr][3]; } }
    __syncthreads();
#pragma unroll
    for (int q = 0; q < 4; ++q) { const int n = q * 64 + (tid >> 3), k8 = (tid & 7) * 8; float v[8];
#pragma unroll
      for (int e = 0; e < 8; ++e) v[e] = tile[(k8 + e) * 257 + n];
      int nn = n0 + n;
      if (permIn && nn < 2048) { const int c = nn & 1023, half = nn >> 10; nn = (c >> 7) * 256 + half * 128 + (c & 127); }
      u32x4 w; w.x = cvt_pk_bf16(v[0], v[1]); w.y = cvt_pk_bf16(v[2], v[3]); w.z = cvt_pk_bf16(v[4], v[5]); w.w = cvt_pk_bf16(v[6], v[7]);
      *(u32x4*)(dst + (size_t)nn * K + k0 + k8) = w; }
    __syncthreads();
}

__device__ void phase0(const Params& p, unsigned char* smem) {
    float* tile = (float*)smem;
    float* scond = (float*)(smem + 66048);
    float* red = (float*)(smem + 66048 + 36864);
    const int tid = tid_opaque();
    constexpr int NT_L = 1408, NT = 2 * NT_L, NMOD = 192;
    for (int it = blockIdx.x; it < NT + NMOD + 1; it += gridDim.x) {
        if (it < NT) {
            const int l = it / NT_L; int j = it - l * NT_L; unsigned char* wb = p.ws + WS_W + (size_t)l * WL_SZ;
            if (j < 640) tconv_item(p.in[9] + (size_t)l * DM * PW, (bf16_t*)(wb + WL_IN), DM, PW, j, true, tile);
            else if ((j -= 640) < 64) tconv_item(p.in[13] + (size_t)l * DM * DM, (bf16_t*)(wb + WL_CONV), DM, DM, j, false, tile);
            else if ((j -= 64) < 128) tconv_item(p.in[15] + (size_t)l * VW * DM, (bf16_t*)(wb + WL_RET), VW, DM, j, false, tile);
            else if ((j -= 128) < 64) tconv_item(p.in[16] + (size_t)l * DM * DM, (bf16_t*)(wb + WL_OUT), DM, DM, j, false, tile);
            else if ((j -= 64) < 256) tconv_item(p.in[17] + (size_t)l * DM * MLPW, (bf16_t*)(wb + WL_M1), DM, MLPW, j, false, tile);
            else { j -= 256; tconv_item(p.in[18] + (size_t)l * MLPW * DM, (bf16_t*)(wb + WL_M2), MLPW, DM, j, false, tile); }
        } else if (it < NT + NMOD) {
            const int j = it - NT, l = j / 96, c0 = (j % 96) * 64;
            for (int idx = tid; idx < 9 * 1024; idx += NTHR) { const int g = idx >> 10, k = idx & 1023; const float v = g == 0 ? p.in[4][k] : p.in[2][(g - 1) * 1024 + k]; scond[idx] = siluf_(v); }
            __syncthreads();
            const int col = tid & 63, kg = tid >> 6; float a[9];
#pragma unroll
            for (int g = 0; g < 9; ++g) a[g] = 0.f;
            const float* wm = p.in[7] + (size_t)l * DM * 6144 + c0 + col;
#pragma unroll 16
            for (int k = kg * 128; k < kg * 128 + 128; ++k) { const float w = __builtin_nontemporal_load(wm + (size_t)k * 6144);
#pragma unroll
                for (int g = 0; g < 9; ++g) a[g] += scond[g * 1024 + k] * w; }
#pragma unroll
            for (int g = 0; g < 9; ++g) red[(kg * 9 + g) * 64 + col] = a[g];
            __syncthreads();
            for (int o = tid; o < 9 * 64; o += NTHR) { const int g = o >> 6, cc = o & 63; float s = 0.f;
#pragma unroll
                for (int q = 0; q < 8; ++q) s += red[(q * 9 + g) * 64 + cc];
                ((float*)(p.ws + WS_MOD))[(size_t)(l * 9 + g) * 6144 + c0 + cc] = s + p.in[8][l * 6144 + c0 + cc]; }
            __syncthreads();
        } else {
            float* rc = (float*)(p.ws + WS_ROPE); float* rs = rc + 4096;
            if (tid < 128) ((unsigned*)(p.ws + WS_CNT))[tid] = 0u;
            for (int idx = tid; idx < 4096; idx += NTHR) { const int pos = idx >> 6, i = idx & 63; const float inv = exp2f(-(float)i * (13.287712379549449f / 64.f)); const float ang = (float)pos * inv;
                rc[idx] = __cosf(ang); rs[idx] = __sinf(ang); }
        }
    }
}

__device__ void norm_mod_phase(const float* xa, const float* xb, bf16_t* dst, const float* ng, const float* modl, int sh_chunk) {
    const int tid = tid_opaque(), lane = tid & 63, gw = blockIdx.x * 8 + (tid >> 6), nw = gridDim.x * 8;
    for (int row0 = gw; row0 < TT; row0 += 2 * nw) {
        f32x4 v[2][4]; float ss[2];
#pragma unroll
        for (int q = 0; q < 2; ++q) { const int row = min(row0 + q * nw, TT - 1); const float* xr = row < TC ? xa + (size_t)row * DM : xb + (size_t)(row - TC) * DM;
#pragma unroll
            for (int i = 0; i < 4; ++i) v[q][i] = __builtin_nontemporal_load((const f32x4*)(xr + i * 256 + lane * 4)); }
#pragma unroll
        for (int q = 0; q < 2; ++q) { float s = 0.f;
#pragma unroll
            for (int i = 0; i < 4; ++i) s += v[q][i][0] * v[q][i][0] + v[q][i][1] * v[q][i][1] + v[q][i][2] * v[q][i][2] + v[q][i][3] * v[q][i][3];
            ss[q] = s; }
#pragma unroll
        for (int q = 0; q < 2; ++q) { const int row = row0 + q * nw; if (row >= TT) break;
            const float rstd = rsqrtf(wave_sum(ss[q]) * (1.f / DM) + EPSV); const float* md = modl + row_group(row) * 6144;
#pragma unroll
            for (int i = 0; i < 4; ++i) { const int c = i * 256 + lane * 4; const f32x4 g = *(const f32x4*)(ng + c), sh = *(const f32x4*)(md + sh_chunk * 1024 + c), sc = *(const f32x4*)(md + (sh_chunk + 1) * 1024 + c);
                const f32x4 o = v[q][i] * rstd * g * (sc + 1.f) + sh; st_bf16x4(dst + (size_t)row * DM + c, o); } }
    }
}
__device__ void final_norm_phase(float* x, const float* ng) {
    const int tid = tid_opaque(), lane = tid & 63, gw = blockIdx.x * 8 + (tid >> 6), nw = gridDim.x * 8;
    for (int row = gw; row < TT; row += nw) {
        float* xr = x + (size_t)row * DM; f32x4 v[4]; float ss = 0.f;
#pragma unroll
        for (int i = 0; i < 4; ++i) { v[i] = __builtin_nontemporal_load((const f32x4*)(xr + i * 256 + lane * 4)); ss += v[i][0] * v[i][0] + v[i][1] * v[i][1] + v[i][2] * v[i][2] + v[i][3] * v[i][3]; }
        ss = wave_sum(ss); const float rstd = rsqrtf(ss * (1.f / DM) + EPSV);
#pragma unroll
        for (int i = 0; i < 4; ++i) { const int c = i * 256 + lane * 4; const f32x4 g = *(const f32x4*)(ng + c); __builtin_nontemporal_store(v[i] * rstd * g, (f32x4*)(xr + c)); }
    }
}

__device__ void conv_phase(const Params& p, int l, unsigned char* smem) {
    const int tid = tid_opaque(), lane = tid & 63, wv = tid >> 6;
    const bf16_t* aglu = (const bf16_t*)(p.ws + WS_R2); bf16_t* aconv = (bf16_t*)(p.ws + WS_R1);
    float* red = (float*)(smem + 46 * 2048);
    float* rst = red + 128;
    const int c0 = 2 * tid;
    float w0[31], w1[31];
#pragma unroll
    for (int j = 0; j < 31; ++j) { const f32x2 wv2 = *(const f32x2*)(p.in[10] + (size_t)(l * 31 + j) * DM + c0); w0[j] = wv2.x; w1[j] = wv2.y; }
    const f32x2 bias = *(const f32x2*)(p.in[11] + l * DM + c0), gn = *(const f32x2*)(p.in[12] + l * DM + c0);
    for (int it = blockIdx.x; it < TT / 16; it += gridDim.x) {
        const int t0 = it * 16, segl = t0 < TC ? 256 : 64, ss = t0 & ~(segl - 1), se = ss + segl;
        for (int idx = tid; idx < 46 * 128; idx += NTHR) { const int rr = idx >> 7, ch = idx & 127, tt = t0 - 15 + rr; u32x4 v = (u32x4){0u, 0u, 0u, 0u};
            if (tt >= ss && tt < se) v = *(const u32x4*)(aglu + (size_t)tt * DM + ch * 8);
            *(u32x4*)(smem + rr * 2048 + ch * 16) = v; }
        __syncthreads();
        float a0[16], a1[16];
#pragma unroll
        for (int t = 0; t < 16; ++t) { a0[t] = bias.x; a1[t] = bias.y; }
#pragma unroll
        for (int rr = 0; rr < 46; ++rr) { const unsigned uv = *(const unsigned*)(smem + rr * 2048 + c0 * 2); const float lo = bf_lo(uv), hi = bf_hi(uv);
#pragma unroll
            for (int t = 0; t < 16; ++t) { const int j = rr - t; if (j >= 0 && j < 31) { a0[t] += w0[j] * lo; a1[t] += w1[j] * hi; } } }
#pragma unroll
        for (int t = 0; t < 16; ++t) { const float s = wave_sum(a0[t] * a0[t] + a1[t] * a1[t]); if (lane == 0) red[wv * 16 + t] = s; }
        __syncthreads();
        if (tid < 16) { float s = 0.f;
#pragma unroll
            for (int q = 0; q < 8; ++q) s += red[q * 16 + tid];
            rst[tid] = rsqrtf(s * (1.f / DM) + EPSV); }
        __syncthreads();
#pragma unroll
        for (int t = 0; t < 16; ++t) { const float r = rst[t]; *(unsigned*)(aconv + (size_t)(t0 + t) * DM + c0) = cvt_pk_bf16(siluf_(a0[t] * r * gn.x), siluf_(a1[t] * r * gn.y)); }
        __syncthreads();
    }
}

__device__ void ret_phase(const Params& p, int l, unsigned char* smem) {
    LAS unsigned char* lds = (LAS unsigned char*)smem;
    const int tid = tid_opaque(), lane = tid & 63, w = __builtin_amdgcn_readfirstlane(tid >> 6), fr = lane & 15, fq = lane >> 4;
    const bf16_t* Qg = (const bf16_t*)(p.ws + WS_Q); const bf16_t* Kg = (const bf16_t*)(p.ws + WS_K); const bf16_t* KTg = (const bf16_t*)(p.ws + WS_KT); const bf16_t* VTg = (const bf16_t*)(p.ws + WS_VT);
    constexpr int QOFF = 0, KTOFF = 65536;
    const unsigned voffQ = (unsigned)(((2 * w + (lane >> 5)) * DM + (((lane & 31) ^ ((2 * w + (lane >> 5)) & 15))) * 8) * 2);
    const unsigned voffKT = (unsigned)(((4 * w + (lane >> 4)) * TT + (((lane & 15) ^ ((((2 * w + (lane >> 5)) & 12)) | ((lane >> 4) & 3)))) * 8) * 2);
    const unsigned voffK = (unsigned)(((16 * w + fr) * DM + fq * 8) * 2);
    const unsigned voffV = (unsigned)(((16 * w + fr) * TT + fq * 8) * 2);
    const unsigned voffY = (unsigned)(((4 * fq) * VW + 16 * w + fr) * 2);
    int xb[4];
#pragma unroll
    for (int k4 = 0; k4 < 4; ++k4) xb[k4] = ((k4 * 4 + fq) ^ fr) * 16;
    for (int it = blockIdx.x; it < 768; it += gridDim.x) {
        int es, dir, h, bb, tok0, nch; const bool lat = it < 256;
        { const int j = lat ? it : it - 256, x = j & 7, y = j >> 3; es = y & 3; const int cmb = (y >> 2) * 8 + x; dir = cmb & 1; h = (cmb >> 1) & 3; bb = cmb >> 3;
          tok0 = lat ? TC + bb * 2048 : bb * 256; nch = lat ? 16 : 2; }
        const float dl = p.in[14][l * 8 + dir * 4 + h]; const float lg2 = -log1pf(expf(-dl)) * 1.4426950408889634f;
        const float sdec = exp2f(128.f * lg2);
        const float zl = dir ? -lg2 : lg2, zb2 = (float)(dir ? 128 - 4 * fq : 4 * fq + 1) * lg2, kb2 = (float)(dir ? 8 * fq : 127 - 8 * fq) * lg2;
        const int pbase = dir ? (16 * w + 4 * fq - fr) : (fr - 16 * w - 4 * fq);
        f32x4 S[16];
        const unsigned voffS = (unsigned)((8 * fq * 512 + 16 * w + fr) * 4);
        if (lat) { const float* sp = p.in[3] + ((((size_t)bb * 2 + l) * 2 + dir) * 4 + h) * 256 * 512 + es * 128;
#pragma unroll
            for (int D = 0; D < 16; ++D)
#pragma unroll
                for (int r = 0; r < 4; ++r) S[D][r] = __builtin_nontemporal_load((const float*)((const char*)(sp + ((D >> 1) * 32 + 4 * (D & 1) + r) * 512) + voffS));
        } else {
#pragma unroll
            for (int D = 0; D < 16; ++D) S[D] = (f32x4){0.f, 0.f, 0.f, 0.f};
        }
        bf16_t* Yg = (bf16_t*)(p.ws + (dir ? WS_YB : WS_YF));
        for (int s = 0; s < nch; ++s) {
            const int c = dir ? nch - 1 - s : s, r0 = tok0 + c * 128;
            { const bf16_t* qu = Qg + (size_t)r0 * DM + h * 256; const bf16_t* ku = KTg + (size_t)(h * 256) * TT + r0;
#pragma unroll
              for (int n = 0; n < 8; ++n) {
                  __builtin_amdgcn_global_load_lds((const unsigned*)((const char*)(qu + (size_t)(n * 16) * DM) + voffQ), (LAS unsigned*)(lds + QOFF + (n * 8 + w) * 1024), 16, 0, 0);
                  __builtin_amdgcn_global_load_lds((const unsigned*)((const char*)(ku + (size_t)(n * 32) * TT) + voffKT), (LAS unsigned*)(lds + KTOFF + (n * 8 + w) * 1024), 16, 0, 0); } }
            bf16x8 Kf[8], Vf[4];
            { const char* kb = (const char*)(Kg + (size_t)r0 * DM + h * 256) + voffK;
#pragma unroll
              for (int ks = 0; ks < 4; ++ks) Kf[ks] = *(const bf16x8*)(kb + ks * 64); }
            asm volatile("s_waitcnt vmcnt(0)" ::: "memory");
            __syncthreads();
            { const char* kb = (const char*)(Kg + (size_t)r0 * DM + h * 256) + voffK;
#pragma unroll
              for (int ks = 4; ks < 8; ++ks) Kf[ks] = *(const bf16x8*)(kb + ks * 64); }
            f32x4 Z[8], PT[8];
#pragma unroll
            for (int i8 = 0; i8 < 8; ++i8) { Z[i8] = (f32x4){0.f, 0.f, 0.f, 0.f}; PT[i8] = (f32x4){0.f, 0.f, 0.f, 0.f}; }
#define QFRAG(ks, i8) (*(const LAS bf16x8*)(lds + QOFF + xb[(ks) & 3] + fr * 512 + (i8) * 8192 + ((ks) >> 2) * 256))
            { bf16x8 qa[4], qb[4];
#pragma unroll
              for (int j = 0; j < 4; ++j) qa[j] = QFRAG(0, j);
#pragma unroll
              for (int ks = 0; ks < 8; ++ks) { u32x4 t; t.x = cvt_pk_bf16(S[2 * ks][0], S[2 * ks][1]); t.y = cvt_pk_bf16(S[2 * ks][2], S[2 * ks][3]); t.z = cvt_pk_bf16(S[2 * ks + 1][0], S[2 * ks + 1][1]); t.w = cvt_pk_bf16(S[2 * ks + 1][2], S[2 * ks + 1][3]);
                  const bf16x8 Sb = __builtin_bit_cast(bf16x8, t);
#pragma unroll
                  for (int j = 0; j < 4; ++j) qb[j] = QFRAG(ks, 4 + j);
                  __builtin_amdgcn_sched_barrier(0);
#pragma unroll
                  for (int j = 0; j < 4; ++j) { Z[j] = __builtin_amdgcn_mfma_f32_16x16x32_bf16(qa[j], Sb, Z[j], 0, 0, 0); PT[j] = __builtin_amdgcn_mfma_f32_16x16x32_bf16(Kf[ks], qa[j], PT[j], 0, 0, 0); }
                  __builtin_amdgcn_sched_barrier(0);
                  if (ks < 7) {
#pragma unroll
                      for (int j = 0; j < 4; ++j) qa[j] = QFRAG(ks + 1, j); }
                  __builtin_amdgcn_sched_barrier(0);
#pragma unroll
                  for (int j = 0; j < 4; ++j) { Z[4 + j] = __builtin_amdgcn_mfma_f32_16x16x32_bf16(qb[j], Sb, Z[4 + j], 0, 0, 0); PT[4 + j] = __builtin_amdgcn_mfma_f32_16x16x32_bf16(Kf[ks], qb[j], PT[4 + j], 0, 0, 0); }
                  __builtin_amdgcn_sched_barrier(0); } }
#undef QFRAG
            { const char* vb = (const char*)(VTg + (size_t)(h * 512 + es * 128) * TT + r0) + voffV;
#pragma unroll
              for (int ks = 0; ks < 4; ++ks) Vf[ks] = *(const bf16x8*)(vb + ks * 64); }
            float zb2_ = zb2, zl_ = zl, kb2_ = kb2; int pbase_ = pbase;
            asm volatile("" : "+v"(zb2_), "+v"(zl_), "+v"(kb2_), "+v"(pbase_));
            { f32x4 zf, pf; const float z16 = __builtin_amdgcn_exp2f(16.f * zl_);
#pragma unroll
              for (int r = 0; r < 4; ++r) { zf[r] = __builtin_amdgcn_exp2f(zb2_ + (float)r * zl_); pf[r] = __builtin_amdgcn_exp2f((float)(pbase_ + (dir ? r : -r)) * lg2); }
#pragma unroll
              for (int i8 = 0; i8 < 8; ++i8) {
#pragma unroll
                  for (int r = 0; r < 4; ++r) { Z[i8][r] *= zf[r];
                      const int df = pbase_ + (dir ? -(i8 * 16 - r) : (i8 * 16 - r)); PT[i8][r] = df >= 0 ? PT[i8][r] * pf[r] : 0.f; }
                  zf *= z16; pf *= z16; } }
            __syncthreads();
#pragma unroll
            for (int i8 = 0; i8 < 8; ++i8) { const int i = i8 * 16 + fr; u32x2 t; t.x = cvt_pk_bf16(PT[i8][0], PT[i8][1]); t.y = cvt_pk_bf16(PT[i8][2], PT[i8][3]);
                *(LAS u32x2*)(lds + QOFF + i * 256 + (((2 * w + (fq >> 1)) ^ fr)) * 16 + (fq & 1) * 8) = t; }
            __syncthreads();
#define PFRAG(i8, ks) (*(const LAS bf16x8*)(lds + QOFF + xb[ks] + fr * 256 + (i8) * 4096))
            { bf16x8 pa[4], pb[4];
#pragma unroll
              for (int ks = 0; ks < 4; ++ks) pa[ks] = PFRAG(0, ks);
#pragma unroll
              for (int i8 = 0; i8 < 8; i8 += 2) {
#pragma unroll
                  for (int ks = 0; ks < 4; ++ks) pb[ks] = PFRAG(i8 + 1, ks);
                  __builtin_amdgcn_sched_barrier(0);
#pragma unroll
                  for (int ks = 0; ks < 4; ++ks) Z[i8] = __builtin_amdgcn_mfma_f32_16x16x32_bf16(pa[ks], Vf[ks], Z[i8], 0, 0, 0);
                  __builtin_amdgcn_sched_barrier(0);
                  if (i8 < 6) {
#pragma unroll
                      for (int ks = 0; ks < 4; ++ks) pa[ks] = PFRAG(i8 + 2, ks); }
                  __builtin_amdgcn_sched_barrier(0);
#pragma unroll
                  for (int ks = 0; ks < 4; ++ks) Z[i8 + 1] = __builtin_amdgcn_mfma_f32_16x16x32_bf16(pb[ks], Vf[ks], Z[i8 + 1], 0, 0, 0);
                  __builtin_amdgcn_sched_barrier(0); } }
#undef PFRAG
#pragma unroll
            for (int i8 = 0; i8 < 8; ++i8)
#pragma unroll
                for (int r = 0; r < 4; ++r) *(bf16_t*)((char*)(Yg + (size_t)(r0 + i8 * 16 + r) * VW + h * 512 + es * 128) + voffY) = bf16_1(Z[i8][r]);
            bf16x8 Vs[4];
            float kf8[8], kstep[4];
#pragma unroll
            for (int e = 0; e < 8; ++e) kf8[e] = __builtin_amdgcn_exp2f(kb2_ - (float)e * zl_);
            { const float k32 = __builtin_amdgcn_exp2f(-32.f * zl_); kstep[0] = 1.f; kstep[1] = k32; kstep[2] = k32 * k32; kstep[3] = kstep[2] * k32; }
#pragma unroll
            for (int ks = 0; ks < 4; ++ks) { const u32x4 t = __builtin_bit_cast(u32x4, Vf[ks]); float f[8]; f[0] = bf_lo(t.x); f[1] = bf_hi(t.x); f[2] = bf_lo(t.y); f[3] = bf_hi(t.y); f[4] = bf_lo(t.z); f[5] = bf_hi(t.z); f[6] = bf_lo(t.w); f[7] = bf_hi(t.w);
#pragma unroll
                for (int e = 0; e < 8; ++e) f[e] *= kf8[e] * kstep[ks];
                u32x4 o; o.x = cvt_pk_bf16(f[0], f[1]); o.y = cvt_pk_bf16(f[2], f[3]); o.z = cvt_pk_bf16(f[4], f[5]); o.w = cvt_pk_bf16(f[6], f[7]); Vs[ks] = __builtin_bit_cast(bf16x8, o); }
#define TFRAG(D, ks) (*(const LAS bf16x8*)(lds + KTOFF + xb[ks] + (8 * (fr >> 2) + (fr & 3)) * 256 + ((D) >> 1) * 8192 + ((D) & 1) * 1024))
            { bf16x8 ta[4], tb[4];
#pragma unroll
              for (int ks = 0; ks < 4; ++ks) ta[ks] = TFRAG(0, ks);
#pragma unroll
              for (int D = 0; D < 16; D += 2) { S[D] *= sdec; S[D + 1] *= sdec;
#pragma unroll
                  for (int ks = 0; ks < 4; ++ks) tb[ks] = TFRAG(D + 1, ks);
                  __builtin_amdgcn_sched_barrier(0);
#pragma unroll
                  for (int ks = 0; ks < 4; ++ks) S[D] = __builtin_amdgcn_mfma_f32_16x16x32_bf16(ta[ks], Vs[ks], S[D], 0, 0, 0);
                  __builtin_amdgcn_sched_barrier(0);
                  if (D < 14) {
#pragma unroll
                      for (int ks = 0; ks < 4; ++ks) ta[ks] = TFRAG(D + 2, ks); }
                  __builtin_amdgcn_sched_barrier(0);
#pragma unroll
                  for (int ks = 0; ks < 4; ++ks) S[D + 1] = __builtin_amdgcn_mfma_f32_16x16x32_bf16(tb[ks], Vs[ks], S[D + 1], 0, 0, 0);
                  __builtin_amdgcn_sched_barrier(0); } }
#undef TFRAG
            __syncthreads();
        }
        if (!lat) { float* so = p.out + (size_t)TT * DM + ((((size_t)bb * 2 + l) * 2 + dir) * 4 + h) * 256 * 512 + es * 128;
#pragma unroll
            for (int D = 0; D < 16; ++D)
#pragma unroll
                for (int r = 0; r < 4; ++r) __builtin_nontemporal_store(S[D][r], (float*)((char*)(so + ((D >> 1) * 32 + 4 * (D & 1) + r) * 512) + voffS)); }
    }
}

__device__ void comb_phase(const Params& p) {
    const int tid = tid_opaque(), lane = tid & 63, gw = blockIdx.x * 8 + (tid >> 6), nw = gridDim.x * 8;
    const bf16_t* yf = (const bf16_t*)(p.ws + WS_YF); const bf16_t* yb = (const bf16_t*)(p.ws + WS_YB); const bf16_t* rg = (const bf16_t*)(p.ws + WS_RG); bf16_t* ar = (bf16_t*)(p.ws + WS_Q);
    for (int tok = gw; tok < TT; tok += nw) {
        u32x4 a[4], b[4], g[4];
#pragma unroll
        for (int h = 0; h < 4; ++h) { const size_t off = (size_t)tok * VW + h * 512 + lane * 8; a[h] = __builtin_nontemporal_load((const u32x4*)(yf + off)); b[h] = __builtin_nontemporal_load((const u32x4*)(yb + off)); g[h] = __builtin_nontemporal_load((const u32x4*)(rg + off)); }
#pragma unroll
        for (int h = 0; h < 4; ++h) {
            float y[8];
#pragma unroll
            for (int e = 0; e < 4; ++e) { y[2 * e] = bf_lo(a[h][e]) + bf_lo(b[h][e]); y[2 * e + 1] = bf_hi(a[h][e]) + bf_hi(b[h][e]); }
            float s = 0.f;
#pragma unroll
            for (int e = 0; e < 8; ++e) s += y[e];
            const float mu = wave_sum(s) * (1.f / 512.f); float v = 0.f;
#pragma unroll
            for (int e = 0; e < 8; ++e) { y[e] -= mu; v += y[e] * y[e]; }
            const float rstd = rsqrtf(wave_sum(v) * (1.f / 512.f) + EPSV);
            u32x4 o;
#pragma unroll
            for (int e = 0; e < 4; ++e) o[e] = cvt_pk_bf16(y[2 * e] * rstd * bf_lo(g[h][e]), y[2 * e + 1] * rstd * bf_hi(g[h][e]));
            *(u32x4*)(ar + (size_t)tok * VW + h * 512 + lane * 8) = o;
        }
    }
}


#define XB_TMO      128
#define XB_XCNT(j)  (256  + 64 * (j))
#define XB_XSUB(j)  (1280 + 64 * (j))
#define XB_XGEN(j)  (2304 + 64 * (j))
#define XB_TOP      3328
#define XB_TOPGEN   3392
#define XCD_BAR_WORDS 3456
#define XB_SPIN_CAP (1u << 18)
__device__ __forceinline__ unsigned xb_ld(unsigned* p)              { return __hip_atomic_load(p, __ATOMIC_RELAXED, __HIP_MEMORY_SCOPE_AGENT); }
__device__ __forceinline__ unsigned xb_add(unsigned* p, unsigned v) { return __hip_atomic_fetch_add(p, v, __ATOMIC_RELAXED, __HIP_MEMORY_SCOPE_AGENT); }
__device__ __forceinline__ unsigned xb_xcc_id() { return (unsigned)__builtin_amdgcn_s_getreg((3 << 11) | 20) & 0xFu; }
#define XB_SPIN(cond, bar) do { unsigned _sp = 0; while (cond) { __builtin_amdgcn_s_sleep(1); \
    if ((++_sp & 255u) == 0u) { if (xb_ld(&(bar)[XB_TMO])) break; if (_sp > XB_SPIN_CAP) { atomicAdd(&(bar)[XB_TMO], 1u); break; } } } } while (0)
struct XcdBarrier { unsigned* bar; unsigned x; volatile LAS unsigned* st; };
__device__ __forceinline__ XcdBarrier xcd_barrier_post(unsigned* bar, volatile LAS unsigned* st) {
    XcdBarrier b; b.bar = bar; b.x = xb_xcc_id(); b.st = st;
    if (threadIdx.x == 0) (void)xb_add(&bar[XB_XCNT(b.x)], 1u);
    return b;
}
__device__ __forceinline__ void xcd_barrier_complete(unsigned* bar, unsigned x, unsigned& nloc, unsigned& nx) {
    const unsigned G = gridDim.x * gridDim.y * gridDim.z;
    unsigned sum, cnt, mine, sp = 0u;
    for (;;) {
        sum = 0u; cnt = 0u; mine = 0u;
#pragma unroll
        for (unsigned j = 0; j < 16; ++j) { const unsigned c = xb_ld(&bar[XB_XCNT(j)]); sum += c; cnt += (c > 0u) ? 1u : 0u; mine = (j == x) ? c : mine; }
        if (sum == G) break;
        __builtin_amdgcn_s_sleep(1);
        if ((++sp & 255u) == 0u) { if (xb_ld(&bar[XB_TMO])) break; if (sp > XB_SPIN_CAP) { atomicAdd(&bar[XB_TMO], 1u); break; } }
    }
    nloc = mine > 0u ? mine : 1u; nx = cnt > 0u ? cnt : 1u;
}
__device__ __forceinline__ void xcd_barrier(const XcdBarrier& b) {
    asm volatile("s_waitcnt vmcnt(0)" ::: "memory");
    __syncthreads();
    if (threadIdx.x == 0) {
        unsigned* bar = b.bar;
        __builtin_amdgcn_s_waitcnt(0);
        unsigned nloc = b.st[0], nx = b.st[1];
        if (nloc == 0u) { xcd_barrier_complete(bar, b.x, nloc, nx); b.st[0] = nloc; b.st[1] = nx; }
        const unsigned old = xb_add(&bar[XB_XSUB(b.x)], 1u);
        const unsigned gen = old / nloc;
        if (old + 1u == (gen + 1u) * nloc) {
            __builtin_amdgcn_fence(__ATOMIC_RELEASE, "agent");
            asm volatile("s_waitcnt vmcnt(0)" ::: "memory");
            const unsigned og = xb_add(&bar[XB_TOP], 1u);
            const unsigned tg = og / nx;
            if (og + 1u == (tg + 1u) * nx) xb_add(&bar[XB_TOPGEN], 1u);
            else XB_SPIN(xb_ld(&bar[XB_TOPGEN]) == tg, bar);
            __builtin_amdgcn_fence(__ATOMIC_ACQUIRE, "agent");
            xb_add(&bar[XB_XGEN(b.x)], 1u);
            asm volatile("s_waitcnt vmcnt(0)" ::: "memory");
        } else {
            XB_SPIN(xb_ld(&bar[XB_XGEN(b.x)]) == gen, bar);
            __builtin_amdgcn_fence(__ATOMIC_ACQUIRE, "agent");
            asm volatile("s_waitcnt vmcnt(0)" ::: "memory");
        }
    }
    __syncthreads();
}

__global__ void __launch_bounds__(NTHR) mega(Params p) {
    __shared__ __attribute__((aligned(16))) unsigned char smem[131072];
    cg::grid_group grid = cg::this_grid();
    LAS unsigned char* lds = (LAS unsigned char*)smem;
    unsigned char* ws = p.ws;
    float* xbuf = p.out;
    const float* modb = (const float*)(ws + WS_MOD);
    pg8::StaticOrder so;
    __shared__ __attribute__((aligned(16))) unsigned xb_st[4];
    if (threadIdx.x < 4) xb_st[threadIdx.x] = 0u;
    __syncthreads();
    if (blockIdx.x == 1) { const int t = tid_opaque(); for (int i = t; i < XCD_BAR_WORDS; i += NTHR) ((unsigned*)(ws + WS_BAR))[i] = 0u; }
    phase0(p, smem);
    grid.sync();
    const XcdBarrier xbar = xcd_barrier_post((unsigned*)(ws + WS_BAR), (volatile LAS unsigned*)xb_st);
    for (int l = 0; l < 2; ++l) {
        const unsigned char* wl = ws + WS_W + (size_t)l * WL_SZ;
        const float* modl = modb + (size_t)l * 9 * 6144;
        const float* xa = l == 0 ? p.in[0] : xbuf; const float* xb = l == 0 ? p.in[1] : xbuf + (size_t)TC * DM;
        norm_mod_phase(xa, xb, (bf16_t*)(ws + WS_R1), p.in[5] + l * DM, modl, 0);
        xcd_barrier(xbar);
        { pg8::Gemm g{(const bf16_t*)(ws + WS_R1), (const bf16_t*)(wl + WL_IN), TT, PW, DM, nullptr, nullptr}; so.init(TT, PW, gridDim.x, blockIdx.x);
          EpiG1 e{(bf16_t*)(ws + WS_R2), (bf16_t*)(ws + WS_Q), (bf16_t*)(ws + WS_K), (bf16_t*)(ws + WS_KT), (bf16_t*)(ws + WS_VT), (bf16_t*)(ws + WS_RG), (bf16_t*)(ws + WS_GATE), (const float*)(ws + WS_ROPE), (const float*)(ws + WS_ROPE) + 4096};
          pg8::gemm_phase(lds, g, so, e); }
        xcd_barrier(xbar);
        ret_phase(p, l, smem);
        conv_phase(p, l, smem);
        xcd_barrier(xbar);
        { pg8::Gemm g{(const bf16_t*)(ws + WS_R1), (const bf16_t*)(wl + WL_CONV), TT, DM, DM, (unsigned long long*)(ws + WS_DUMP), (unsigned*)(ws + WS_CNT)}; so.init(TT, DM, gridDim.x, blockIdx.x, true);
          EpiE1 e{(bf16_t*)(ws + WS_KT), (const bf16_t*)(ws + WS_GATE)};
          comb_phase(p);
          __syncthreads();
          pg8::gemm_phase(lds, g, so, e); }
        xcd_barrier(xbar);
        { pg8::Gemm g{(const bf16_t*)(ws + WS_Q), (const bf16_t*)(wl + WL_RET), TT, DM, VW, (unsigned long long*)(ws + WS_DUMP), (unsigned*)(ws + WS_CNT)}; so.init(TT, DM, gridDim.x, blockIdx.x, true);
          EpiE2 e{(const bf16_t*)(ws + WS_KT), (const bf16_t*)(ws + WS_GATE), (bf16_t*)(ws + WS_R2)};
          pg8::gemm_phase(lds, g, so, e); }
        xcd_barrier(xbar);
        { pg8::Gemm g{(const bf16_t*)(ws + WS_R2), (const bf16_t*)(wl + WL_OUT), TT, DM, DM, (unsigned long long*)(ws + WS_DUMP), (unsigned*)(ws + WS_CNT)}; so.init(TT, DM, gridDim.x, blockIdx.x, true);
          EpiResT<true> e{xa, xb, xbuf, modl + 2 * 1024};
          pg8::gemm_phase(lds, g, so, e); }
        xcd_barrier(xbar);
        norm_mod_phase(xbuf, xbuf + (size_t)TC * DM, (bf16_t*)(ws + WS_R1), p.in[6] + l * DM, modl, 3);
        xcd_barrier(xbar);
        { pg8::Gemm g{(const bf16_t*)(ws + WS_R1), (const bf16_t*)(wl + WL_M1), TT, MLPW, DM, nullptr, nullptr}; so.init(TT, MLPW, gridDim.x, blockIdx.x);
          EpiF1 e{(bf16_t*)(ws + WS_RG)};
          pg8::gemm_phase(lds, g, so, e); }
        xcd_barrier(xbar);
        { pg8::Gemm g{(const bf16_t*)(ws + WS_RG), (const bf16_t*)(wl + WL_M2), TT, DM, MLPW, (unsigned long long*)(ws + WS_DUMP), (unsigned*)(ws + WS_CNT)}; so.init(TT, DM, gridDim.x, blockIdx.x, true);
          EpiResT<true> e{xbuf, xbuf + (size_t)TC * DM, xbuf, modl + 5 * 1024};
          pg8::gemm_phase(lds, g, so, e); }
        xcd_barrier(xbar);
    }
    final_norm_phase(xbuf, p.in[19]);
}

extern "C" void kernel_launch(void* const* d_in, const int* in_sizes, int n_in, void* d_out, int out_size, void* d_ws, size_t ws_size, hipStream_t stream) {
    static int grid_blocks = 0;
    if (!grid_blocks) {
        int dev = 0, cus = 0, per_cu = 0;
        (void)hipGetDevice(&dev);
        (void)hipDeviceGetAttribute(&cus, hipDeviceAttributeMultiprocessorCount, dev);
        (void)hipOccupancyMaxActiveBlocksPerMultiprocessor(&per_cu, mega, NTHR, 0);
        if (per_cu < 1) per_cu = 1;
        grid_blocks = cus;
    }
    if (n_in != 20 || ws_size < WS_END) return;
    Params p{};
    for (int i = 0; i < 20; ++i) p.in[i] = (const float*)d_in[i];
    p.out = (float*)d_out; p.ws = (unsigned char*)d_ws;
    void* args[] = {&p};
    (void)hipLaunchCooperativeKernel((void*)mega, dim3(grid_blocks), dim3(NTHR), args, 0, stream);
}
```
